# Optimizing an MI355X kernel written in HIP

```python
import math
import jax, jax.numpy as jnp
from jax import lax
import numpy as np

D_MODEL = 1024
BATCH = 16
SEQ = 2048
DEPTH = 1
DEC_BATCH = 8
DEC_SEQ = 2048
PAST_LEN = 128

MIX_W = D_MODEL
POOL_W = MIX_W // 2
POOL_WINDOWS = (2, 4, 8, 16)
N_POOL_GROUPS = len(POOL_WINDOWS)
POOL_GC = POOL_W // N_POOL_GROUPS
N_HEADS = 8
QK_NOPE = 64
QK_ROPE = 32
QK_DIM = QK_NOPE + QK_ROPE
V_DIM = 64
ATT_W = N_HEADS * V_DIM
Q_LORA = 384
KV_LORA = 256
ROPE_BASE = 10000.0
Q_BLOCK = 128
ATTN_SCALE = 1.0 / math.sqrt(QK_DIM)
IN_W = POOL_W + Q_LORA + KV_LORA + QK_ROPE
D_FF = int(math.ceil(D_MODEL * 8 / 3 / 256) * 256)
PLE_DIM = 256
EPS = 1e-6

kernel_name = "hybrid_pool_mla_encoder"


def rms_norm(x, g):
    xf = x.astype(jnp.float32)
    y = xf * lax.rsqrt(jnp.mean(xf * xf, axis=-1, keepdims=True) + EPS)
    return (y * g.astype(jnp.float32)).astype(x.dtype)


def rope_tables(S, dtype):
    inv = ROPE_BASE ** (-jnp.arange(0, QK_ROPE, 2, dtype=jnp.float32) / QK_ROPE)
    ang = jnp.arange(S, dtype=jnp.float32)[:, None] * inv[None, :]
    return jnp.cos(ang).astype(dtype), jnp.sin(ang).astype(dtype)


def apply_rope(x, cos, sin):
    x1, x2 = jnp.split(x, 2, axis=-1)
    c = cos[None, :, None, :]
    s = sin[None, :, None, :]
    return jnp.concatenate([x1 * c - x2 * s, x1 * s + x2 * c], axis=-1)


def multiscale_pool(u, w_pool, pool_scale):
    B, S, _ = u.shape
    ug = u.reshape(B, S, N_POOL_GROUPS, POOL_GC)
    csum = jnp.cumsum(ug.astype(jnp.float32), axis=1)
    cs = jnp.concatenate([jnp.zeros_like(csum[:, :1]), csum], axis=1)
    t = jnp.arange(S)
    means = []
    for g, w in enumerate(POOL_WINDOWS):
        lo = jnp.clip(t - w // 2, 0, S)
        hi = jnp.clip(t - w // 2 + w, 0, S)
        csg = cs[:, :, g]
        cnt = (hi - lo).astype(jnp.float32)[None, :, None]
        means.append((csg[:, hi] - csg[:, lo]) / cnt)
    mean = jnp.stack(means, axis=2).astype(u.dtype)
    y = jnp.einsum('bsgc,gcd->bsgd', mean - ug, w_pool)
    return y.reshape(B, S, POOL_W) * pool_scale


def block_attention(q, k, v):
    B, S, H, D = q.shape
    nb = S // Q_BLOCK
    qb = q.reshape(B, nb, Q_BLOCK, H, D).transpose(1, 0, 2, 3, 4)

    def one(qblk):
        s = jnp.einsum('bqhd,bkhd->bhqk', qblk, k).astype(jnp.float32) * ATTN_SCALE
        p = jax.nn.softmax(s, axis=-1).astype(v.dtype)
        return jnp.einsum('bhqk,bkhd->bqhd', p, v)

    o = lax.map(one, qb)
    return o.transpose(1, 0, 2, 3, 4).reshape(B, S, H * V_DIM)


def encoder_layer(h, p, cos, sin, ln1, w_in, w_pool, pool_scale, q_a_norm, w_qb, kv_a_norm, w_kvb,
                  q_norm, k_norm, w_o, ln2, w_gate, w_up, w_down, ple_norm, w_ple_gate, w_ple_proj):
    B, S, _ = h.shape
    u = rms_norm(h, ln1)
    z = u @ w_in
    pool_in = z[..., :POOL_W]
    c_q = z[..., POOL_W:POOL_W + Q_LORA]
    c_kv = z[..., POOL_W + Q_LORA:POOL_W + Q_LORA + KV_LORA]
    k_r = z[..., POOL_W + Q_LORA + KV_LORA:]

    y_pool = multiscale_pool(pool_in, w_pool, pool_scale)

    q = (rms_norm(c_q, q_a_norm) @ w_qb).reshape(B, S, N_HEADS, QK_DIM)
    kv = (rms_norm(c_kv, kv_a_norm) @ w_kvb).reshape(B, S, N_HEADS, QK_NOPE + V_DIM)
    k_nope, v = kv[..., :QK_NOPE], kv[..., QK_NOPE:]
    k = jnp.concatenate([k_nope, jnp.broadcast_to(k_r[:, :, None, :], (B, S, N_HEADS, QK_ROPE))], axis=-1)
    q = rms_norm(q, q_norm)
    k = rms_norm(k, k_norm)
    q = jnp.concatenate([q[..., :QK_NOPE], apply_rope(q[..., QK_NOPE:], cos, sin)], axis=-1)
    k = jnp.concatenate([k[..., :QK_NOPE], apply_rope(k[..., QK_NOPE:], cos, sin)], axis=-1)
    y_att = block_attention(q, k, v)

    h = h + jnp.concatenate([y_pool, y_att], axis=-1) @ w_o

    u2 = rms_norm(h, ln2)
    h = h + (jax.nn.silu(u2 @ w_gate) * (u2 @ w_up)) @ w_down

    gate = jax.nn.sigmoid(rms_norm(h, ple_norm) @ w_ple_gate)
    return h + gate * (p @ w_ple_proj)


def setup_inputs(seed: int = 0) -> dict:
    key = jax.random.key(seed)
    ks = jax.random.split(key, 24)
    f = jnp.float32

    def nrm(k, shape, fan_in):
        return jax.random.normal(k, shape, f) * (fan_in ** -0.5)

    def gain(k, shape):
        return 1.0 + 0.1 * jax.random.normal(k, shape, f)

    L = DEPTH
    return {
        "x_prompt": jax.random.normal(ks[0], (BATCH, SEQ, D_MODEL), f),
        "x_sample": jax.random.normal(ks[1], (DEC_BATCH, DEC_SEQ, D_MODEL), f),
        "p_prompt": jax.random.normal(ks[2], (DEPTH, BATCH, SEQ, PLE_DIM), f),
        "p_sample": jax.random.normal(ks[3], (DEPTH, DEC_BATCH, DEC_SEQ, PLE_DIM), f),
        "ln1": gain(ks[4], (L, D_MODEL)),
        "w_in": nrm(ks[5], (L, D_MODEL, IN_W), D_MODEL),
        "w_pool": nrm(ks[6], (L, N_POOL_GROUPS, POOL_GC, POOL_GC), POOL_GC),
        "pool_scale": gain(ks[7], (L, POOL_W)),
        "q_a_norm": gain(ks[8], (L, Q_LORA)),
        "w_qb": nrm(ks[9], (L, Q_LORA, N_HEADS * QK_DIM), Q_LORA),
        "kv_a_norm": gain(ks[10], (L, KV_LORA)),
        "w_kvb": nrm(ks[11], (L, KV_LORA, N_HEADS * (QK_NOPE + V_DIM)), KV_LORA),
        "q_norm": gain(ks[12], (L, QK_DIM)),
        "k_norm": gain(ks[13], (L, QK_DIM)),
        "w_o": nrm(ks[14], (L, MIX_W, D_MODEL), MIX_W),
        "ln2": gain(ks[15], (L, D_MODEL)),
        "w_gate": nrm(ks[16], (L, D_MODEL, D_FF), D_MODEL),
        "w_up": nrm(ks[17], (L, D_MODEL, D_FF), D_MODEL),
        "w_down": nrm(ks[18], (L, D_FF, D_MODEL), D_FF),
        "ple_norm": gain(ks[19], (L, D_MODEL)),
        "w_ple_gate": nrm(ks[20], (L, D_MODEL, D_MODEL), D_MODEL),
        "w_ple_proj": nrm(ks[21], (L, PLE_DIM, D_MODEL), PLE_DIM),
    }


def reference(x_prompt, x_sample, p_prompt, p_sample, ln1, w_in, w_pool, pool_scale, q_a_norm, w_qb,
              kv_a_norm, w_kvb, q_norm, k_norm, w_o, ln2, w_gate, w_up, w_down, ple_norm, w_ple_gate,
              w_ple_proj):
    def run(x, p):
        cos, sin = rope_tables(x.shape[1], x.dtype)
        h = x
        for i in range(DEPTH):
            h = encoder_layer(h, p[i], cos, sin, ln1[i], w_in[i], w_pool[i], pool_scale[i], q_a_norm[i],
                              w_qb[i], kv_a_norm[i], w_kvb[i], q_norm[i], k_norm[i], w_o[i], ln2[i],
                              w_gate[i], w_up[i], w_down[i], ple_norm[i], w_ple_gate[i], w_ple_proj[i])
        return h

    y_prompt = run(x_prompt, p_prompt)
    y_sample = run(x_sample, p_sample)
    return (y_prompt, y_sample)
```

```cpp
#include <hip/hip_runtime.h>
#include <cstdio>
#include <cstdint>

namespace pg8 {
#define PG8_LAS __attribute__((address_space(3)))
typedef unsigned short bf16_t;
typedef short bf16x8 __attribute__((ext_vector_type(8)));
typedef float f32x4 __attribute__((ext_vector_type(4)));
typedef unsigned u32x4 __attribute__((ext_vector_type(4)));
constexpr int BM = 256, BK = 64, HALF = 128, HTB = HALF * BK * 2  , STAGE_BYTES = 8 * HTB, NXCD = 8, WGM = 8;

__host__ __device__ __forceinline__ int lds_byte(int r, int c) { const int st = (r >> 4) * 2 + (c >> 5), rr = r & 15, cc = c & 31, ob = rr * 64 + cc * 2; return st * 1024 + (ob ^ (((ob >> 9) & 1) << 5)); }
__host__ __device__ __forceinline__ void stage_rc(int b, int& R, int& C) { const int st = b / 1024, sb = b % 1024, swz = sb ^ (((sb >> 9) & 1) << 5); R = (st >> 1) * 16 + swz / 64; C = (st & 1) * 32 + (swz % 64) / 2; }
__host__ __device__ __forceinline__ int perm32(int rho) { const int n = rho >> 4, i = rho & 15; return 8 * (i >> 2) + 4 * n + (i & 3); }

struct Unit { int pm, pn; };
struct Gemm { const bf16_t* A; const bf16_t* Bt; int M, N, K, lda; };

struct StaticOrder {
    int nM, nN, nwg, G, c;
    __host__ __device__ void init(int M, int N, int G_, int c_) { nM = M / BM; nN = N / BM; nwg = nM * nN; G = G_; c = c_; }
    __host__ __device__ bool next(int i, Unit& u) const {
        const long L = (long)i * G + c; if (L >= nwg) return false;
        int wgid = (int)L; { const int q = nwg / NXCD, r = nwg % NXCD, xcd = wgid % NXCD, off = wgid / NXCD; wgid = (xcd < r ? xcd * (q + 1) : r * (q + 1) + (xcd - r) * q) + off; }
        const int nig = WGM * nN, gid = wgid / nig, fm = gid * WGM, gsz = (nM - fm) < WGM ? (nM - fm) : WGM;
        u.pm = fm + ((wgid % nig) % gsz); u.pn = (wgid % nig) / gsz; return true;
    }
    __device__ __forceinline__ void a_ready(const Unit&) const {}
    __device__ __forceinline__ void done(const Unit&) const {}
};

__device__ __forceinline__ unsigned cvt_pk_bf16(float lo, float hi) { unsigned r; asm volatile("v_cvt_pk_bf16_f32 %0, %1, %2" : "=v"(r) : "v"(lo), "v"(hi)); return r; }
typedef float f32x2 __attribute__((ext_vector_type(2)));

constexpr int MROWS = 49152, SEQ = 2048, MPROMPT = 32768;
constexpr float NEPS = 1e-6f;
__device__ __forceinline__ u32x4 pack8(const f32x4 a, const f32x4 b) { u32x4 w; w.x = cvt_pk_bf16(a[0], a[1]); w.y = cvt_pk_bf16(a[2], a[3]); w.z = cvt_pk_bf16(b[0], b[1]); w.w = cvt_pk_bf16(b[2], b[3]); return w; }
__device__ __forceinline__ float sq8(const f32x4 a, const f32x4 b) { return (a[0] * a[0] + a[1] * a[1]) + (a[2] * a[2] + a[3] * a[3]) + (b[0] * b[0] + b[1] * b[1]) + (b[2] * b[2] + b[3] * b[3]); }
__device__ __forceinline__ float red_fq(float s) { s += __shfl_xor(s, 16); s += __shfl_xor(s, 32); return s; }
__device__ __forceinline__ float bflo(unsigned w) { return __uint_as_float(w << 16); }
__device__ __forceinline__ float bfhi(unsigned w) { return __uint_as_float(w & 0xffff0000u); }
#define EPI_ROWS_BEGIN _Pragma("unroll") for (int ai = 0; ai < 2; ++ai) _Pragma("unroll") for (int m = 0; m < 4; ++m) { int row = u.pm * BM + ai * HALF + wr * 64 + m * 16 + fr; asm volatile("" : "+v"(row) :: "memory");
#define EPI_ROWS_END }

struct EpiIn {
    static constexpr bool PERM = true, AFTER_DRAIN = false;
    bf16_t* z; const float* ss1; float* ss_q; float* ss_kv; float* ss_kr; float* krr; const float* kn_g; const float* tab;
    __device__ __forceinline__ void operator()(const f32x4 (&acc)[2][2][4][2], const Unit& u, int wr, int wc, int fr, int fq) const {
        const int colt = u.pn * BM + wc * 32 + 8 * fq;
        EPI_ROWS_BEGIN
            const float rs = 1.0f / sqrtf(ss1[row] * (1.0f / 1024.0f) + NEPS);
            f32x4 v00 = acc[ai][0][m][0] * rs, v01 = acc[ai][0][m][1] * rs, v10 = acc[ai][1][m][0] * rs, v11 = acc[ai][1][m][1] * rs;
            bf16_t* zr = z + (size_t)row * 1280 + colt;
            if (u.pn != 3) {
                *(u32x4*)(zr) = pack8(v00, v01); *(u32x4*)(zr + HALF) = pack8(v10, v11);
                if (u.pn == 2 || u.pn == 4) { const float s = red_fq(sq8(v00, v01) + sq8(v10, v11)); if (fq == 0) atomicAdd((u.pn == 2 ? ss_q : ss_kv) + row, s); }
            } else {
                *(u32x4*)(zr) = pack8(v00, v01);
                { const float s = red_fq(sq8(v00, v01)); if (fq == 0) atomicAdd(ss_q + row, s); }
                if (wc == 0) {
                    const float s = red_fq(sq8(v10, v11)); if (fq == 0) ss_kr[row] = s;
                    const int t = row & (SEQ - 1); const float* tb = tab + ((size_t)t * 16 + 4 * fq) * 2;
                    const f32x4 cs0 = *(const f32x4*)(tb), cs1 = *(const f32x4*)(tb + 4);
                    const f32x4 g1 = *(const f32x4*)(kn_g + 64 + 4 * fq), g2 = *(const f32x4*)(kn_g + 80 + 4 * fq);
                    f32x4 o0, o1;
                    { const float a = v10[0] * g1[0], b = v10[1] * g2[0]; o0[0] = a * cs0[0] - b * cs0[1]; o0[1] = a * cs0[1] + b * cs0[0]; }
                    { const float a = v10[2] * g1[1], b = v10[3] * g2[1]; o0[2] = a * cs0[2] - b * cs0[3]; o0[3] = a * cs0[3] + b * cs0[2]; }
                    { const float a = v11[0] * g1[2], b = v11[1] * g2[2]; o1[0] = a * cs1[0] - b * cs1[1]; o1[1] = a * cs1[1] + b * cs1[0]; }
                    { const float a = v11[2] * g1[3], b = v11[3] * g2[3]; o1[2] = a * cs1[2] - b * cs1[3]; o1[3] = a * cs1[3] + b * cs1[2]; }
                    float* kr = krr + (size_t)row * 32 + 8 * fq; *(f32x4*)kr = o0; *(f32x4*)(kr + 4) = o1;
                }
            }
        EPI_ROWS_END
    }
};
struct EpiQ {
    static constexpr bool PERM = true, AFTER_DRAIN = false;
    bf16_t* Q; const float* ss_q; float* hss;
    __device__ __forceinline__ void operator()(const f32x4 (&acc)[2][2][4][2], const Unit& u, int wr, int wc, int fr, int fq) const {
        const int s0 = u.pn * 8 + wc, s1 = s0 + 4; const int h0 = s0 / 3, p0 = s0 - 3 * h0, h1 = s1 / 3, p1 = s1 - 3 * h1;
        EPI_ROWS_BEGIN
            const float rs = 1.0f / sqrtf(ss_q[row] * (1.0f / 384.0f) + NEPS);
            const int b = row >> 11, t = row & (SEQ - 1);
            const f32x4 v00 = acc[ai][0][m][0] * rs, v01 = acc[ai][0][m][1] * rs, v10 = acc[ai][1][m][0] * rs, v11 = acc[ai][1][m][1] * rs;
            *(u32x4*)(Q + ((size_t)(b * 8 + h0) * SEQ + t) * 96 + p0 * 32 + 8 * fq) = pack8(v00, v01);
            *(u32x4*)(Q + ((size_t)(b * 8 + h1) * SEQ + t) * 96 + p1 * 32 + 8 * fq) = pack8(v10, v11);
            const float q0 = red_fq(sq8(v00, v01)), q1 = red_fq(sq8(v10, v11));
            if (fq == 0) { atomicAdd(hss + (size_t)h0 * MROWS + row, q0); atomicAdd(hss + (size_t)h1 * MROWS + row, q1); }
        EPI_ROWS_END
    }
};
struct EpiKV {
    static constexpr bool PERM = true, AFTER_DRAIN = false;
    bf16_t* K; bf16_t* V; const float* ss_kv; const float* ss_kr; const float* krr; const float* kn_g;
    __device__ __forceinline__ void operator()(const f32x4 (&acc)[2][2][4][2], const Unit& u, int wr, int wc, int fr, int fq) const {
        const int h = 2 * u.pn + (wc & 1);
        EPI_ROWS_BEGIN
            const float rs = 1.0f / sqrtf(ss_kv[row] * (1.0f / 256.0f) + NEPS);
            const int b = row >> 11, t = row & (SEQ - 1);
            f32x4 v00 = acc[ai][0][m][0] * rs, v01 = acc[ai][0][m][1] * rs, v10 = acc[ai][1][m][0] * rs, v11 = acc[ai][1][m][1] * rs;
            if (wc >= 2) {
                bf16_t* vp = V + ((size_t)(b * 8 + h) * SEQ + t) * 64 + 8 * fq;
                *(u32x4*)(vp) = pack8(v00, v01); *(u32x4*)(vp + 32) = pack8(v10, v11);
            } else {
                const float tot = red_fq(sq8(v00, v01) + sq8(v10, v11));
                const float sk = 1.0f / sqrtf((tot + ss_kr[row]) * (1.0f / 96.0f) + NEPS);
                const f32x4 g00 = *(const f32x4*)(kn_g + 8 * fq), g01 = *(const f32x4*)(kn_g + 8 * fq + 4), g10 = *(const f32x4*)(kn_g + 32 + 8 * fq), g11 = *(const f32x4*)(kn_g + 36 + 8 * fq);
                v00 = v00 * g00 * sk; v01 = v01 * g01 * sk; v10 = v10 * g10 * sk; v11 = v11 * g11 * sk;
                bf16_t* kp = K + ((size_t)(b * 8 + h) * SEQ + t) * 96 + 8 * fq;
                *(u32x4*)(kp) = pack8(v00, v01); *(u32x4*)(kp + 32) = pack8(v10, v11);
                const float* kr = krr + (size_t)row * 32 + 8 * fq; const f32x4 r0 = *(const f32x4*)kr * sk, r1 = *(const f32x4*)(kr + 4) * sk;
                *(u32x4*)(kp + 64) = pack8(r0, r1);
            }
        EPI_ROWS_END
    }
};
struct EpiRes {
    static constexpr bool PERM = true, AFTER_DRAIN = false;
    const float* xa; const float* xb; float* out; bf16_t* hb; float* ss;
    __device__ __forceinline__ void operator()(const f32x4 (&acc)[2][2][4][2], const Unit& u, int wr, int wc, int fr, int fq) const {
        const int colt = u.pn * BM + wc * 32 + 8 * fq;
        EPI_ROWS_BEGIN
            const float* br = (row < MPROMPT ? xa + (size_t)row * 1024 : xb + (size_t)(row - MPROMPT) * 1024) + colt;
            float s = 0.f;
#pragma unroll
            for (int bj = 0; bj < 2; ++bj) {
                const f32x4 h0 = *(const f32x4*)(br + bj * HALF) + acc[ai][bj][m][0], h1 = *(const f32x4*)(br + bj * HALF + 4) + acc[ai][bj][m][1];
                float* o = out + (size_t)row * 1024 + colt + bj * HALF; *(f32x4*)o = h0; *(f32x4*)(o + 4) = h1;
                *(u32x4*)(hb + (size_t)row * 1024 + colt + bj * HALF) = pack8(h0, h1);
                s += sq8(h0, h1);
            }
            s = red_fq(s); if (fq == 0) atomicAdd(ss + row, s);
        EPI_ROWS_END
    }
};
struct EpiSwiglu {
    static constexpr bool PERM = true, AFTER_DRAIN = false;
    bf16_t* act; const float* ss2;
    __device__ __forceinline__ void operator()(const f32x4 (&acc)[2][2][4][2], const Unit& u, int wr, int wc, int fr, int fq) const {
        const int colt = u.pn * HALF + wc * 32 + 8 * fq;
        EPI_ROWS_BEGIN
            const float rs = 1.0f / sqrtf(ss2[row] * (1.0f / 1024.0f) + NEPS);
            f32x4 a[2];
#pragma unroll
            for (int n = 0; n < 2; ++n) { const f32x4 g = acc[ai][0][m][n] * rs, w = acc[ai][1][m][n] * rs;
#pragma unroll
                for (int e = 0; e < 4; ++e) a[n][e] = g[e] * __builtin_amdgcn_rcpf(1.0f + __builtin_amdgcn_exp2f(-1.4426950408889634f * g[e])) * w[e]; }
            *(u32x4*)(act + (size_t)row * 2816 + colt) = pack8(a[0], a[1]);
        EPI_ROWS_END
    }
};
struct EpiStore {
    static constexpr bool PERM = true, AFTER_DRAIN = false;
    bf16_t* o;
    __device__ __forceinline__ void operator()(const f32x4 (&acc)[2][2][4][2], const Unit& u, int wr, int wc, int fr, int fq) const {
        const int colt = u.pn * BM + wc * 32 + 8 * fq;
        EPI_ROWS_BEGIN
#pragma unroll
            for (int bj = 0; bj < 2; ++bj) *(u32x4*)(o + (size_t)row * 1024 + colt + bj * HALF) = pack8(acc[ai][bj][m][0], acc[ai][bj][m][1]);
        EPI_ROWS_END
    }
};
struct EpiFinal {
    static constexpr bool PERM = true, AFTER_DRAIN = false;
    float* out; const bf16_t* proj; const float* ss3;
    __device__ __forceinline__ void operator()(const f32x4 (&acc)[2][2][4][2], const Unit& u, int wr, int wc, int fr, int fq) const {
        const int colt = u.pn * BM + wc * 32 + 8 * fq;
        EPI_ROWS_BEGIN
            const float rs = 1.0f / sqrtf(ss3[row] * (1.0f / 1024.0f) + NEPS);
#pragma unroll
            for (int bj = 0; bj < 2; ++bj) {
                float* o = out + (size_t)row * 1024 + colt + bj * HALF; const u32x4 pj = *(const u32x4*)(proj + (size_t)row * 1024 + colt + bj * HALF);
                f32x4 h0 = *(const f32x4*)o, h1 = *(const f32x4*)(o + 4);
                const float pf[8] = {bflo(pj.x), bfhi(pj.x), bflo(pj.y), bfhi(pj.y), bflo(pj.z), bfhi(pj.z), bflo(pj.w), bfhi(pj.w)};
#pragma unroll
                for (int e = 0; e < 4; ++e) { const float g0 = acc[ai][bj][m][0][e] * rs, g1 = acc[ai][bj][m][1][e] * rs;
                    h0[e] += pf[e] * __builtin_amdgcn_rcpf(1.0f + __builtin_amdgcn_exp2f(-1.4426950408889634f * g0));
                    h1[e] += pf[4 + e] * __builtin_amdgcn_rcpf(1.0f + __builtin_amdgcn_exp2f(-1.4426950408889634f * g1)); }
                *(f32x4*)o = h0; *(f32x4*)(o + 4) = h1;
            }
        EPI_ROWS_END
    }
};

template <class Epi, class Sched, bool ALIGN_EPI = false, bool SP2 = false>
__device__ __forceinline__ void gemm_phase(PG8_LAS unsigned char* lds, const Gemm g, const Sched& S, const Epi& E) {
    const int tid = threadIdx.x, wid = __builtin_amdgcn_readfirstlane(tid >> 6), lane = tid & 63, wr = wid >> 2, wc = wid & 3, fr = lane & 15, fq = lane >> 4;
    const int K = g.K, nt = K / BK;
    unsigned voffA[2], voffB[2];
#pragma unroll
    for (int i = 0; i < 2; ++i) { int R, C; stage_rc(tid * 16 + i * 8192, R, C); const int Rb = Epi::PERM ? ((R & ~31) + perm32(R & 31)) : R;
        voffA[i] = (unsigned)(R * g.lda + C) * 2u; voffB[i] = (unsigned)(Rb * K + C) * 2u; }
    const size_t kstep = (size_t)(BK * 2);
    const size_t hstepA = (size_t)HALF * g.lda * 2, hstepB = (size_t)HALF * K * 2;
    const size_t tstepA = 2 * hstepA, tstepB = 2 * hstepB;
    const unsigned ldsw = (unsigned)wid * 1024u;
    const int aoff = lds_byte(wr * 64 + fr, fq * 8), boff = lds_byte(wc * 32 + fr, fq * 8);
#define PG8_SA(b, h) (((b) * 2 + (h)) * HTB)
#define PG8_SB(b, h) ((4 + (b) * 2 + (h)) * HTB)
#define PG8_STAGE(bufoff, gbase, voff) do { _Pragma("unroll") for (int _i = 0; _i < 2; ++_i) \
        __builtin_amdgcn_global_load_lds((const unsigned*)((const char*)(gbase) + (voff)[_i]), (PG8_LAS unsigned*)(lds + (bufoff) + ldsw + _i * 8192), 16, 0, 0); } while (0)
#define PG8_LDA(dst, b, h) do { _Pragma("unroll") for (int m = 0; m < 4; ++m) _Pragma("unroll") for (int k = 0; k < 2; ++k) dst[m][k] = *(const PG8_LAS bf16x8*)(lds + PG8_SA(b, h) + aoff + m * 2048 + k * 1024); } while (0)
#define PG8_LDB(dst, b, h) do { _Pragma("unroll") for (int n = 0; n < 2; ++n) _Pragma("unroll") for (int k = 0; k < 2; ++k) dst[n][k] = *(const PG8_LAS bf16x8*)(lds + PG8_SB(b, h) + boff + n * 2048 + k * 1024); } while (0)
#define PG8_MMA(ai, bj, At, Bt) do { __builtin_amdgcn_s_setprio(1); _Pragma("unroll") for (int m = 0; m < 4; ++m) _Pragma("unroll") for (int n = 0; n < 2; ++n) _Pragma("unroll") for (int k = 0; k < 2; ++k) \
        acc[ai][bj][m][n] = __builtin_amdgcn_mfma_f32_16x16x32_bf16(Bt[n][k], At[m][k], acc[ai][bj][m][n], 0, 0, 0); __builtin_amdgcn_s_setprio(0); } while (0)
#define PG8_WAIT_V(n) asm volatile("s_waitcnt vmcnt(" #n ")" ::: "memory")
#define PG8_WAIT_L(n) asm volatile("s_waitcnt lgkmcnt(" #n ")" ::: "memory")
#define PG8_BAR __builtin_amdgcn_s_barrier()
#define PG8_SCHED __builtin_amdgcn_sched_barrier(0)
    Unit cur, nxt; int ui = 0;
    if (!S.next(0, cur)) return;
    f32x4 acc[2][2][4][2];
#pragma unroll
    for (int a = 0; a < 2; ++a)
#pragma unroll
        for (int b = 0; b < 2; ++b)
#pragma unroll
            for (int m = 0; m < 4; ++m)
#pragma unroll
                for (int n = 0; n < 2; ++n) acc[a][b][m][n] = (f32x4){0.f, 0.f, 0.f, 0.f};
    bf16x8 At[4][2], B0[2][2], B1[2][2];
    const char* cA = (const char*)g.A + (size_t)cur.pm * tstepA; const char* cB = (const char*)g.Bt + (size_t)cur.pn * tstepB;
    S.a_ready(cur);
    if constexpr (SP2) {
        PG8_STAGE(PG8_SB(0, 0), cB, voffB); PG8_STAGE(PG8_SB(0, 1), cB + hstepB, voffB); PG8_STAGE(PG8_SA(0, 0), cA, voffA); PG8_STAGE(PG8_SA(0, 1), cA + hstepA, voffA);
        if (wr == 1) PG8_BAR;
        PG8_WAIT_V(2); PG8_BAR;
        PG8_STAGE(PG8_SB(1, 0), cB + kstep, voffB); PG8_STAGE(PG8_SA(1, 0), cA + kstep, voffA); PG8_STAGE(PG8_SB(1, 1), cB + hstepB + kstep, voffB);
        PG8_WAIT_V(6); PG8_BAR;
    } else {
        PG8_STAGE(PG8_SB(0, 0), cB, voffB); PG8_STAGE(PG8_SA(0, 0), cA, voffA); PG8_STAGE(PG8_SB(0, 1), cB + hstepB, voffB); PG8_STAGE(PG8_SA(0, 1), cA + hstepA, voffA);
        if (wr == 1) PG8_BAR;
        PG8_WAIT_V(4); PG8_BAR;
        PG8_STAGE(PG8_SB(1, 0), cB + kstep, voffB); PG8_STAGE(PG8_SA(1, 0), cA + kstep, voffA); PG8_STAGE(PG8_SB(1, 1), cB + hstepB + kstep, voffB);
        PG8_WAIT_V(6); PG8_BAR;
    }
    for (;;) {
        const bool has_next = S.next(ui + 1, nxt);
        const char* nA = has_next ? (const char*)g.A + (size_t)nxt.pm * tstepA : cA; const char* nB = has_next ? (const char*)g.Bt + (size_t)nxt.pn * tstepB : cB;
#pragma nounroll
        for (int t = 0; t < nt; t += 2) {
            const bool last = (t == nt - 2);
            const char* a1 = cA + (size_t)(t + 1) * kstep;
            const char* a2 = last ? nA : cA + (size_t)(t + 2) * kstep; const char* b2 = last ? nB : cB + (size_t)(t + 2) * kstep;
            const char* a3 = a2 + kstep; const char* b3 = b2 + kstep;
            if (last && has_next) S.a_ready(nxt);
            if constexpr (SP2) {
            PG8_LDB(B0, 0, 0); PG8_LDB(B1, 0, 1); PG8_SCHED; PG8_LDA(At, 0, 0); PG8_STAGE(PG8_SA(1, 1), a1 + hstepA, voffA);
            PG8_WAIT_V(8); PG8_WAIT_L(0); PG8_BAR; PG8_MMA(0, 0, At, B0); PG8_MMA(0, 1, At, B1); PG8_BAR; PG8_SCHED;
            PG8_LDA(At, 0, 1); PG8_STAGE(PG8_SB(0, 0), b2, voffB); PG8_STAGE(PG8_SB(0, 1), b2 + hstepB, voffB); PG8_STAGE(PG8_SA(0, 0), a2, voffA);
            PG8_WAIT_V(8); PG8_WAIT_L(0); PG8_BAR; PG8_MMA(1, 0, At, B0); PG8_MMA(1, 1, At, B1); PG8_BAR; PG8_SCHED;
            PG8_LDB(B0, 1, 0); PG8_LDB(B1, 1, 1); PG8_SCHED; PG8_LDA(At, 1, 0); PG8_STAGE(PG8_SA(0, 1), a2 + hstepA, voffA);
            PG8_WAIT_V(8); PG8_WAIT_L(0); PG8_BAR; PG8_MMA(0, 0, At, B0); PG8_MMA(0, 1, At, B1); PG8_BAR; PG8_SCHED;
            PG8_LDA(At, 1, 1); PG8_STAGE(PG8_SB(1, 0), b3, voffB); PG8_STAGE(PG8_SB(1, 1), b3 + hstepB, voffB); PG8_STAGE(PG8_SA(1, 0), a3, voffA);
            PG8_WAIT_V(8); PG8_WAIT_L(0); PG8_BAR; PG8_MMA(1, 0, At, B0); PG8_MMA(1, 1, At, B1); PG8_BAR; PG8_SCHED;
            } else {
            PG8_LDB(B0, 0, 0); PG8_SCHED; PG8_LDA(At, 0, 0); PG8_STAGE(PG8_SA(1, 1), a1 + hstepA, voffA);
            PG8_WAIT_L(8); PG8_BAR; PG8_WAIT_L(0); PG8_MMA(0, 0, At, B0); PG8_BAR; PG8_SCHED;
            PG8_LDB(B1, 0, 1); PG8_STAGE(PG8_SB(0, 0), b2, voffB);
            PG8_BAR; PG8_WAIT_L(0); PG8_MMA(0, 1, At, B1); PG8_BAR;
            PG8_LDA(At, 0, 1); PG8_STAGE(PG8_SA(0, 0), a2, voffA);
            PG8_BAR; PG8_WAIT_L(0); PG8_MMA(1, 0, At, B0); PG8_BAR; PG8_SCHED;
            PG8_STAGE(PG8_SB(0, 1), b2 + hstepB, voffB);
            PG8_WAIT_V(6); PG8_BAR; PG8_MMA(1, 1, At, B1); PG8_BAR;
            PG8_LDB(B0, 1, 0); PG8_SCHED; PG8_LDA(At, 1, 0); PG8_STAGE(PG8_SA(0, 1), a2 + hstepA, voffA);
            PG8_WAIT_L(8); PG8_BAR; PG8_WAIT_L(0); PG8_MMA(0, 0, At, B0); PG8_BAR; PG8_SCHED;
            PG8_LDB(B1, 1, 1); PG8_STAGE(PG8_SB(1, 0), b3, voffB);
            PG8_BAR; PG8_WAIT_L(0); PG8_MMA(0, 1, At, B1); PG8_BAR;
            PG8_LDA(At, 1, 1); PG8_STAGE(PG8_SA(1, 0), a3, voffA);
            PG8_BAR; PG8_WAIT_L(0); PG8_MMA(1, 0, At, B0); PG8_BAR; PG8_SCHED;
            PG8_STAGE(PG8_SB(1, 1), b3 + hstepB, voffB);
            PG8_WAIT_V(6); PG8_BAR; PG8_MMA(1, 1, At, B1); PG8_BAR;
            }
        }
        if constexpr (ALIGN_EPI) { if (wr == 0) PG8_BAR; }
        if constexpr (!Epi::AFTER_DRAIN) { E(acc, cur, wr, wc, fr, fq); S.done(cur); }
        if (!has_next) break;
#pragma unroll
        for (int a = 0; a < 2; ++a)
#pragma unroll
            for (int b = 0; b < 2; ++b)
#pragma unroll
                for (int m = 0; m < 4; ++m)
#pragma unroll
                    for (int n = 0; n < 2; ++n) acc[a][b][m][n] = (f32x4){0.f, 0.f, 0.f, 0.f};
        cur = nxt; cA = nA; cB = nB; ++ui;
        if constexpr (ALIGN_EPI) { if (wr == 1) PG8_BAR; }
    }
    PG8_WAIT_V(0);
    if constexpr (!ALIGN_EPI) { if (wr == 0) PG8_BAR; }
    PG8_BAR;
    if constexpr (Epi::AFTER_DRAIN) { E.fused(acc, cur, wr, wc, fr, fq, lds, wid, lane); S.done(cur); }
#undef PG8_SA
#undef PG8_SB
#undef PG8_STAGE
#undef PG8_LDA
#undef PG8_LDB
#undef PG8_MMA
#undef PG8_WAIT_V
#undef PG8_WAIT_L
#undef PG8_BAR
#undef PG8_SCHED
}
}

namespace att {
using bf16x8 = __attribute__((ext_vector_type(8))) short;
using s16x4  = __attribute__((ext_vector_type(4))) short;
using f32x16 = __attribute__((ext_vector_type(16))) float;
using f32x4  = __attribute__((ext_vector_type(4))) float;
using u32x4  = __attribute__((ext_vector_type(4))) unsigned;
typedef unsigned short bf16_t;
typedef __attribute__((address_space(3))) char LCH;
typedef __attribute__((address_space(3))) float LFL;
constexpr int NW = 8, QBLK = 32, KVBLK = 64, DQK = 96, DV = 64, SEQ = 2048, MROWS = 49152;
constexpr float SCALE = 0.10206207261596577f;
constexpr float THR = 8.f;
constexpr int KROW = 208;
constexpr int SHM_V = KVBLK * DV * 2, SHM_K = KVBLK * KROW, SHM_ATTN = 2 * SHM_V + 2 * SHM_K + NW * 64 * 4;
#define SBAR() __builtin_amdgcn_sched_barrier(0)
__device__ __forceinline__ int crow(int r, int hi) { return (r & 3) + 8 * (r >> 2) + 4 * hi; }
__device__ __forceinline__ unsigned cvtpk(float lo, float hi) { unsigned r; asm volatile("v_cvt_pk_bf16_f32 %0, %1, %2" : "=v"(r) : "v"(lo), "v"(hi)); return r; }
__device__ __forceinline__ float bflo(unsigned w) { return __uint_as_float(w << 16); }
__device__ __forceinline__ float bfhi(unsigned w) { return __uint_as_float(w & 0xffff0000u); }

__device__ __forceinline__ void partialSM(f32x16& p0, f32x16& p1, float& m_reg, float& mn, float& alpha) {
  constexpr float C = SCALE * 1.4426950408889634f;
  float pmax = p0[0];
#pragma unroll
  for (int r = 1; r < 16; ++r) pmax = fmaxf(pmax, p0[r]);
#pragma unroll
  for (int r = 0; r < 16; ++r) pmax = fmaxf(pmax, p1[r]);
  { auto rr = __builtin_amdgcn_permlane32_swap(__float_as_uint(pmax), __float_as_uint(pmax), false, false);
    pmax = fmaxf(__uint_as_float(rr[0]), __uint_as_float(rr[1])); }
  if (__builtin_expect(__all(pmax - m_reg <= THR / SCALE), 1)) { mn = m_reg; alpha = 1.f; }
  else { mn = fmaxf(m_reg, pmax); alpha = __builtin_amdgcn_exp2f((m_reg - mn) * C); m_reg = mn; }
  const float mnC = -mn * C;
#pragma unroll
  for (int r = 0; r < 16; ++r) p0[r] = fmaf(p0[r], C, mnC);
#pragma unroll
  for (int r = 0; r < 16; ++r) p1[r] = fmaf(p1[r], C, mnC);
#pragma unroll
  for (int r = 0; r < 16; ++r) p0[r] = __builtin_amdgcn_exp2f(p0[r]);
}
__device__ __forceinline__ void finishSM(f32x16& p0, f32x16& p1, float alpha, float& l_reg, bf16x8& pa0, bf16x8& pa1, bf16x8& pa2, bf16x8& pa3) {
#pragma unroll
  for (int r = 0; r < 16; ++r) p1[r] = __builtin_amdgcn_exp2f(p1[r]);
  float ps = 0;
#pragma unroll
  for (int r = 0; r < 16; ++r) ps += p0[r];
#pragma unroll
  for (int r = 0; r < 16; ++r) ps += p1[r];
  { auto rr = __builtin_amdgcn_permlane32_swap(__float_as_uint(ps), __float_as_uint(ps), false, false);
    ps = __uint_as_float(rr[0]) + __uint_as_float(rr[1]); }
  l_reg = l_reg * alpha + ps;
#define PK4(P, BASE, OUT) do { unsigned a0 = cvtpk(P[BASE + 0], P[BASE + 1]), a1 = cvtpk(P[BASE + 2], P[BASE + 3]);   \
    unsigned b0 = cvtpk(P[BASE + 4], P[BASE + 5]), b1 = cvtpk(P[BASE + 6], P[BASE + 7]);                              \
    auto r0 = __builtin_amdgcn_permlane32_swap(a0, b0, false, false); auto r1 = __builtin_amdgcn_permlane32_swap(a1, b1, false, false); \
    u32x4 w = {r0[0], r1[0], r0[1], r1[1]}; OUT = *reinterpret_cast<bf16x8*>(&w); } while (0)
  PK4(p0, 0, pa0); PK4(p0, 8, pa1); PK4(p1, 0, pa2); PK4(p1, 8, pa3);
#undef PK4
}
__device__ __forceinline__ void qkt(f32x16& p0, f32x16& p1, const LCH* Ks, const bf16x8* qr, int r32, int hi) {
  p0 = f32x16{}; p1 = f32x16{};
#pragma unroll
  for (int d0 = 0; d0 < 6; ++d0) { const int cb = (d0 * 16 + hi * 8) * 2;
    const bf16x8 b0 = *(const __attribute__((address_space(3))) bf16x8*)(Ks + r32 * KROW + cb);
    const bf16x8 b1 = *(const __attribute__((address_space(3))) bf16x8*)(Ks + (32 + r32) * KROW + cb);
    p0 = __builtin_amdgcn_mfma_f32_32x32x16_bf16(b0, qr[d0], p0, 0, 0, 0);
    p1 = __builtin_amdgcn_mfma_f32_32x32x16_bf16(b1, qr[d0], p1, 0, 0, 0); }
}
__device__ __forceinline__ int v_st(int k, int c) { const int kk = (k & ~0xC) | ((k & 4) << 1) | ((k & 8) >> 1); return ((kk >> 3) * 2 + (c >> 5)) * 512 + ((kk & 7) * 32 + (c & 31)) * 2; }
__device__ __forceinline__ int v_rd_base(int lane) { return ((lane & 3) << 3) | (((lane >> 2) & 3) << 6) | (((lane >> 4) & 1) << 5) | (((lane >> 5) & 1) << 8); }
constexpr int v_rd_off(int d0, int ks, int half) { return d0 * 512 + ks * 2048 + half * 1024; }
template <int OFF> __device__ __forceinline__ s16x4 tr_read(int vb) { s16x4 r; asm volatile("ds_read_b64_tr_b16 %0, %1 offset:%2" : "=&v"(r) : "v"(vb), "i"(OFF) : "memory"); return r; }
template <int D0> __device__ __forceinline__ void pv_one(f32x16& od, int vb, bf16x8 pa0, bf16x8 pa1, bf16x8 pa2, bf16x8 pa3) {
  const s16x4 l0 = tr_read<v_rd_off(D0, 0, 0)>(vb), h0 = tr_read<v_rd_off(D0, 0, 1)>(vb), l1 = tr_read<v_rd_off(D0, 1, 0)>(vb), h1 = tr_read<v_rd_off(D0, 1, 1)>(vb);
  const s16x4 l2 = tr_read<v_rd_off(D0, 2, 0)>(vb), h2 = tr_read<v_rd_off(D0, 2, 1)>(vb), l3 = tr_read<v_rd_off(D0, 3, 0)>(vb), h3 = tr_read<v_rd_off(D0, 3, 1)>(vb);
  asm volatile("s_waitcnt lgkmcnt(0)" ::: "memory"); SBAR();
#define PK(L, H) (bf16x8){L[0], L[1], L[2], L[3], H[0], H[1], H[2], H[3]}
  od = __builtin_amdgcn_mfma_f32_32x32x16_bf16(pa0, PK(l0, h0), od, 0, 0, 0);
  od = __builtin_amdgcn_mfma_f32_32x32x16_bf16(pa1, PK(l1, h1), od, 0, 0, 0);
  od = __builtin_amdgcn_mfma_f32_32x32x16_bf16(pa2, PK(l2, h2), od, 0, 0, 0);
  od = __builtin_amdgcn_mfma_f32_32x32x16_bf16(pa3, PK(l3, h3), od, 0, 0, 0);
#undef PK
}
__device__ __forceinline__ void pv_d0(f32x16* o, int vb, bf16x8 pa0, bf16x8 pa1, bf16x8 pa2, bf16x8 pa3) {
  pv_one<0>(o[0], vb, pa0, pa1, pa2, pa3); pv_one<1>(o[1], vb, pa0, pa1, pa2, pa3);
}
struct AttnArgs { const bf16_t* Q; const bf16_t* K; const bf16_t* V; const float* hss; const float* qn_g; const float* tab; bf16_t* Y; };
__device__ __forceinline__ void attn_unit(const AttnArgs& A, int b, int h, int q0, LCH* lds) {
  const int tid = threadIdx.x, wid = tid >> 6, lane = tid & 63, r32 = lane & 31, hi = lane >> 5;
  LCH* V_lds = lds; LCH* K_lds = lds + 2 * SHM_V;
  LFL* ws = (LFL*)(lds + 2 * SHM_V + 2 * SHM_K) + wid * 64; LFL* li_l = ws; LFL* al_l = ws + 32;
  const bf16_t* Kh = A.K + (size_t)(b * 8 + h) * SEQ * DQK; const bf16_t* Vh = A.V + (size_t)(b * 8 + h) * SEQ * DV;
  float m_reg = -1e30f, l_reg = 0; f32x16 o[2] = {}; bf16x8 qr[6];
  {
    const int t = q0 + wid * QBLK + r32; const size_t mrow = (size_t)b * SEQ + t;
    const bf16_t* Qw = A.Q + ((size_t)(b * 8 + h) * SEQ + t) * DQK + hi * 8;
    const float sq = 1.0f / sqrtf(A.hss[(size_t)h * MROWS + mrow] * (1.0f / 96.0f) + 1e-6f);
#pragma unroll
    for (int d0 = 0; d0 < 4; ++d0) {
      const u32x4 w = *reinterpret_cast<const u32x4*>(Qw + d0 * 16);
      const f32x4 g0 = *reinterpret_cast<const f32x4*>(A.qn_g + d0 * 16 + hi * 8), g1 = *reinterpret_cast<const f32x4*>(A.qn_g + d0 * 16 + hi * 8 + 4);
      u32x4 o4; o4.x = cvtpk(bflo(w.x) * g0[0] * sq, bfhi(w.x) * g0[1] * sq); o4.y = cvtpk(bflo(w.y) * g0[2] * sq, bfhi(w.y) * g0[3] * sq);
      o4.z = cvtpk(bflo(w.z) * g1[0] * sq, bfhi(w.z) * g1[1] * sq); o4.w = cvtpk(bflo(w.w) * g1[2] * sq, bfhi(w.w) * g1[3] * sq);
      qr[d0] = *reinterpret_cast<bf16x8*>(&o4);
    }
#pragma unroll
    for (int d0 = 4; d0 < 6; ++d0) {
      const u32x4 w = *reinterpret_cast<const u32x4*>(Qw + d0 * 16);
      const int i0 = 8 * (d0 - 4) + 4 * hi;
      const f32x4 g1 = *reinterpret_cast<const f32x4*>(A.qn_g + 64 + i0), g2 = *reinterpret_cast<const f32x4*>(A.qn_g + 80 + i0);
      const float* tb = A.tab + ((size_t)t * 16 + i0) * 2; const f32x4 cs0 = *reinterpret_cast<const f32x4*>(tb), cs1 = *reinterpret_cast<const f32x4*>(tb + 4);
      const unsigned ww[4] = {w.x, w.y, w.z, w.w}; const float cc[4] = {cs0[0], cs0[2], cs1[0], cs1[2]}, sn[4] = {cs0[1], cs0[3], cs1[1], cs1[3]};
      unsigned ow[4];
#pragma unroll
      for (int jj = 0; jj < 4; ++jj) { const float a = bflo(ww[jj]) * g1[jj] * sq, bb = bfhi(ww[jj]) * g2[jj] * sq; ow[jj] = cvtpk(a * cc[jj] - bb * sn[jj], a * sn[jj] + bb * cc[jj]); }
      u32x4 o4 = {ow[0], ow[1], ow[2], ow[3]}; qr[d0] = *reinterpret_cast<bf16x8*>(&o4);
    }
  }
  const int kc0 = tid, kc1 = tid < 256 ? tid + 512 : tid; const bool k2 = tid < 256;
  const int kr0 = kc0 / 12, kch0 = kc0 - 12 * kr0, kr1 = kc1 / 12, kch1 = kc1 - 12 * kr1;
  const int kg0 = kr0 * DQK + kch0 * 8, kg1 = kr1 * DQK + kch1 * 8, kl0 = kr0 * KROW + kch0 * 16, kl1 = kr1 * KROW + kch1 * 16;
  const int vk = tid >> 3, vc = (tid & 7) * 8, vg = vk * DV + vc, vl = v_st(vk, vc);
  const int vb0 = (int)(unsigned)(uintptr_t)V_lds + v_rd_base(lane);
  struct { bf16x8 v, k0, k1; } sr_[2];
#define SLOAD(i, key0) do { sr_[i].v = *reinterpret_cast<const bf16x8*>(Vh + (size_t)(key0) * DV + vg); sr_[i].k0 = *reinterpret_cast<const bf16x8*>(Kh + (size_t)(key0) * DQK + kg0); \
    sr_[i].k1 = *reinterpret_cast<const bf16x8*>(Kh + (size_t)(key0) * DQK + kg1); } while (0)
#define SWRITE(bf, i) do { *(__attribute__((address_space(3))) bf16x8*)(V_lds + (bf) * SHM_V + vl) = sr_[i].v; *(__attribute__((address_space(3))) bf16x8*)(K_lds + (bf) * SHM_K + kl0) = sr_[i].k0; if (k2) *(__attribute__((address_space(3))) bf16x8*)(K_lds + (bf) * SHM_K + kl1) = sr_[i].k1; } while (0)
#define SWAIT() asm volatile("s_waitcnt vmcnt(3)" ::: "memory")
#define RESC(a) do { if (__any((a) < 1.f)) { if (hi == 0) al_l[r32] = (a); asm volatile("s_waitcnt lgkmcnt(0)" ::: "memory"); \
    _Pragma("unroll") for (int d = 0; d < 2; ++d) _Pragma("unroll") for (int r = 0; r < 16; ++r) o[d][r] *= al_l[crow(r, hi)]; } } while (0)
  f32x16 pA0, pA1, pB0, pB1; float mnA, mnB, alA, alB; bf16x8 pa0, pa1, pa2, pa3; constexpr int NT = SEQ / KVBLK;
  constexpr int SE = 0, SO = 1;
  SLOAD(SE, 0); asm volatile("s_waitcnt vmcnt(0)" ::: "memory"); SWRITE(0, SE); __syncthreads();
  qkt(pA0, pA1, K_lds, qr, r32, hi); partialSM(pA0, pA1, m_reg, mnA, alA);
  SLOAD(SO, KVBLK); SLOAD(SE, 2 * KVBLK);
  SWAIT(); SWRITE(1, SO); __syncthreads();
  for (int j = 1; j + 1 < NT; j += 2) {
    SBAR(); qkt(pB0, pB1, K_lds + SHM_K, qr, r32, hi);
    finishSM(pA0, pA1, alA, l_reg, pa0, pa1, pa2, pa3); SBAR();
    SLOAD(SO, (j + 2) * KVBLK); SBAR();
    pv_d0(o, vb0, pa0, pa1, pa2, pa3); partialSM(pB0, pB1, m_reg, mnB, alB);
    __syncthreads(); SWAIT(); SWRITE(0, SE);
    RESC(alB); __syncthreads();
    SBAR(); qkt(pA0, pA1, K_lds, qr, r32, hi);
    finishSM(pB0, pB1, alB, l_reg, pa0, pa1, pa2, pa3); SBAR();
    if (j + 3 < NT) SLOAD(SE, (j + 3) * KVBLK); SBAR();
    pv_d0(o, vb0 + SHM_V, pa0, pa1, pa2, pa3); partialSM(pA0, pA1, m_reg, mnA, alA);
    __syncthreads(); SWAIT(); SWRITE(1, SO);
    RESC(alA); __syncthreads();
  }
  SBAR(); qkt(pB0, pB1, K_lds + SHM_K, qr, r32, hi);
  finishSM(pA0, pA1, alA, l_reg, pa0, pa1, pa2, pa3); SBAR();
  pv_d0(o, vb0, pa0, pa1, pa2, pa3); partialSM(pB0, pB1, m_reg, mnB, alB);
  __syncthreads(); RESC(alB);
  finishSM(pB0, pB1, alB, l_reg, pa0, pa1, pa2, pa3); SBAR();
  pv_d0(o, vb0 + SHM_V, pa0, pa1, pa2, pa3);
  if (hi == 0) li_l[r32] = l_reg; asm volatile("s_waitcnt lgkmcnt(0)" ::: "memory");
  float rli[16];
#pragma unroll
  for (int r = 0; r < 16; ++r) rli[r] = __builtin_amdgcn_rcpf(li_l[crow(r, hi)]);
  bf16_t* Yw = A.Y + ((size_t)b * SEQ + q0 + wid * QBLK) * 1024 + 512 + h * DV;
#pragma unroll
  for (int r = 0; r < 16; ++r) { const int orow = crow(r, hi);
#pragma unroll
    for (int d0 = 0; d0 < 2; ++d0) { const unsigned pk = cvtpk(o[d0][r] * rli[r], 0.f); Yw[(size_t)orow * 1024 + d0 * 32 + r32] = (bf16_t)(pk & 0xffffu); } }
  __syncthreads();
#undef SLOAD
#undef SWRITE
#undef SWAIT
#undef RESC
}
#undef SBAR
}

constexpr int NWAVES = 8;
constexpr int M = 49152, DM = 1024, SEQL = 2048, MPR = 32768, NPH = 9;
constexpr size_t MiB = 1u << 20;
constexpr size_t WS_CTL = 0, CTL_ZERO_BYTES = 1 * MiB;
constexpr size_t WS_TAB = 1 * MiB;
constexpr size_t WS_SSZ = 2 * MiB, SSZ_BYTES = 13 * (size_t)M * 4;
constexpr size_t WS_SS1 = 5 * MiB;
constexpr size_t WS_KRR = 6 * MiB;
constexpr size_t WS_WIN = 12 * MiB, WS_WQB = WS_WIN + 1280 * 1024 * 2, WS_WKVB = WS_WQB + 768 * 384 * 2, WS_WO = 16 * MiB, WS_WGU = 18 * MiB, WS_WD = 29 * MiB, WS_WPG = 35 * MiB, WS_WPP = 37 * MiB;
constexpr size_t WS_PB = 40 * MiB;
constexpr size_t WS_Z = 64 * MiB;
constexpr size_t WS_XB = 184 * MiB;
constexpr size_t WS_Q = 184 * MiB, WS_K = 256 * MiB, WS_V = 328 * MiB, WS_Y = 376 * MiB;
constexpr size_t WS_HB = 64 * MiB;
constexpr size_t WS_ACT = 184 * MiB;
constexpr size_t WS_PROJ = 184 * MiB;
constexpr size_t WS_END = 472 * MiB;
static_assert(WS_WKVB + 1024 * 256 * 2 <= WS_WO && WS_WGU + (size_t)5632 * 1024 * 2 <= WS_WD && WS_WD + (size_t)1024 * 2816 * 2 <= WS_WPG && WS_WPP + 1024 * 256 * 2 <= WS_PB, "weight map");
static_assert(WS_SSZ + SSZ_BYTES <= WS_SS1 && WS_SS1 + 2 * (size_t)M * 4 <= WS_KRR && WS_KRR + (size_t)M * 32 * 4 <= WS_WIN, "small arrays map");
constexpr int CW_TMO = 0, CW_BAR = 4096;
constexpr int RING_OFF = 0, RING_BYTES = 131072, LDSCTL_OFF = RING_BYTES, MISC_OFF = LDSCTL_OFF + 320, LDS_BYTES = 147456;

#define GAS __attribute__((address_space(1)))
#define LAS __attribute__((address_space(3)))
typedef unsigned short bf16;
typedef unsigned v4u __attribute__((ext_vector_type(4)));
typedef float f32x4 __attribute__((ext_vector_type(4)));
typedef GAS unsigned gu32;
#define RLX_AGENT __ATOMIC_RELAXED, __HIP_MEMORY_SCOPE_AGENT
#define LDS_WAIT() asm volatile("s_waitcnt lgkmcnt(0)" ::: "memory")
#define VM_WAIT() asm volatile("s_waitcnt vmcnt(0)" ::: "memory")
__device__ __forceinline__ unsigned f2bf(float f) { unsigned u = __builtin_bit_cast(unsigned, f); return (u + 0x7fffu + ((u >> 16) & 1u)) >> 16; }
__device__ __forceinline__ unsigned pk2(float lo, float hi) { return f2bf(lo) | (f2bf(hi) << 16); }

#define XB_TMO      128
#define XB_XCNT(j)  (256  + 64 * (j))
#define XB_XSUB(j)  (1280 + 64 * (j))
#define XB_XGEN(j)  (2304 + 64 * (j))
#define XB_TOP      3328
#define XB_TOPGEN   3392
#define XCD_BAR_WORDS 3456
#define XB_SPIN_CAP (1u << 18)

__device__ __forceinline__ unsigned xb_ld(unsigned* p)              { return __hip_atomic_load(p, __ATOMIC_RELAXED, __HIP_MEMORY_SCOPE_AGENT); }
__device__ __forceinline__ unsigned xb_add(unsigned* p, unsigned v) { return __hip_atomic_fetch_add(p, v, __ATOMIC_RELAXED, __HIP_MEMORY_SCOPE_AGENT); }
__device__ __forceinline__ unsigned xb_xcc_id() { return (unsigned)__builtin_amdgcn_s_getreg((3 << 11) | 20) & 0xFu; }
#define XB_SPIN(cond, bar) do { unsigned _sp = 0; while (cond) { __builtin_amdgcn_s_sleep(1); \
    if ((++_sp & 255u) == 0u) { if (xb_ld(&(bar)[XB_TMO])) break; if (_sp > XB_SPIN_CAP) { atomicAdd(&(bar)[XB_TMO], 1u); break; } } } } while (0)

struct XcdBarrier {
    unsigned* bar; unsigned x;
    volatile LAS unsigned* st;
};

__device__ __forceinline__ XcdBarrier xcd_barrier_post(unsigned* bar, volatile LAS unsigned* st) {
    XcdBarrier b; b.bar = bar; b.x = xb_xcc_id(); b.st = st;
    if (threadIdx.x == 0) (void)xb_add(&bar[XB_XCNT(b.x)], 1u);
    return b;
}
__device__ __forceinline__ void xcd_barrier_complete(unsigned* bar, unsigned x, unsigned& nloc, unsigned& nx) {
    const unsigned G = gridDim.x * gridDim.y * gridDim.z;
    unsigned sum, cnt, mine, sp = 0u;
    for (;;) {
        sum = 0u; cnt = 0u; mine = 0u;
#pragma unroll
        for (unsigned j = 0; j < 16; ++j) { const unsigned c = xb_ld(&bar[XB_XCNT(j)]); sum += c; cnt += (c > 0u) ? 1u : 0u; mine = (j == x) ? c : mine; }
        if (sum == G) break;
        __builtin_amdgcn_s_sleep(1);
        if ((++sp & 255u) == 0u) { if (xb_ld(&bar[XB_TMO])) break; if (sp > XB_SPIN_CAP) { atomicAdd(&bar[XB_TMO], 1u); break; } }
    }
    nloc = mine > 0u ? mine : 1u; nx = cnt > 0u ? cnt : 1u;
}

__device__ __forceinline__ void xcd_barrier(const XcdBarrier& b) {
    asm volatile("s_waitcnt vmcnt(0)" ::: "memory");
    __syncthreads();
    if (threadIdx.x == 0) {
        unsigned* bar = b.bar;
        __builtin_amdgcn_s_waitcnt(0);
        unsigned nloc = b.st[0], nx = b.st[1];
        if (nloc == 0u) { xcd_barrier_complete(bar, b.x, nloc, nx); b.st[0] = nloc; b.st[1] = nx; }
        const unsigned old = xb_add(&bar[XB_XSUB(b.x)], 1u);
        const unsigned gen = old / nloc;
        if (old + 1u == (gen + 1u) * nloc) {
            __builtin_amdgcn_fence(__ATOMIC_RELEASE, "agent");
            asm volatile("s_waitcnt vmcnt(0)" ::: "memory");
            const unsigned og = xb_add(&bar[XB_TOP], 1u);
            const unsigned tg = og / nx;
            if (og + 1u == (tg + 1u) * nx) xb_add(&bar[XB_TOPGEN], 1u);
            else XB_SPIN(xb_ld(&bar[XB_TOPGEN]) == tg, bar);
            __builtin_amdgcn_fence(__ATOMIC_ACQUIRE, "agent");
            xb_add(&bar[XB_XGEN(b.x)], 1u);
            asm volatile("s_waitcnt vmcnt(0)" ::: "memory");
        } else {
            XB_SPIN(xb_ld(&bar[XB_XGEN(b.x)]) == gen, bar);
            __builtin_amdgcn_fence(__ATOMIC_ACQUIRE, "agent");
            asm volatile("s_waitcnt vmcnt(0)" ::: "memory");
        }
    }
    __syncthreads();
}


struct Frame {
    LAS unsigned char* lds; volatile LAS unsigned* MISC; gu32* ctl;
    int tid, lane, wave, vcu, G;
};
struct Args { const float* in[22]; float* out; unsigned char* ws; int ph_lo, ph_hi; };

__device__ __forceinline__ float wave_sum(float v) {
#pragma unroll
    for (int o = 1; o < 64; o <<= 1) v += __shfl_xor(v, o);
    return v;
}
enum { MAP_ID = 0, MAP_IN = 1, MAP_QB = 2, MAP_KVB = 3, MAP_GU = 4 };
__device__ __forceinline__ int map_col(int map, int n) {
    if (map == MAP_IN) { if (n < 896) return n; if (n < 928) { const int i = n - 896, pr = i >> 1; return 1152 + ((i & 1) ? 16 + pr : pr); } if (n < 1024) return -1; return 896 + (n - 1024); }
    if (map == MAP_QB) { const int slab = n >> 5, c = n & 31, head = slab / 3, part = slab - 3 * head; const int lg = part < 2 ? part * 32 + c : 64 + ((c & 1) ? 16 + (c >> 1) : (c >> 1)); return head * 96 + lg; }
    if (map == MAP_KVB) { const int t = n >> 8, r = n & 255, bj = r >> 7, wc = (r >> 5) & 3, c = r & 31; return (2 * t + (wc & 1)) * 128 + (wc >> 1) * 64 + bj * 32 + c; }
    if (map == MAP_GU) { const int pn = n >> 8, r = n & 255; return ((r >> 7) ? 2816 : 0) + pn * 128 + (r & 127); }
    return n;
}
__device__ __forceinline__ void p0_transpose_item(const float* W, const float* W2, int ldw, const float* gain, bf16* WT, int ldt, int kdst0, int nblk, int map, LAS float* scr, int item, int lane) {
    const int kb = item / nblk, nb = item - kb * nblk, k0 = 64 * kb, n0 = 32 * nb;
    int col = map_col(map, n0 + (lane & 31)); const float* src = W; if (map == MAP_GU && col >= 2816) { col -= 2816; src = W2; }
#pragma unroll 8
    for (int i = 0; i < 32; ++i) { const int kk = 2 * i + (lane >> 5); float v = col >= 0 ? src[(size_t)(k0 + kk) * ldw + col] : 0.f; if (gain) v *= gain[k0 + kk]; scr[kk * 33 + (lane & 31)] = v; }
    LDS_WAIT(); asm volatile("" ::: "memory");
    const int c = lane & 7;
#pragma unroll
    for (int j = 0; j < 4; ++j) { const int n = (lane >> 3) + 8 * j; const LAS float* s = scr + (8 * c) * 33 + n;
        v4u o; o.x = pk2(s[0 * 33], s[1 * 33]); o.y = pk2(s[2 * 33], s[3 * 33]); o.z = pk2(s[4 * 33], s[5 * 33]); o.w = pk2(s[6 * 33], s[7 * 33]);
        *(GAS v4u*)(WT + (size_t)(n0 + n) * ldt + kdst0 + k0 + 8 * c) = o; }
    LDS_WAIT(); asm volatile("" ::: "memory");
}
__device__ __forceinline__ void p0_prologue(Frame& F, const Args& a) {
    unsigned char* ws = a.ws;
    LAS float* scr = (LAS float*)(F.lds + RING_OFF + F.wave * 16384);
    const int gw = F.vcu * NWAVES + F.wave, NGW = F.G * NWAVES;
    const int gt = F.vcu * (NWAVES * 64) + F.tid, NGT = F.G * NWAVES * 64;
    { v4u* zp = (v4u*)(ws + WS_SSZ); const v4u zz = {0u, 0u, 0u, 0u}; for (int i = gt; i < (int)(SSZ_BYTES / 16); i += NGT) zp[i] = zz; }
    { float* tab = (float*)(ws + WS_TAB); for (int i = gt; i < SEQL * 16; i += NGT) { const int t = i >> 4, f = i & 15; const float ang = (float)t * powf(10000.0f, -(float)(2 * f) / 32.0f); tab[2 * i] = cosf(ang); tab[2 * i + 1] = sinf(ang); } }
    {
        const float *ln1 = a.in[4], *w_in = a.in[5], *qan = a.in[8], *w_qb = a.in[9], *kvan = a.in[10], *w_kvb = a.in[11], *w_o = a.in[14], *ln2 = a.in[15], *w_gate = a.in[16], *w_up = a.in[17], *w_down = a.in[18], *plen = a.in[19], *w_pg = a.in[20], *w_pp = a.in[21];
        constexpr int I_IN = (1024 / 64) * (1280 / 32), I_QB = (384 / 64) * (768 / 32), I_KVB = (256 / 64) * (1024 / 32), I_O = (512 / 64) * (1024 / 32), I_GU = (1024 / 64) * (5632 / 32), I_D = (2816 / 64) * (1024 / 32), I_PG = (1024 / 64) * (1024 / 32), I_PP = (256 / 64) * (1024 / 32);
        constexpr int NITEMS = I_IN + I_QB + I_KVB + I_O + I_GU + I_D + I_PG + I_PP;
        for (int it = gw; it < NITEMS; it += NGW) {
            int r = it;
            if (r < I_IN) { p0_transpose_item(w_in, nullptr, 1184, ln1, (bf16*)(ws + WS_WIN), 1024, 0, 1280 / 32, MAP_IN, scr, r, F.lane); continue; } r -= I_IN;
            if (r < I_QB) { p0_transpose_item(w_qb, nullptr, 768, qan, (bf16*)(ws + WS_WQB), 384, 0, 768 / 32, MAP_QB, scr, r, F.lane); continue; } r -= I_QB;
            if (r < I_KVB) { p0_transpose_item(w_kvb, nullptr, 1024, kvan, (bf16*)(ws + WS_WKVB), 256, 0, 1024 / 32, MAP_KVB, scr, r, F.lane); continue; } r -= I_KVB;
            if (r < I_O) { p0_transpose_item(w_o + (size_t)512 * 1024, nullptr, 1024, nullptr, (bf16*)(ws + WS_WO), 1024, 512, 1024 / 32, MAP_ID, scr, r, F.lane); continue; } r -= I_O;
            if (r < I_GU) { p0_transpose_item(w_gate, w_up, 2816, ln2, (bf16*)(ws + WS_WGU), 1024, 0, 5632 / 32, MAP_GU, scr, r, F.lane); continue; } r -= I_GU;
            if (r < I_D) { p0_transpose_item(w_down, nullptr, 1024, nullptr, (bf16*)(ws + WS_WD), 2816, 0, 1024 / 32, MAP_ID, scr, r, F.lane); continue; } r -= I_D;
            if (r < I_PG) { p0_transpose_item(w_pg, nullptr, 1024, plen, (bf16*)(ws + WS_WPG), 1024, 0, 1024 / 32, MAP_ID, scr, r, F.lane); continue; } r -= I_PG;
            p0_transpose_item(w_pp, nullptr, 1024, nullptr, (bf16*)(ws + WS_WPP), 256, 0, 1024 / 32, MAP_ID, scr, r, F.lane);
        }
    }
    {
        const float *w_pool = a.in[6], *psc = a.in[7], *w_o = a.in[14]; bf16* WO = (bf16*)(ws + WS_WO);
        for (int o = gt; o < 512 * 1024; o += NGT) { const int n = o & 1023, kk = o >> 10, g = kk >> 7; const float* wp = w_pool + (size_t)kk * 128; const float* sc = psc + g * 128; const float* wo = w_o + (size_t)(g * 128) * 1024 + n;
            float acc = 0.f;
#pragma unroll 8
            for (int j = 0; j < 128; ++j) acc = fmaf(wp[j] * sc[j], wo[(size_t)j * 1024], acc);
            WO[(size_t)n * 1024 + kk] = (bf16)f2bf(acc); }
    }
    {
        bf16* XB = (bf16*)(ws + WS_XB); bf16* PB = (bf16*)(ws + WS_PB); float* ss1 = (float*)(ws + WS_SS1);
        for (int m = gw; m < M; m += NGW) {
            const float* xrow = m < MPR ? a.in[0] + (size_t)m * DM : a.in[1] + (size_t)(m - MPR) * DM;
            const float* prow = m < MPR ? a.in[2] + (size_t)m * 256 : a.in[3] + (size_t)(m - MPR) * 256;
            const GAS f32x4* xr = (const GAS f32x4*)xrow + F.lane; f32x4 v[4]; float s = 0.f;
#pragma unroll
            for (int j = 0; j < 4; ++j) { v[j] = xr[64 * j]; s += (v[j].x * v[j].x + v[j].y * v[j].y) + (v[j].z * v[j].z + v[j].w * v[j].w); }
            const f32x4 pv = ((const GAS f32x4*)prow)[F.lane];
            s = wave_sum(s); if (F.lane == 0) ss1[m] = s;
            GAS unsigned long long* o8 = (GAS unsigned long long*)(XB + (size_t)m * DM) + F.lane;
#pragma unroll
            for (int j = 0; j < 4; ++j) o8[64 * j] = (unsigned long long)pk2(v[j].x, v[j].y) | ((unsigned long long)pk2(v[j].z, v[j].w) << 32);
            ((GAS unsigned long long*)(PB + (size_t)m * 256))[F.lane] = (unsigned long long)pk2(pv.x, pv.y) | ((unsigned long long)pk2(pv.z, pv.w) << 32);
        }
    }
}
__device__ __forceinline__ void pool_phase(Frame& F, const bf16* Z, bf16* Y) {
    const int gt = F.vcu * (NWAVES * 64) + F.tid, NGT = F.G * NWAVES * 64;
    for (int idx = gt; idx < M * 64; idx += NGT) {
        const int row = idx >> 6, c8 = idx & 63, t = row & (SEQL - 1), w = 2 << (c8 >> 4);
        int lo = t - (w >> 1), hi = lo + w; lo = lo < 0 ? 0 : lo; hi = hi > SEQL ? SEQL : hi;
        const bf16* zb = Z + (size_t)(row - t) * 1280 + c8 * 8;
        float s[8];
#pragma unroll
        for (int e = 0; e < 8; ++e) s[e] = 0.f;
        for (int j = lo; j < hi; ++j) { const v4u wv = *(const GAS v4u*)(zb + (size_t)j * 1280);
            s[0] += __uint_as_float(wv.x << 16); s[1] += __uint_as_float(wv.x & 0xffff0000u); s[2] += __uint_as_float(wv.y << 16); s[3] += __uint_as_float(wv.y & 0xffff0000u);
            s[4] += __uint_as_float(wv.z << 16); s[5] += __uint_as_float(wv.z & 0xffff0000u); s[6] += __uint_as_float(wv.w << 16); s[7] += __uint_as_float(wv.w & 0xffff0000u); }
        const v4u cv = *(const GAS v4u*)(zb + (size_t)t * 1280); const float inv = 1.0f / (float)(hi - lo);
        v4u o; o.x = pk2(s[0] * inv - __uint_as_float(cv.x << 16), s[1] * inv - __uint_as_float(cv.x & 0xffff0000u)); o.y = pk2(s[2] * inv - __uint_as_float(cv.y << 16), s[3] * inv - __uint_as_float(cv.y & 0xffff0000u));
        o.z = pk2(s[4] * inv - __uint_as_float(cv.z << 16), s[5] * inv - __uint_as_float(cv.z & 0xffff0000u)); o.w = pk2(s[6] * inv - __uint_as_float(cv.w << 16), s[7] * inv - __uint_as_float(cv.w & 0xffff0000u));
        *(GAS v4u*)(Y + (size_t)row * 1024 + c8 * 8) = o;
    }
}

__global__ void __launch_bounds__(NWAVES * 64, 2) mega_fwd(Args args) {
    extern __shared__ __attribute__((aligned(16))) unsigned char lds[];
    Frame F;
    F.lds = (LAS unsigned char*)lds; F.MISC = (volatile LAS unsigned*)(F.lds + MISC_OFF);
    F.tid = threadIdx.x; F.lane = F.tid & 63; F.wave = __builtin_amdgcn_readfirstlane(F.tid >> 6);
    F.G = gridDim.x; { const int bx = blockIdx.x; F.vcu = (F.G % 8 == 0) ? (bx % 8) * (F.G / 8) + bx / 8 : bx; }
    unsigned char* ws = args.ws; F.ctl = (gu32*)(ws + WS_CTL);
    for (int u = F.tid; u < (LDS_BYTES - LDSCTL_OFF) / 4; u += NWAVES * 64) ((LAS unsigned*)(F.lds + LDSCTL_OFF))[u] = 0u;
    __syncthreads();
    XcdBarrier bar = xcd_barrier_post((unsigned*)(F.ctl + CW_BAR), F.MISC + 8);
    const int lo = args.ph_lo, hi = args.ph_hi;
#ifndef PHMASK
#define PHMASK 0x1ff
#endif
#define IN(k) (((PHMASK >> (k)) & 1) && lo <= (k) && (k) < hi)
#define SEAM(k) do { if (IN(k) && IN((k) + 1)) xcd_barrier(bar); } while (0)
    float* ssz = (float*)(ws + WS_SSZ); float *ss_q = ssz, *ss_kv = ssz + M, *ss2 = ssz + 2 * (size_t)M, *ss3 = ssz + 3 * (size_t)M, *hss = ssz + 5 * (size_t)M;
    float* ss1 = (float*)(ws + WS_SS1); float* ss_kr = ss1 + M; float* krr = (float*)(ws + WS_KRR); const float* tab = (const float*)(ws + WS_TAB);
    float* out = args.out;

    if (IN(0)) { p0_prologue(F, args); } SEAM(0);
    if (IN(1)) {
        pg8::Gemm g{(const pg8::bf16_t*)(ws + WS_XB), (const pg8::bf16_t*)(ws + WS_WIN), M, 1280, 1024, 1024}; pg8::StaticOrder S; S.init(M, 1280, F.G, (int)blockIdx.x);
        pg8::EpiIn E{(pg8::bf16_t*)(ws + WS_Z), ss1, ss_q, ss_kv, ss_kr, krr, args.in[13], tab};
        pg8::gemm_phase<pg8::EpiIn, pg8::StaticOrder, true, true>(F.lds + RING_OFF, g, S, E);
    } SEAM(1);
    if (IN(2)) {
#ifndef NOPOOL
        pool_phase(F, (const bf16*)(ws + WS_Z), (bf16*)(ws + WS_Y)); VM_WAIT();
#endif
#ifndef NOQ
        { pg8::Gemm g{(const pg8::bf16_t*)(ws + WS_Z) + 512, (const pg8::bf16_t*)(ws + WS_WQB), M, 768, 384, 1280}; pg8::StaticOrder S; S.init(M, 768, F.G, (int)blockIdx.x);
          pg8::EpiQ E{(pg8::bf16_t*)(ws + WS_Q), ss_q, hss};
          pg8::gemm_phase<pg8::EpiQ, pg8::StaticOrder, true, true>(F.lds + RING_OFF, g, S, E); }
#endif
#ifndef NOKV
        { pg8::Gemm g{(const pg8::bf16_t*)(ws + WS_Z) + 1024, (const pg8::bf16_t*)(ws + WS_WKVB), M, 1024, 256, 1280}; pg8::StaticOrder S; S.init(M, 1024, F.G, (int)blockIdx.x);
          pg8::EpiKV E{(pg8::bf16_t*)(ws + WS_K), (pg8::bf16_t*)(ws + WS_V), ss_kv, ss_kr, krr, args.in[13]};
          pg8::gemm_phase<pg8::EpiKV, pg8::StaticOrder, true, true>(F.lds + RING_OFF, g, S, E); }
#endif
    } SEAM(2);
    if (IN(3)) {
        const att::AttnArgs A{(const att::bf16_t*)(ws + WS_Q), (const att::bf16_t*)(ws + WS_K), (const att::bf16_t*)(ws + WS_V), hss, args.in[12], tab, (att::bf16_t*)(ws + WS_Y)};
        for (int i = 0; i < 6; ++i) { const int u = i * 256 + F.vcu; if (u < 1536) { const int bh = u >> 3, qb = u & 7; att::attn_unit(A, bh >> 3, bh & 7, qb * 256, (att::LCH*)(F.lds + RING_OFF)); } }
    } SEAM(3);
    if (IN(4)) {
        pg8::Gemm g{(const pg8::bf16_t*)(ws + WS_Y), (const pg8::bf16_t*)(ws + WS_WO), M, 1024, 1024, 1024}; pg8::StaticOrder S; S.init(M, 1024, F.G, (int)blockIdx.x);
        pg8::EpiRes E{args.in[0], args.in[1], out, (pg8::bf16_t*)(ws + WS_HB), ss2};
        pg8::gemm_phase<pg8::EpiRes, pg8::StaticOrder, true, true>(F.lds + RING_OFF, g, S, E);
    } SEAM(4);
    if (IN(5)) {
        pg8::Gemm g{(const pg8::bf16_t*)(ws + WS_HB), (const pg8::bf16_t*)(ws + WS_WGU), M, 5632, 1024, 1024}; pg8::StaticOrder S; S.init(M, 5632, F.G, (int)blockIdx.x);
        pg8::EpiSwiglu E{(pg8::bf16_t*)(ws + WS_ACT), ss2};
        pg8::gemm_phase<pg8::EpiSwiglu, pg8::StaticOrder, true, true>(F.lds + RING_OFF, g, S, E);
    } SEAM(5);
    if (IN(6)) {
        pg8::Gemm g{(const pg8::bf16_t*)(ws + WS_ACT), (const pg8::bf16_t*)(ws + WS_WD), M, 1024, 2816, 2816}; pg8::StaticOrder S; S.init(M, 1024, F.G, (int)blockIdx.x);
        pg8::EpiRes E{out, out + (size_t)MPR * DM, out, (pg8::bf16_t*)(ws + WS_HB), ss3};
        pg8::gemm_phase<pg8::EpiRes, pg8::StaticOrder, true, true>(F.lds + RING_OFF, g, S, E);
    } SEAM(6);
    if (IN(7)) {
        pg8::Gemm g{(const pg8::bf16_t*)(ws + WS_PB), (const pg8::bf16_t*)(ws + WS_WPP), M, 1024, 256, 256}; pg8::StaticOrder S; S.init(M, 1024, F.G, (int)blockIdx.x);
        pg8::EpiStore E{(pg8::bf16_t*)(ws + WS_PROJ)};
        pg8::gemm_phase<pg8::EpiStore, pg8::StaticOrder, true, true>(F.lds + RING_OFF, g, S, E);
    } SEAM(7);
    if (IN(8)) {
        pg8::Gemm g{(const pg8::bf16_t*)(ws + WS_HB), (const pg8::bf16_t*)(ws + WS_WPG), M, 1024, 1024, 1024}; pg8::StaticOrder S; S.init(M, 1024, F.G, (int)blockIdx.x);
        pg8::EpiFinal E{out, (const pg8::bf16_t*)(ws + WS_PROJ), ss3};
        pg8::gemm_phase<pg8::EpiFinal, pg8::StaticOrder, true, true>(F.lds + RING_OFF, g, S, E);
    }
#undef IN
#undef SEAM
}

static int launch_fast(void* const* d_in, void* d_out, void* d_ws, size_t ws_size, hipStream_t stream, int ph_lo, int ph_hi) {
    static int grid = 0;
    if (grid == 0) {
        if (ws_size < WS_END) { fprintf(stderr, "kernel_launch: workspace too small: %zu < %zu\n", ws_size, (size_t)WS_END); grid = -1; return -1; }
        int dev = 0, cus = 0, per_cu = 0;
        if (hipGetDevice(&dev) != hipSuccess || hipDeviceGetAttribute(&cus, hipDeviceAttributeMultiprocessorCount, dev) != hipSuccess) { grid = -1; return -1; }
        if (hipFuncSetAttribute((const void*)mega_fwd, hipFuncAttributeMaxDynamicSharedMemorySize, LDS_BYTES) != hipSuccess) { fprintf(stderr, "kernel_launch: hipFuncSetAttribute failed\n"); grid = -1; return -1; }
        if (hipOccupancyMaxActiveBlocksPerMultiprocessor(&per_cu, (const void*)mega_fwd, NWAVES * 64, LDS_BYTES) != hipSuccess || per_cu < 1) fprintf(stderr, "kernel_launch: note: occupancy query reports %d\n", per_cu);
        (void)hipGetLastError();
        grid = cus;
    }
    if (grid < 0) return -1;
    if (hipMemsetAsync((char*)d_ws + WS_CTL, 0, CTL_ZERO_BYTES, stream) != hipSuccess) return -1;
    Args a{};
    for (int i = 0; i < 22; ++i) a.in[i] = (const float*)d_in[i];
    a.out = (float*)d_out; a.ws = (unsigned char*)d_ws; a.ph_lo = ph_lo; a.ph_hi = ph_hi;
    hipLaunchKernelGGL(mega_fwd, dim3(grid), dim3(NWAVES * 64), LDS_BYTES, stream, a);
    const hipError_t le = hipPeekAtLastError();
    if (le != hipSuccess) { fprintf(stderr, "kernel_launch: launch failed: %s\n", hipGetErrorName(le)); return -1; }
    return 0;
}

extern "C" void kernel_launch(void* const* d_in, const int* in_sizes, int n_in, void* d_out, int out_size, void* d_ws, size_t ws_size, hipStream_t stream) {
  (void)in_sizes; (void)n_in; (void)out_size;
  launch_fast(d_in, d_out, d_ws, ws_size, stream, 0, NPH);
}
```

```cpp
#include <hip/hip_runtime.h>
#include <cstdio>
#include <cstdint>

namespace pg8 {
#define PG8_LAS __attribute__((address_space(3)))
typedef unsigned short bf16_t;
typedef short bf16x8 __attribute__((ext_vector_type(8)));
typedef float f32x4 __attribute__((ext_vector_type(4)));
typedef unsigned u32x4 __attribute__((ext_vector_type(4)));
constexpr int BM = 256, BK = 64, HALF = 128, HTB = HALF * BK * 2  , STAGE_BYTES = 8 * HTB, NXCD = 8, WGM = 8;

__host__ __device__ __forceinline__ int lds_byte(int r, int c) { const int st = (r >> 4) * 2 + (c >> 5), rr = r & 15, cc = c & 31, ob = rr * 64 + cc * 2; return st * 1024 + (ob ^ (((ob >> 9) & 1) << 5)); }
__host__ __device__ __forceinline__ void stage_rc(int b, int& R, int& C) { const int st = b / 1024, sb = b % 1024, swz = sb ^ (((sb >> 9) & 1) << 5); R = (st >> 1) * 16 + swz / 64; C = (st & 1) * 32 + (swz % 64) / 2; }
__host__ __device__ __forceinline__ int perm32(int rho) { const int n = rho >> 4, i = rho & 15; return 8 * (i >> 2) + 4 * n + (i & 3); }

struct Unit { int pm, pn; };
struct Gemm { const bf16_t* A; const bf16_t* Bt; int M, N, K, lda; };

struct StaticOrder {
    int nM, nN, nwg, G, c;
    __host__ __device__ void init(int M, int N, int G_, int c_) { nM = M / BM; nN = N / BM; nwg = nM * nN; G = G_; c = c_; }
    __host__ __device__ bool next(int i, Unit& u) const {
        const long L = (long)i * G + c; if (L >= nwg) return false;
        int wgid = (int)L; { const int q = nwg / NXCD, r = nwg % NXCD, xcd = wgid % NXCD, off = wgid / NXCD; wgid = (xcd < r ? xcd * (q + 1) : r * (q + 1) + (xcd - r) * q) + off; }
        const int nig = WGM * nN, gid = wgid / nig, fm = gid * WGM, gsz = (nM - fm) < WGM ? (nM - fm) : WGM;
        u.pm = fm + ((wgid % nig) % gsz); u.pn = (wgid % nig) / gsz; return true;
    }
    __device__ __forceinline__ void a_ready(const Unit&) const {}
    __device__ __forceinline__ void done(const Unit&) const {}
};

__device__ __forceinline__ unsigned cvt_pk_bf16(float lo, float hi) { unsigned r; asm volatile("v_cvt_pk_bf16_f32 %0, %1, %2" : "=v"(r) : "v"(lo), "v"(hi)); return r; }
typedef float f32x2 __attribute__((ext_vector_type(2)));

constexpr int MROWS = 49152, SEQ = 2048, MPROMPT = 32768;
constexpr float NEPS = 1e-6f;
__device__ __forceinline__ u32x4 pack8(const f32x4 a, const f32x4 b) { u32x4 w; w.x = cvt_pk_bf16(a[0], a[1]); w.y = cvt_pk_bf16(a[2], a[3]); w.z = cvt_pk_bf16(b[0], b[1]); w.w = cvt_pk_bf16(b[2], b[3]); return w; }
__device__ __forceinline__ float sq8(const f32x4 a, const f32x4 b) { return (a[0] * a[0] + a[1] * a[1]) + (a[2] * a[2] + a[3] * a[3]) + (b[0] * b[0] + b[1] * b[1]) + (b[2] * b[2] + b[3] * b[3]); }
__device__ __forceinline__ float red_fq(float s) { s += __shfl_xor(s, 16); s += __shfl_xor(s, 32); return s; }
__device__ __forceinline__ float bflo(unsigned w) { return __uint_as_float(w << 16); }
__device__ __forceinline__ float bfhi(unsigned w) { return __uint_as_float(w & 0xffff0000u); }
#define EPI_ROWS_BEGIN _Pragma("unroll") for (int ai = 0; ai < 2; ++ai) _Pragma("unroll") for (int m = 0; m < 4; ++m) { int row = u.pm * BM + ai * HALF + wr * 64 + m * 16 + fr; asm volatile("" : "+v"(row) :: "memory");
#define EPI_ROWS_END }

struct EpiIn {
    static constexpr bool PERM = true, AFTER_DRAIN = false;
    bf16_t* z; const float* ss1; float* ss_q; float* ss_kv; float* ss_kr; float* krr; const float* kn_g; const float* tab;
    __device__ __forceinline__ void operator()(const f32x4 (&acc)[2][2][4][2], const Unit& u, int wr, int wc, int fr, int fq) const {
        const int colt = u.pn * BM + wc * 32 + 8 * fq;
        EPI_ROWS_BEGIN
            const float rs = 1.0f / sqrtf(ss1[row] * (1.0f / 1024.0f) + NEPS);
            f32x4 v00 = acc[ai][0][m][0] * rs, v01 = acc[ai][0][m][1] * rs, v10 = acc[ai][1][m][0] * rs, v11 = acc[ai][1][m][1] * rs;
            bf16_t* zr = z + (size_t)row * 1280 + colt;
            if (u.pn != 3) {
                *(u32x4*)(zr) = pack8(v00, v01); *(u32x4*)(zr + HALF) = pack8(v10, v11);
                if (u.pn == 2 || u.pn == 4) { const float s = red_fq(sq8(v00, v01) + sq8(v10, v11)); if (fq == 0) atomicAdd((u.pn == 2 ? ss_q : ss_kv) + row, s); }
            } else {
                *(u32x4*)(zr) = pack8(v00, v01);
                { const float s = red_fq(sq8(v00, v01)); if (fq == 0) atomicAdd(ss_q + row, s); }
                if (wc == 0) {
                    const float s = red_fq(sq8(v10, v11)); if (fq == 0) ss_kr[row] = s;
                    const int t = row & (SEQ - 1); const float* tb = tab + ((size_t)t * 16 + 4 * fq) * 2;
                    const f32x4 cs0 = *(const f32x4*)(tb), cs1 = *(const f32x4*)(tb + 4);
                    const f32x4 g1 = *(const f32x4*)(kn_g + 64 + 4 * fq), g2 = *(const f32x4*)(kn_g + 80 + 4 * fq);
                    f32x4 o0, o1;
                    { const float a = v10[0] * g1[0], b = v10[1] * g2[0]; o0[0] = a * cs0[0] - b * cs0[1]; o0[1] = a * cs0[1] + b * cs0[0]; }
                    { const float a = v10[2] * g1[1], b = v10[3] * g2[1]; o0[2] = a * cs0[2] - b * cs0[3]; o0[3] = a * cs0[3] + b * cs0[2]; }
                    { const float a = v11[0] * g1[2], b = v11[1] * g2[2]; o1[0] = a * cs1[0] - b * cs1[1]; o1[1] = a * cs1[1] + b * cs1[0]; }
                    { const float a = v11[2] * g1[3], b = v11[3] * g2[3]; o1[2] = a * cs1[2] - b * cs1[3]; o1[3] = a * cs1[3] + b * cs1[2]; }
                    float* kr = krr + (size_t)row * 32 + 8 * fq; *(f32x4*)kr = o0; *(f32x4*)(kr + 4) = o1;
                }
            }
        EPI_ROWS_END
    }
};
struct EpiQ {
    static constexpr bool PERM = true, AFTER_DRAIN = false;
    bf16_t* Q; const float* ss_q; float* hss;
    __device__ __forceinline__ void operator()(const f32x4 (&acc)[2][2][4][2], const Unit& u, int wr, int wc, int fr, int fq) const {
        const int s0 = u.pn * 8 + wc, s1 = s0 + 4; const int h0 = s0 / 3, p0 = s0 - 3 * h0, h1 = s1 / 3, p1 = s1 - 3 * h1;
        EPI_ROWS_BEGIN
            const float rs = 1.0f / sqrtf(ss_q[row] * (1.0f / 384.0f) + NEPS);
            const int b = row >> 11, t = row & (SEQ - 1);
            const f32x4 v00 = acc[ai][0][m][0] * rs, v01 = acc[ai][0][m][1] * rs, v10 = acc[ai][1][m][0] * rs, v11 = acc[ai][1][m][1] * rs;
            *(u32x4*)(Q + ((size_t)(b * 8 + h0) * SEQ + t) * 96 + p0 * 32 + 8 * fq) = pack8(v00, v01);
            *(u32x4*)(Q + ((size_t)(b * 8 + h1) * SEQ + t) * 96 + p1 * 32 + 8 * fq) = pack8(v10, v11);
            const float q0 = red_fq(sq8(v00, v01)), q1 = red_fq(sq8(v10, v11));
            if (fq == 0) { atomicAdd(hss + (size_t)h0 * MROWS + row, q0); atomicAdd(hss + (size_t)h1 * MROWS + row, q1); }
        EPI_ROWS_END
    }
};
struct EpiKV {
    static constexpr bool PERM = true, AFTER_DRAIN = false;
    bf16_t* K; bf16_t* V; const float* ss_kv; const float* ss_kr; const float* krr; const float* kn_g;
    __device__ __forceinline__ void operator()(const f32x4 (&acc)[2][2][4][2], const Unit& u, int wr, int wc, int fr, int fq) const {
        const int h = 2 * u.pn + (wc & 1);
        EPI_ROWS_BEGIN
            const float rs = 1.0f / sqrtf(ss_kv[row] * (1.0f / 256.0f) + NEPS);
            const int b = row >> 11, t = row & (SEQ - 1);
            f32x4 v00 = acc[ai][0][m][0] * rs, v01 = acc[ai][0][m][1] * rs, v10 = acc[ai][1][m][0] * rs, v11 = acc[ai][1][m][1] * rs;
            if (wc >= 2) {
                bf16_t* vp = V + ((size_t)(b * 8 + h) * SEQ + t) * 64 + 8 * fq;
                *(u32x4*)(vp) = pack8(v00, v01); *(u32x4*)(vp + 32) = pack8(v10, v11);
            } else {
                const float tot = red_fq(sq8(v00, v01) + sq8(v10, v11));
                const float sk = 1.0f / sqrtf((tot + ss_kr[row]) * (1.0f / 96.0f) + NEPS);
                const f32x4 g00 = *(const f32x4*)(kn_g + 8 * fq), g01 = *(const f32x4*)(kn_g + 8 * fq + 4), g10 = *(const f32x4*)(kn_g + 32 + 8 * fq), g11 = *(const f32x4*)(kn_g + 36 + 8 * fq);
                v00 = v00 * g00 * sk; v01 = v01 * g01 * sk; v10 = v10 * g10 * sk; v11 = v11 * g11 * sk;
                bf16_t* kp = K + ((size_t)(b * 8 + h) * SEQ + t) * 96 + 8 * fq;
                *(u32x4*)(kp) = pack8(v00, v01); *(u32x4*)(kp + 32) = pack8(v10, v11);
                const float* kr = krr + (size_t)row * 32 + 8 * fq; const f32x4 r0 = *(const f32x4*)kr * sk, r1 = *(const f32x4*)(kr + 4) * sk;
                *(u32x4*)(kp + 64) = pack8(r0, r1);
            }
        EPI_ROWS_END
    }
};
struct EpiResX {
    static constexpr bool PERM = true, AFTER_DRAIN = false;
    const float* xa; const float* xb; bf16_t* hb; float* ss;
    __device__ __forceinline__ void operator()(const f32x4 (&acc)[2][2][4][2], const Unit& u, int wr, int wc, int fr, int fq) const {
        const int colt = u.pn * BM + wc * 32 + 8 * fq;
        EPI_ROWS_BEGIN
            const float* br = (row < MPROMPT ? xa + (size_t)row * 1024 : xb + (size_t)(row - MPROMPT) * 1024) + colt;
            float s = 0.f;
#pragma unroll
            for (int bj = 0; bj < 2; ++bj) {
                const f32x4 h0 = *(const f32x4*)(br + bj * HALF) + acc[ai][bj][m][0], h1 = *(const f32x4*)(br + bj * HALF + 4) + acc[ai][bj][m][1];
                *(u32x4*)(hb + (size_t)row * 1024 + colt + bj * HALF) = pack8(h0, h1);
                s += sq8(h0, h1);
            }
            s = red_fq(s); if (fq == 0) atomicAdd(ss + row, s);
        EPI_ROWS_END
    }
};
struct EpiResB {
    static constexpr bool PERM = true, AFTER_DRAIN = false;
    bf16_t* hb; float* ss;
    __device__ __forceinline__ void operator()(const f32x4 (&acc)[2][2][4][2], const Unit& u, int wr, int wc, int fr, int fq) const {
        const int colt = u.pn * BM + wc * 32 + 8 * fq;
        EPI_ROWS_BEGIN
            float s = 0.f;
#pragma unroll
            for (int bj = 0; bj < 2; ++bj) {
                bf16_t* hp = hb + (size_t)row * 1024 + colt + bj * HALF; const u32x4 w = *(const u32x4*)hp;
                const f32x4 b0 = {bflo(w.x), bfhi(w.x), bflo(w.y), bfhi(w.y)}, b1 = {bflo(w.z), bfhi(w.z), bflo(w.w), bfhi(w.w)};
                const f32x4 h0 = b0 + acc[ai][bj][m][0], h1 = b1 + acc[ai][bj][m][1];
                *(u32x4*)hp = pack8(h0, h1);
                s += sq8(h0, h1);
            }
            s = red_fq(s); if (fq == 0) atomicAdd(ss + row, s);
        EPI_ROWS_END
    }
};
struct EpiSwiglu {
    static constexpr bool PERM = true, AFTER_DRAIN = false;
    bf16_t* act; const float* ss2;
    __device__ __forceinline__ void operator()(const f32x4 (&acc)[2][2][4][2], const Unit& u, int wr, int wc, int fr, int fq) const {
        const int colt = u.pn * HALF + wc * 32 + 8 * fq;
        EPI_ROWS_BEGIN
            const float rs = 1.0f / sqrtf(ss2[row] * (1.0f / 1024.0f) + NEPS);
            f32x4 a[2];
#pragma unroll
            for (int n = 0; n < 2; ++n) { const f32x4 g = acc[ai][0][m][n] * rs, w = acc[ai][1][m][n] * rs;
#pragma unroll
                for (int e = 0; e < 4; ++e) a[n][e] = g[e] * __builtin_amdgcn_rcpf(1.0f + __builtin_amdgcn_exp2f(-1.4426950408889634f * g[e])) * w[e]; }
            *(u32x4*)(act + (size_t)row * 2816 + colt) = pack8(a[0], a[1]);
        EPI_ROWS_END
    }
};
struct EpiStore {
    static constexpr bool PERM = true, AFTER_DRAIN = false;
    bf16_t* o;
    __device__ __forceinline__ void operator()(const f32x4 (&acc)[2][2][4][2], const Unit& u, int wr, int wc, int fr, int fq) const {
        const int colt = u.pn * BM + wc * 32 + 8 * fq;
        EPI_ROWS_BEGIN
#pragma unroll
            for (int bj = 0; bj < 2; ++bj) *(u32x4*)(o + (size_t)row * 1024 + colt + bj * HALF) = pack8(acc[ai][bj][m][0], acc[ai][bj][m][1]);
        EPI_ROWS_END
    }
};
struct EpiFinal {
    static constexpr bool PERM = true, AFTER_DRAIN = false;
    float* out; const bf16_t* hb; const bf16_t* proj; const float* ss3;
    __device__ __forceinline__ void operator()(const f32x4 (&acc)[2][2][4][2], const Unit& u, int wr, int wc, int fr, int fq) const {
        const int colt = u.pn * BM + wc * 32 + 8 * fq;
        EPI_ROWS_BEGIN
            const float rs = 1.0f / sqrtf(ss3[row] * (1.0f / 1024.0f) + NEPS);
#pragma unroll
            for (int bj = 0; bj < 2; ++bj) {
                const size_t off = (size_t)row * 1024 + colt + bj * HALF;
                const u32x4 pj = *(const u32x4*)(proj + off), hw = *(const u32x4*)(hb + off);
                f32x4 h0 = {bflo(hw.x), bfhi(hw.x), bflo(hw.y), bfhi(hw.y)}, h1 = {bflo(hw.z), bfhi(hw.z), bflo(hw.w), bfhi(hw.w)};
                const float pf[8] = {bflo(pj.x), bfhi(pj.x), bflo(pj.y), bfhi(pj.y), bflo(pj.z), bfhi(pj.z), bflo(pj.w), bfhi(pj.w)};
#pragma unroll
                for (int e = 0; e < 4; ++e) { const float g0 = acc[ai][bj][m][0][e] * rs, g1 = acc[ai][bj][m][1][e] * rs;
                    h0[e] += pf[e] * __builtin_amdgcn_rcpf(1.0f + __builtin_amdgcn_exp2f(-1.4426950408889634f * g0));
                    h1[e] += pf[4 + e] * __builtin_amdgcn_rcpf(1.0f + __builtin_amdgcn_exp2f(-1.4426950408889634f * g1)); }
                float* o = out + off; *(f32x4*)o = h0; *(f32x4*)(o + 4) = h1;
            }
        EPI_ROWS_END
    }
};

template <class Epi, class Sched, bool ALIGN_EPI = false, bool SP2 = false>
__device__ __forceinline__ void gemm_phase(PG8_LAS unsigned char* lds, const Gemm g, const Sched& S, const Epi& E) {
    const int tid = threadIdx.x, wid = __builtin_amdgcn_readfirstlane(tid >> 6), lane = tid & 63, wr = wid >> 2, wc = wid & 3, fr = lane & 15, fq = lane >> 4;
    const int K = g.K, nt = K / BK;
    unsigned voffA[2], voffB[2];
#pragma unroll
    for (int i = 0; i < 2; ++i) { int R, C; stage_rc(tid * 16 + i * 8192, R, C); const int Rb = Epi::PERM ? ((R & ~31) + perm32(R & 31)) : R;
        voffA[i] = (unsigned)(R * g.lda + C) * 2u; voffB[i] = (unsigned)(Rb * K + C) * 2u; }
    const size_t kstep = (size_t)(BK * 2);
    const size_t hstepA = (size_t)HALF * g.lda * 2, hstepB = (size_t)HALF * K * 2;
    const size_t tstepA = 2 * hstepA, tstepB = 2 * hstepB;
    const unsigned ldsw = (unsigned)wid * 1024u;
    const int aoff = lds_byte(wr * 64 + fr, fq * 8), boff = lds_byte(wc * 32 + fr, fq * 8);
#define PG8_SA(b, h) (((b) * 2 + (h)) * HTB)
#define PG8_SB(b, h) ((4 + (b) * 2 + (h)) * HTB)
#define PG8_STAGE(bufoff, gbase, voff) do { _Pragma("unroll") for (int _i = 0; _i < 2; ++_i) \
        __builtin_amdgcn_global_load_lds((const unsigned*)((const char*)(gbase) + (voff)[_i]), (PG8_LAS unsigned*)(lds + (bufoff) + ldsw + _i * 8192), 16, 0, 0); } while (0)
#define PG8_LDA(dst, b, h) do { _Pragma("unroll") for (int m = 0; m < 4; ++m) _Pragma("unroll") for (int k = 0; k < 2; ++k) dst[m][k] = *(const PG8_LAS bf16x8*)(lds + PG8_SA(b, h) + aoff + m * 2048 + k * 1024); } while (0)
#define PG8_LDB(dst, b, h) do { _Pragma("unroll") for (int n = 0; n < 2; ++n) _Pragma("unroll") for (int k = 0; k < 2; ++k) dst[n][k] = *(const PG8_LAS bf16x8*)(lds + PG8_SB(b, h) + boff + n * 2048 + k * 1024); } while (0)
#define PG8_MMA(ai, bj, At, Bt) do { __builtin_amdgcn_s_setprio(1); _Pragma("unroll") for (int m = 0; m < 4; ++m) _Pragma("unroll") for (int n = 0; n < 2; ++n) _Pragma("unroll") for (int k = 0; k < 2; ++k) \
        acc[ai][bj][m][n] = __builtin_amdgcn_mfma_f32_16x16x32_bf16(Bt[n][k], At[m][k], acc[ai][bj][m][n], 0, 0, 0); __builtin_amdgcn_s_setprio(0); } while (0)
#define PG8_WAIT_V(n) asm volatile("s_waitcnt vmcnt(" #n ")" ::: "memory")
#define PG8_WAIT_L(n) asm volatile("s_waitcnt lgkmcnt(" #n ")" ::: "memory")
#define PG8_BAR __builtin_amdgcn_s_barrier()
#define PG8_SCHED __builtin_amdgcn_sched_barrier(0)
    Unit cur, nxt; int ui = 0;
    if (!S.next(0, cur)) return;
    f32x4 acc[2][2][4][2];
#pragma unroll
    for (int a = 0; a < 2; ++a)
#pragma unroll
        for (int b = 0; b < 2; ++b)
#pragma unroll
            for (int m = 0; m < 4; ++m)
#pragma unroll
                for (int n = 0; n < 2; ++n) acc[a][b][m][n] = (f32x4){0.f, 0.f, 0.f, 0.f};
    bf16x8 At[4][2], B0[2][2], B1[2][2];
    const char* cA = (const char*)g.A + (size_t)cur.pm * tstepA; const char* cB = (const char*)g.Bt + (size_t)cur.pn * tstepB;
    S.a_ready(cur);
    if constexpr (SP2) {
        PG8_STAGE(PG8_SB(0, 0), cB, voffB); PG8_STAGE(PG8_SB(0, 1), cB + hstepB, voffB); PG8_STAGE(PG8_SA(0, 0), cA, voffA); PG8_STAGE(PG8_SA(0, 1), cA + hstepA, voffA);
        if (wr == 1) PG8_BAR;
        PG8_WAIT_V(2); PG8_BAR;
        PG8_STAGE(PG8_SB(1, 0), cB + kstep, voffB); PG8_STAGE(PG8_SA(1, 0), cA + kstep, voffA); PG8_STAGE(PG8_SB(1, 1), cB + hstepB + kstep, voffB);
        PG8_WAIT_V(6); PG8_BAR;
    } else {
        PG8_STAGE(PG8_SB(0, 0), cB, voffB); PG8_STAGE(PG8_SA(0, 0), cA, voffA); PG8_STAGE(PG8_SB(0, 1), cB + hstepB, voffB); PG8_STAGE(PG8_SA(0, 1), cA + hstepA, voffA);
        if (wr == 1) PG8_BAR;
        PG8_WAIT_V(4); PG8_BAR;
        PG8_STAGE(PG8_SB(1, 0), cB + kstep, voffB); PG8_STAGE(PG8_SA(1, 0), cA + kstep, voffA); PG8_STAGE(PG8_SB(1, 1), cB + hstepB + kstep, voffB);
        PG8_WAIT_V(6); PG8_BAR;
    }
    for (;;) {
        const bool has_next = S.next(ui + 1, nxt);
        const char* nA = has_next ? (const char*)g.A + (size_t)nxt.pm * tstepA : cA; const char* nB = has_next ? (const char*)g.Bt + (size_t)nxt.pn * tstepB : cB;
#pragma nounroll
        for (int t = 0; t < nt; t += 2) {
            const bool last = (t == nt - 2);
            const char* a1 = cA + (size_t)(t + 1) * kstep;
            const char* a2 = last ? nA : cA + (size_t)(t + 2) * kstep; const char* b2 = last ? nB : cB + (size_t)(t + 2) * kstep;
            const char* a3 = a2 + kstep; const char* b3 = b2 + kstep;
            if (last && has_next) S.a_ready(nxt);
            if constexpr (SP2) {
            PG8_LDB(B0, 0, 0); PG8_LDB(B1, 0, 1); PG8_SCHED; PG8_LDA(At, 0, 0); PG8_STAGE(PG8_SA(1, 1), a1 + hstepA, voffA);
            PG8_WAIT_V(8); PG8_WAIT_L(0); PG8_BAR; PG8_MMA(0, 0, At, B0); PG8_MMA(0, 1, At, B1); PG8_BAR; PG8_SCHED;
            PG8_LDA(At, 0, 1); PG8_STAGE(PG8_SB(0, 0), b2, voffB); PG8_STAGE(PG8_SB(0, 1), b2 + hstepB, voffB); PG8_STAGE(PG8_SA(0, 0), a2, voffA);
            PG8_WAIT_V(8); PG8_WAIT_L(0); PG8_BAR; PG8_MMA(1, 0, At, B0); PG8_MMA(1, 1, At, B1); PG8_BAR; PG8_SCHED;
            PG8_LDB(B0, 1, 0); PG8_LDB(B1, 1, 1); PG8_SCHED; PG8_LDA(At, 1, 0); PG8_STAGE(PG8_SA(0, 1), a2 + hstepA, voffA);
            PG8_WAIT_V(8); PG8_WAIT_L(0); PG8_BAR; PG8_MMA(0, 0, At, B0); PG8_MMA(0, 1, At, B1); PG8_BAR; PG8_SCHED;
            PG8_LDA(At, 1, 1); PG8_STAGE(PG8_SB(1, 0), b3, voffB); PG8_STAGE(PG8_SB(1, 1), b3 + hstepB, voffB); PG8_STAGE(PG8_SA(1, 0), a3, voffA);
            PG8_WAIT_V(8); PG8_WAIT_L(0); PG8_BAR; PG8_MMA(1, 0, At, B0); PG8_MMA(1, 1, At, B1); PG8_BAR; PG8_SCHED;
            } else {
            PG8_LDB(B0, 0, 0); PG8_SCHED; PG8_LDA(At, 0, 0); PG8_STAGE(PG8_SA(1, 1), a1 + hstepA, voffA);
            PG8_WAIT_L(8); PG8_BAR; PG8_WAIT_L(0); PG8_MMA(0, 0, At, B0); PG8_BAR; PG8_SCHED;
            PG8_LDB(B1, 0, 1); PG8_STAGE(PG8_SB(0, 0), b2, voffB);
            PG8_BAR; PG8_WAIT_L(0); PG8_MMA(0, 1, At, B1); PG8_BAR;
            PG8_LDA(At, 0, 1); PG8_STAGE(PG8_SA(0, 0), a2, voffA);
            PG8_BAR; PG8_WAIT_L(0); PG8_MMA(1, 0, At, B0); PG8_BAR; PG8_SCHED;
            PG8_STAGE(PG8_SB(0, 1), b2 + hstepB, voffB);
            PG8_WAIT_V(6); PG8_BAR; PG8_MMA(1, 1, At, B1); PG8_BAR;
            PG8_LDB(B0, 1, 0); PG8_SCHED; PG8_LDA(At, 1, 0); PG8_STAGE(PG8_SA(0, 1), a2 + hstepA, voffA);
            PG8_WAIT_L(8); PG8_BAR; PG8_WAIT_L(0); PG8_MMA(0, 0, At, B0); PG8_BAR; PG8_SCHED;
            PG8_LDB(B1, 1, 1); PG8_STAGE(PG8_SB(1, 0), b3, voffB);
            PG8_BAR; PG8_WAIT_L(0); PG8_MMA(0, 1, At, B1); PG8_BAR;
            PG8_LDA(At, 1, 1); PG8_STAGE(PG8_SA(1, 0), a3, voffA);
            PG8_BAR; PG8_WAIT_L(0); PG8_MMA(1, 0, At, B0); PG8_BAR; PG8_SCHED;
            PG8_STAGE(PG8_SB(1, 1), b3 + hstepB, voffB);
            PG8_WAIT_V(6); PG8_BAR; PG8_MMA(1, 1, At, B1); PG8_BAR;
            }
        }
        if constexpr (ALIGN_EPI) { if (wr == 0) PG8_BAR; }
        if constexpr (!Epi::AFTER_DRAIN) { E(acc, cur, wr, wc, fr, fq); S.done(cur); }
        if (!has_next) break;
#pragma unroll
        for (int a = 0; a < 2; ++a)
#pragma unroll
            for (int b = 0; b < 2; ++b)
#pragma unroll
                for (int m = 0; m < 4; ++m)
#pragma unroll
                    for (int n = 0; n < 2; ++n) acc[a][b][m][n] = (f32x4){0.f, 0.f, 0.f, 0.f};
        cur = nxt; cA = nA; cB = nB; ++ui;
        if constexpr (ALIGN_EPI) { if (wr == 1) PG8_BAR; }
    }
    PG8_WAIT_V(0);
    if constexpr (!ALIGN_EPI) { if (wr == 0) PG8_BAR; }
    PG8_BAR;
    if constexpr (Epi::AFTER_DRAIN) { E.fused(acc, cur, wr, wc, fr, fq, lds, wid, lane); S.done(cur); }
#undef PG8_SA
#undef PG8_SB
#undef PG8_STAGE
#undef PG8_LDA
#undef PG8_LDB
#undef PG8_MMA
#undef PG8_WAIT_V
#undef PG8_WAIT_L
#undef PG8_BAR
#undef PG8_SCHED
}
}

namespace att {
using bf16x8 = __attribute__((ext_vector_type(8))) short;
using s16x4  = __attribute__((ext_vector_type(4))) short;
using f32x16 = __attribute__((ext_vector_type(16))) float;
using f32x4  = __attribute__((ext_vector_type(4))) float;
using u32x4  = __attribute__((ext_vector_type(4))) unsigned;
typedef unsigned short bf16_t;
typedef __attribute__((address_space(3))) char LCH;
typedef __attribute__((address_space(3))) float LFL;
constexpr int NW = 8, QBLK = 32, KVBLK = 64, DQK = 96, DV = 64, SEQ = 2048, MROWS = 49152;
constexpr float SCALE = 0.10206207261596577f;
constexpr float THR = 8.f;
constexpr int KROW = 208;
constexpr int SHM_V = KVBLK * DV * 2, SHM_K = KVBLK * KROW, SHM_ATTN = 2 * SHM_V + 2 * SHM_K + NW * 64 * 4;
#define SBAR() __builtin_amdgcn_sched_barrier(0)
__device__ __forceinline__ int crow(int r, int hi) { return (r & 3) + 8 * (r >> 2) + 4 * hi; }
__device__ __forceinline__ unsigned cvtpk(float lo, float hi) { unsigned r; asm volatile("v_cvt_pk_bf16_f32 %0, %1, %2" : "=v"(r) : "v"(lo), "v"(hi)); return r; }
__device__ __forceinline__ float bflo(unsigned w) { return __uint_as_float(w << 16); }
__device__ __forceinline__ float bfhi(unsigned w) { return __uint_as_float(w & 0xffff0000u); }

__device__ __forceinline__ void partialSM(f32x16& p0, f32x16& p1, float& m_reg, float& mn, float& alpha) {
  constexpr float C = SCALE * 1.4426950408889634f;
  float pmax = p0[0];
#pragma unroll
  for (int r = 1; r < 16; ++r) pmax = fmaxf(pmax, p0[r]);
#pragma unroll
  for (int r = 0; r < 16; ++r) pmax = fmaxf(pmax, p1[r]);
  { auto rr = __builtin_amdgcn_permlane32_swap(__float_as_uint(pmax), __float_as_uint(pmax), false, false);
    pmax = fmaxf(__uint_as_float(rr[0]), __uint_as_float(rr[1])); }
  if (__builtin_expect(__all(pmax - m_reg <= THR / SCALE), 1)) { mn = m_reg; alpha = 1.f; }
  else { mn = fmaxf(m_reg, pmax); alpha = __builtin_amdgcn_exp2f((m_reg - mn) * C); m_reg = mn; }
  const float mnC = -mn * C;
#pragma unroll
  for (int r = 0; r < 16; ++r) p0[r] = fmaf(p0[r], C, mnC);
#pragma unroll
  for (int r = 0; r < 16; ++r) p1[r] = fmaf(p1[r], C, mnC);
#pragma unroll
  for (int r = 0; r < 16; ++r) p0[r] = __builtin_amdgcn_exp2f(p0[r]);
}
__device__ __forceinline__ void finishSM(f32x16& p0, f32x16& p1, float alpha, float& l_reg, bf16x8& pa0, bf16x8& pa1, bf16x8& pa2, bf16x8& pa3) {
#pragma unroll
  for (int r = 0; r < 16; ++r) p1[r] = __builtin_amdgcn_exp2f(p1[r]);
  float ps = 0;
#pragma unroll
  for (int r = 0; r < 16; ++r) ps += p0[r];
#pragma unroll
  for (int r = 0; r < 16; ++r) ps += p1[r];
  { auto rr = __builtin_amdgcn_permlane32_swap(__float_as_uint(ps), __float_as_uint(ps), false, false);
    ps = __uint_as_float(rr[0]) + __uint_as_float(rr[1]); }
  l_reg = l_reg * alpha + ps;
#define PK4(P, BASE, OUT) do { unsigned a0 = cvtpk(P[BASE + 0], P[BASE + 1]), a1 = cvtpk(P[BASE + 2], P[BASE + 3]);   \
    unsigned b0 = cvtpk(P[BASE + 4], P[BASE + 5]), b1 = cvtpk(P[BASE + 6], P[BASE + 7]);                              \
    auto r0 = __builtin_amdgcn_permlane32_swap(a0, b0, false, false); auto r1 = __builtin_amdgcn_permlane32_swap(a1, b1, false, false); \
    u32x4 w = {r0[0], r1[0], r0[1], r1[1]}; OUT = *reinterpret_cast<bf16x8*>(&w); } while (0)
  PK4(p0, 0, pa0); PK4(p0, 8, pa1); PK4(p1, 0, pa2); PK4(p1, 8, pa3);
#undef PK4
}
__device__ __forceinline__ void qkt(f32x16& p0, f32x16& p1, const LCH* Ks, const bf16x8* qr, int r32, int hi) {
  p0 = f32x16{}; p1 = f32x16{};
#pragma unroll
  for (int d0 = 0; d0 < 6; ++d0) { const int cb = (d0 * 16 + hi * 8) * 2;
    const bf16x8 b0 = *(const __attribute__((address_space(3))) bf16x8*)(Ks + r32 * KROW + cb);
    const bf16x8 b1 = *(const __attribute__((address_space(3))) bf16x8*)(Ks + (32 + r32) * KROW + cb);
    p0 = __builtin_amdgcn_mfma_f32_32x32x16_bf16(b0, qr[d0], p0, 0, 0, 0);
    p1 = __builtin_amdgcn_mfma_f32_32x32x16_bf16(b1, qr[d0], p1, 0, 0, 0); }
}
__device__ __forceinline__ int v_st(int k, int c) { const int kk = (k & ~0xC) | ((k & 4) << 1) | ((k & 8) >> 1); return ((kk >> 3) * 2 + (c >> 5)) * 512 + ((kk & 7) * 32 + (c & 31)) * 2; }
__device__ __forceinline__ int v_rd_base(int lane) { return ((lane & 3) << 3) | (((lane >> 2) & 3) << 6) | (((lane >> 4) & 1) << 5) | (((lane >> 5) & 1) << 8); }
constexpr int v_rd_off(int d0, int ks, int half) { return d0 * 512 + ks * 2048 + half * 1024; }
template <int OFF> __device__ __forceinline__ s16x4 tr_read(int vb) { s16x4 r; asm volatile("ds_read_b64_tr_b16 %0, %1 offset:%2" : "=&v"(r) : "v"(vb), "i"(OFF) : "memory"); return r; }
template <int D0> __device__ __forceinline__ void pv_one(f32x16& od, int vb, bf16x8 pa0, bf16x8 pa1, bf16x8 pa2, bf16x8 pa3) {
  const s16x4 l0 = tr_read<v_rd_off(D0, 0, 0)>(vb), h0 = tr_read<v_rd_off(D0, 0, 1)>(vb), l1 = tr_read<v_rd_off(D0, 1, 0)>(vb), h1 = tr_read<v_rd_off(D0, 1, 1)>(vb);
  const s16x4 l2 = tr_read<v_rd_off(D0, 2, 0)>(vb), h2 = tr_read<v_rd_off(D0, 2, 1)>(vb), l3 = tr_read<v_rd_off(D0, 3, 0)>(vb), h3 = tr_read<v_rd_off(D0, 3, 1)>(vb);
  asm volatile("s_waitcnt lgkmcnt(0)" ::: "memory"); SBAR();
#define PK(L, H) (bf16x8){L[0], L[1], L[2], L[3], H[0], H[1], H[2], H[3]}
  od = __builtin_amdgcn_mfma_f32_32x32x16_bf16(pa0, PK(l0, h0), od, 0, 0, 0);
  od = __builtin_amdgcn_mfma_f32_32x32x16_bf16(pa1, PK(l1, h1), od, 0, 0, 0);
  od = __builtin_amdgcn_mfma_f32_32x32x16_bf16(pa2, PK(l2, h2), od, 0, 0, 0);
  od = __builtin_amdgcn_mfma_f32_32x32x16_bf16(pa3, PK(l3, h3), od, 0, 0, 0);
#undef PK
}
__device__ __forceinline__ void pv_d0(f32x16* o, int vb, bf16x8 pa0, bf16x8 pa1, bf16x8 pa2, bf16x8 pa3) {
  pv_one<0>(o[0], vb, pa0, pa1, pa2, pa3); pv_one<1>(o[1], vb, pa0, pa1, pa2, pa3);
}
struct AttnArgs { const bf16_t* Q; const bf16_t* K; const bf16_t* V; const float* hss; const float* qn_g; const float* tab; bf16_t* Y; };
__device__ __forceinline__ void attn_unit(const AttnArgs& A, int b, int h, int q0, LCH* lds) {
  const int tid = threadIdx.x, wid = tid >> 6, lane = tid & 63, r32 = lane & 31, hi = lane >> 5;
  LCH* V_lds = lds; LCH* K_lds = lds + 2 * SHM_V;
  LFL* ws = (LFL*)(lds + 2 * SHM_V + 2 * SHM_K) + wid * 64; LFL* li_l = ws; LFL* al_l = ws + 32;
  const bf16_t* Kh = A.K + (size_t)(b * 8 + h) * SEQ * DQK; const bf16_t* Vh = A.V + (size_t)(b * 8 + h) * SEQ * DV;
  float m_reg = -1e30f, l_reg = 0; f32x16 o[2] = {}; bf16x8 qr[6];
  {
    const int t = q0 + wid * QBLK + r32; const size_t mrow = (size_t)b * SEQ + t;
    const bf16_t* Qw = A.Q + ((size_t)(b * 8 + h) * SEQ + t) * DQK + hi * 8;
    const float sq = 1.0f / sqrtf(A.hss[(size_t)h * MROWS + mrow] * (1.0f / 96.0f) + 1e-6f);
#pragma unroll
    for (int d0 = 0; d0 < 4; ++d0) {
      const u32x4 w = *reinterpret_cast<const u32x4*>(Qw + d0 * 16);
      const f32x4 g0 = *reinterpret_cast<const f32x4*>(A.qn_g + d0 * 16 + hi * 8), g1 = *reinterpret_cast<const f32x4*>(A.qn_g + d0 * 16 + hi * 8 + 4);
      u32x4 o4; o4.x = cvtpk(bflo(w.x) * g0[0] * sq, bfhi(w.x) * g0[1] * sq); o4.y = cvtpk(bflo(w.y) * g0[2] * sq, bfhi(w.y) * g0[3] * sq);
      o4.z = cvtpk(bflo(w.z) * g1[0] * sq, bfhi(w.z) * g1[1] * sq); o4.w = cvtpk(bflo(w.w) * g1[2] * sq, bfhi(w.w) * g1[3] * sq);
      qr[d0] = *reinterpret_cast<bf16x8*>(&o4);
    }
#pragma unroll
    for (int d0 = 4; d0 < 6; ++d0) {
      const u32x4 w = *reinterpret_cast<const u32x4*>(Qw + d0 * 16);
      const int i0 = 8 * (d0 - 4) + 4 * hi;
      const f32x4 g1 = *reinterpret_cast<const f32x4*>(A.qn_g + 64 + i0), g2 = *reinterpret_cast<const f32x4*>(A.qn_g + 80 + i0);
      const float* tb = A.tab + ((size_t)t * 16 + i0) * 2; const f32x4 cs0 = *reinterpret_cast<const f32x4*>(tb), cs1 = *reinterpret_cast<const f32x4*>(tb + 4);
      const unsigned ww[4] = {w.x, w.y, w.z, w.w}; const float cc[4] = {cs0[0], cs0[2], cs1[0], cs1[2]}, sn[4] = {cs0[1], cs0[3], cs1[1], cs1[3]};
      unsigned ow[4];
#pragma unroll
      for (int jj = 0; jj < 4; ++jj) { const float a = bflo(ww[jj]) * g1[jj] * sq, bb = bfhi(ww[jj]) * g2[jj] * sq; ow[jj] = cvtpk(a * cc[jj] - bb * sn[jj], a * sn[jj] + bb * cc[jj]); }
      u32x4 o4 = {ow[0], ow[1], ow[2], ow[3]}; qr[d0] = *reinterpret_cast<bf16x8*>(&o4);
    }
  }
  const int kc0 = tid, kc1 = tid < 256 ? tid + 512 : tid; const bool k2 = tid < 256;
  const int kr0 = kc0 / 12, kch0 = kc0 - 12 * kr0, kr1 = kc1 / 12, kch1 = kc1 - 12 * kr1;
  const int kg0 = kr0 * DQK + kch0 * 8, kg1 = kr1 * DQK + kch1 * 8, kl0 = kr0 * KROW + kch0 * 16, kl1 = kr1 * KROW + kch1 * 16;
  const int vk = tid >> 3, vc = (tid & 7) * 8, vg = vk * DV + vc, vl = v_st(vk, vc);
  const int vb0 = (int)(unsigned)(uintptr_t)V_lds + v_rd_base(lane);
  struct { bf16x8 v, k0, k1; } sr_[2];
#define SLOAD(i, key0) do { sr_[i].v = *reinterpret_cast<const bf16x8*>(Vh + (size_t)(key0) * DV + vg); sr_[i].k0 = *reinterpret_cast<const bf16x8*>(Kh + (size_t)(key0) * DQK + kg0); \
    sr_[i].k1 = *reinterpret_cast<const bf16x8*>(Kh + (size_t)(key0) * DQK + kg1); } while (0)
#define SWRITE(bf, i) do { *(__attribute__((address_space(3))) bf16x8*)(V_lds + (bf) * SHM_V + vl) = sr_[i].v; *(__attribute__((address_space(3))) bf16x8*)(K_lds + (bf) * SHM_K + kl0) = sr_[i].k0; if (k2) *(__attribute__((address_space(3))) bf16x8*)(K_lds + (bf) * SHM_K + kl1) = sr_[i].k1; } while (0)
#define SWAIT() asm volatile("s_waitcnt vmcnt(3)" ::: "memory")
#define RESC(a) do { if (__any((a) < 1.f)) { if (hi == 0) al_l[r32] = (a); asm volatile("s_waitcnt lgkmcnt(0)" ::: "memory"); \
    _Pragma("unroll") for (int d = 0; d < 2; ++d) _Pragma("unroll") for (int r = 0; r < 16; ++r) o[d][r] *= al_l[crow(r, hi)]; } } while (0)
  f32x16 pA0, pA1, pB0, pB1; float mnA, mnB, alA, alB; bf16x8 pa0, pa1, pa2, pa3; constexpr int NT = SEQ / KVBLK;
  constexpr int SE = 0, SO = 1;
  SLOAD(SE, 0); asm volatile("s_waitcnt vmcnt(0)" ::: "memory"); SWRITE(0, SE); __syncthreads();
  qkt(pA0, pA1, K_lds, qr, r32, hi); partialSM(pA0, pA1, m_reg, mnA, alA);
  SLOAD(SO, KVBLK); SLOAD(SE, 2 * KVBLK);
  SWAIT(); SWRITE(1, SO); __syncthreads();
  for (int j = 1; j + 1 < NT; j += 2) {
    SBAR(); qkt(pB0, pB1, K_lds + SHM_K, qr, r32, hi);
    finishSM(pA0, pA1, alA, l_reg, pa0, pa1, pa2, pa3); SBAR();
    SLOAD(SO, (j + 2) * KVBLK); SBAR();
    pv_d0(o, vb0, pa0, pa1, pa2, pa3); partialSM(pB0, pB1, m_reg, mnB, alB);
    __syncthreads(); SWAIT(); SWRITE(0, SE);
    RESC(alB); __syncthreads();
    SBAR(); qkt(pA0, pA1, K_lds, qr, r32, hi);
    finishSM(pB0, pB1, alB, l_reg, pa0, pa1, pa2, pa3); SBAR();
    if (j + 3 < NT) SLOAD(SE, (j + 3) * KVBLK); SBAR();
    pv_d0(o, vb0 + SHM_V, pa0, pa1, pa2, pa3); partialSM(pA0, pA1, m_reg, mnA, alA);
    __syncthreads(); SWAIT(); SWRITE(1, SO);
    RESC(alA); __syncthreads();
  }
  SBAR(); qkt(pB0, pB1, K_lds + SHM_K, qr, r32, hi);
  finishSM(pA0, pA1, alA, l_reg, pa0, pa1, pa2, pa3); SBAR();
  pv_d0(o, vb0, pa0, pa1, pa2, pa3); partialSM(pB0, pB1, m_reg, mnB, alB);
  __syncthreads(); RESC(alB);
  finishSM(pB0, pB1, alB, l_reg, pa0, pa1, pa2, pa3); SBAR();
  pv_d0(o, vb0 + SHM_V, pa0, pa1, pa2, pa3);
  if (hi == 0) li_l[r32] = l_reg; asm volatile("s_waitcnt lgkmcnt(0)" ::: "memory");
  float rli[16];
#pragma unroll
  for (int r = 0; r < 16; ++r) rli[r] = __builtin_amdgcn_rcpf(li_l[crow(r, hi)]);
  bf16_t* Yw = A.Y + ((size_t)b * SEQ + q0 + wid * QBLK) * 1024 + 512 + h * DV;
#pragma unroll
  for (int r = 0; r < 16; ++r) { const int orow = crow(r, hi);
#pragma unroll
    for (int d0 = 0; d0 < 2; ++d0) { const unsigned pk = cvtpk(o[d0][r] * rli[r], 0.f); Yw[(size_t)orow * 1024 + d0 * 32 + r32] = (bf16_t)(pk & 0xffffu); } }
  __syncthreads();
#undef SLOAD
#undef SWRITE
#undef SWAIT
#undef RESC
}
#undef SBAR
}

constexpr int NWAVES = 8;
constexpr int M = 49152, DM = 1024, SEQL = 2048, MPR = 32768, NPH = 9;
constexpr size_t MiB = 1u << 20;
constexpr size_t WS_CTL = 0, CTL_ZERO_BYTES = 1 * MiB;
constexpr size_t WS_TAB = 1 * MiB;
constexpr size_t WS_SSZ = 2 * MiB, SSZ_BYTES = 13 * (size_t)M * 4;
constexpr size_t WS_SS1 = 5 * MiB;
constexpr size_t WS_KRR = 6 * MiB;
constexpr size_t WS_WIN = 12 * MiB, WS_WQB = WS_WIN + 1280 * 1024 * 2, WS_WKVB = WS_WQB + 768 * 384 * 2, WS_WO = 16 * MiB, WS_WGU = 18 * MiB, WS_WD = 29 * MiB, WS_WPG = 35 * MiB, WS_WPP = 37 * MiB;
constexpr size_t WS_PB = 40 * MiB;
constexpr size_t WS_Z = 64 * MiB;
constexpr size_t WS_XB = 184 * MiB;
constexpr size_t WS_Q = 184 * MiB, WS_K = 256 * MiB, WS_V = 328 * MiB, WS_Y = 376 * MiB;
constexpr size_t WS_HB = 64 * MiB;
constexpr size_t WS_ACT = 184 * MiB;
constexpr size_t WS_PROJ = 184 * MiB;
constexpr size_t WS_END = 472 * MiB;
static_assert(WS_WKVB + 1024 * 256 * 2 <= WS_WO && WS_WGU + (size_t)5632 * 1024 * 2 <= WS_WD && WS_WD + (size_t)1024 * 2816 * 2 <= WS_WPG && WS_WPP + 1024 * 256 * 2 <= WS_PB, "weight map");
static_assert(WS_SSZ + SSZ_BYTES <= WS_SS1 && WS_SS1 + 2 * (size_t)M * 4 <= WS_KRR && WS_KRR + (size_t)M * 32 * 4 <= WS_WIN, "small arrays map");
constexpr int CW_TMO = 0, CW_BAR = 4096;
constexpr int RING_OFF = 0, RING_BYTES = 131072, LDSCTL_OFF = RING_BYTES, MISC_OFF = LDSCTL_OFF + 320, LDS_BYTES = 147456;

#define GAS __attribute__((address_space(1)))
#define LAS __attribute__((address_space(3)))
typedef unsigned short bf16;
typedef unsigned v4u __attribute__((ext_vector_type(4)));
typedef float f32x4 __attribute__((ext_vector_type(4)));
typedef GAS unsigned gu32;
#define RLX_AGENT __ATOMIC_RELAXED, __HIP_MEMORY_SCOPE_AGENT
#define LDS_WAIT() asm volatile("s_waitcnt lgkmcnt(0)" ::: "memory")
#define VM_WAIT() asm volatile("s_waitcnt vmcnt(0)" ::: "memory")
__device__ __forceinline__ unsigned f2bf(float f) { unsigned u = __builtin_bit_cast(unsigned, f); return (u + 0x7fffu + ((u >> 16) & 1u)) >> 16; }
__device__ __forceinline__ unsigned pk2(float lo, float hi) { return f2bf(lo) | (f2bf(hi) << 16); }

#define XB_TMO      128
#define XB_XCNT(j)  (256  + 64 * (j))
#define XB_XSUB(j)  (1280 + 64 * (j))
#define XB_XGEN(j)  (2304 + 64 * (j))
#define XB_TOP      3328
#define XB_TOPGEN   3392
#define XCD_BAR_WORDS 3456
#define XB_SPIN_CAP (1u << 18)

__device__ __forceinline__ unsigned xb_ld(unsigned* p)              { return __hip_atomic_load(p, __ATOMIC_RELAXED, __HIP_MEMORY_SCOPE_AGENT); }
__device__ __forceinline__ unsigned xb_add(unsigned* p, unsigned v) { return __hip_atomic_fetch_add(p, v, __ATOMIC_RELAXED, __HIP_MEMORY_SCOPE_AGENT); }
__device__ __forceinline__ unsigned xb_xcc_id() { return (unsigned)__builtin_amdgcn_s_getreg((3 << 11) | 20) & 0xFu; }
#define XB_SPIN(cond, bar) do { unsigned _sp = 0; while (cond) { __builtin_amdgcn_s_sleep(1); \
    if ((++_sp & 255u) == 0u) { if (xb_ld(&(bar)[XB_TMO])) break; if (_sp > XB_SPIN_CAP) { atomicAdd(&(bar)[XB_TMO], 1u); break; } } } } while (0)

struct XcdBarrier {
    unsigned* bar; unsigned x;
    volatile LAS unsigned* st;
};

__device__ __forceinline__ XcdBarrier xcd_barrier_post(unsigned* bar, volatile LAS unsigned* st) {
    XcdBarrier b; b.bar = bar; b.x = xb_xcc_id(); b.st = st;
    if (threadIdx.x == 0) (void)xb_add(&bar[XB_XCNT(b.x)], 1u);
    return b;
}
__device__ __forceinline__ void xcd_barrier_complete(unsigned* bar, unsigned x, unsigned& nloc, unsigned& nx) {
    const unsigned G = gridDim.x * gridDim.y * gridDim.z;
    unsigned sum, cnt, mine, sp = 0u;
    for (;;) {
        sum = 0u; cnt = 0u; mine = 0u;
#pragma unroll
        for (unsigned j = 0; j < 16; ++j) { const unsigned c = xb_ld(&bar[XB_XCNT(j)]); sum += c; cnt += (c > 0u) ? 1u : 0u; mine = (j == x) ? c : mine; }
        if (sum == G) break;
        __builtin_amdgcn_s_sleep(1);
        if ((++sp & 255u) == 0u) { if (xb_ld(&bar[XB_TMO])) break; if (sp > XB_SPIN_CAP) { atomicAdd(&bar[XB_TMO], 1u); break; } }
    }
    nloc = mine > 0u ? mine : 1u; nx = cnt > 0u ? cnt : 1u;
}

__device__ __forceinline__ void xcd_barrier(const XcdBarrier& b) {
    asm volatile("s_waitcnt vmcnt(0)" ::: "memory");
    __syncthreads();
    if (threadIdx.x == 0) {
        unsigned* bar = b.bar;
        __builtin_amdgcn_s_waitcnt(0);
        unsigned nloc = b.st[0], nx = b.st[1];
        if (nloc == 0u) { xcd_barrier_complete(bar, b.x, nloc, nx); b.st[0] = nloc; b.st[1] = nx; }
        const unsigned old = xb_add(&bar[XB_XSUB(b.x)], 1u);
        const unsigned gen = old / nloc;
        if (old + 1u == (gen + 1u) * nloc) {
            __builtin_amdgcn_fence(__ATOMIC_RELEASE, "agent");
            asm volatile("s_waitcnt vmcnt(0)" ::: "memory");
            const unsigned og = xb_add(&bar[XB_TOP], 1u);
            const unsigned tg = og / nx;
            if (og + 1u == (tg + 1u) * nx) xb_add(&bar[XB_TOPGEN], 1u);
            else XB_SPIN(xb_ld(&bar[XB_TOPGEN]) == tg, bar);
            __builtin_amdgcn_fence(__ATOMIC_ACQUIRE, "agent");
            xb_add(&bar[XB_XGEN(b.x)], 1u);
            asm volatile("s_waitcnt vmcnt(0)" ::: "memory");
        } else {
            XB_SPIN(xb_ld(&bar[XB_XGEN(b.x)]) == gen, bar);
            __builtin_amdgcn_fence(__ATOMIC_ACQUIRE, "agent");
            asm volatile("s_waitcnt vmcnt(0)" ::: "memory");
        }
    }
    __syncthreads();
}


struct Frame {
    LAS unsigned char* lds; volatile LAS unsigned* MISC; gu32* ctl;
    int tid, lane, wave, vcu, G;
};
struct Args { const float* in[22]; float* out; unsigned char* ws; int ph_lo, ph_hi; };

__device__ __forceinline__ float wave_sum(float v) {
#pragma unroll
    for (int o = 1; o < 64; o <<= 1) v += __shfl_xor(v, o);
    return v;
}
enum { MAP_ID = 0, MAP_IN = 1, MAP_QB = 2, MAP_KVB = 3, MAP_GU = 4 };
__device__ __forceinline__ int map_col(int map, int n) {
    if (map == MAP_IN) { if (n < 896) return n; if (n < 928) { const int i = n - 896, pr = i >> 1; return 1152 + ((i & 1) ? 16 + pr : pr); } if (n < 1024) return -1; return 896 + (n - 1024); }
    if (map == MAP_QB) { const int slab = n >> 5, c = n & 31, head = slab / 3, part = slab - 3 * head; const int lg = part < 2 ? part * 32 + c : 64 + ((c & 1) ? 16 + (c >> 1) : (c >> 1)); return head * 96 + lg; }
    if (map == MAP_KVB) { const int t = n >> 8, r = n & 255, bj = r >> 7, wc = (r >> 5) & 3, c = r & 31; return (2 * t + (wc & 1)) * 128 + (wc >> 1) * 64 + bj * 32 + c; }
    if (map == MAP_GU) { const int pn = n >> 8, r = n & 255; return ((r >> 7) ? 2816 : 0) + pn * 128 + (r & 127); }
    return n;
}
__device__ __forceinline__ void p0_transpose_item(const float* W, const float* W2, int ldw, const float* gain, bf16* WT, int ldt, int kdst0, int nblk, int map, LAS float* scr, int item, int lane) {
    const int kb = item / nblk, nb = item - kb * nblk, k0 = 64 * kb, n0 = 32 * nb;
    int col = map_col(map, n0 + (lane & 31)); const float* src = W; if (map == MAP_GU && col >= 2816) { col -= 2816; src = W2; }
#pragma unroll 8
    for (int i = 0; i < 32; ++i) { const int kk = 2 * i + (lane >> 5); float v = col >= 0 ? src[(size_t)(k0 + kk) * ldw + col] : 0.f; if (gain) v *= gain[k0 + kk]; scr[kk * 33 + (lane & 31)] = v; }
    LDS_WAIT(); asm volatile("" ::: "memory");
    const int c = lane & 7;
#pragma unroll
    for (int j = 0; j < 4; ++j) { const int n = (lane >> 3) + 8 * j; const LAS float* s = scr + (8 * c) * 33 + n;
        v4u o; o.x = pk2(s[0 * 33], s[1 * 33]); o.y = pk2(s[2 * 33], s[3 * 33]); o.z = pk2(s[4 * 33], s[5 * 33]); o.w = pk2(s[6 * 33], s[7 * 33]);
        *(GAS v4u*)(WT + (size_t)(n0 + n) * ldt + kdst0 + k0 + 8 * c) = o; }
    LDS_WAIT(); asm volatile("" ::: "memory");
}
__device__ __forceinline__ void p0_prologue(Frame& F, const Args& a) {
    unsigned char* ws = a.ws;
    LAS float* scr = (LAS float*)(F.lds + RING_OFF + F.wave * 16384);
    const int gw = F.vcu * NWAVES + F.wave, NGW = F.G * NWAVES;
    const int gt = F.vcu * (NWAVES * 64) + F.tid, NGT = F.G * NWAVES * 64;
    { v4u* zp = (v4u*)(ws + WS_SSZ); const v4u zz = {0u, 0u, 0u, 0u}; for (int i = gt; i < (int)(SSZ_BYTES / 16); i += NGT) zp[i] = zz; }
    { float* tab = (float*)(ws + WS_TAB); for (int i = gt; i < SEQL * 16; i += NGT) { const int t = i >> 4, f = i & 15; const float ang = (float)t * powf(10000.0f, -(float)(2 * f) / 32.0f); tab[2 * i] = cosf(ang); tab[2 * i + 1] = sinf(ang); } }
    {
        const float *ln1 = a.in[4], *w_in = a.in[5], *qan = a.in[8], *w_qb = a.in[9], *kvan = a.in[10], *w_kvb = a.in[11], *w_o = a.in[14], *ln2 = a.in[15], *w_gate = a.in[16], *w_up = a.in[17], *w_down = a.in[18], *plen = a.in[19], *w_pg = a.in[20], *w_pp = a.in[21];
        constexpr int I_IN = (1024 / 64) * (1280 / 32), I_QB = (384 / 64) * (768 / 32), I_KVB = (256 / 64) * (1024 / 32), I_O = (512 / 64) * (1024 / 32), I_GU = (1024 / 64) * (5632 / 32), I_D = (2816 / 64) * (1024 / 32), I_PG = (1024 / 64) * (1024 / 32), I_PP = (256 / 64) * (1024 / 32);
        constexpr int NITEMS = I_IN + I_QB + I_KVB + I_O + I_GU + I_D + I_PG + I_PP;
        for (int it = gw; it < NITEMS; it += NGW) {
            int r = it;
            if (r < I_IN) { p0_transpose_item(w_in, nullptr, 1184, ln1, (bf16*)(ws + WS_WIN), 1024, 0, 1280 / 32, MAP_IN, scr, r, F.lane); continue; } r -= I_IN;
            if (r < I_QB) { p0_transpose_item(w_qb, nullptr, 768, qan, (bf16*)(ws + WS_WQB), 384, 0, 768 / 32, MAP_QB, scr, r, F.lane); continue; } r -= I_QB;
            if (r < I_KVB) { p0_transpose_item(w_kvb, nullptr, 1024, kvan, (bf16*)(ws + WS_WKVB), 256, 0, 1024 / 32, MAP_KVB, scr, r, F.lane); continue; } r -= I_KVB;
            if (r < I_O) { p0_transpose_item(w_o + (size_t)512 * 1024, nullptr, 1024, nullptr, (bf16*)(ws + WS_WO), 1024, 512, 1024 / 32, MAP_ID, scr, r, F.lane); continue; } r -= I_O;
            if (r < I_GU) { p0_transpose_item(w_gate, w_up, 2816, ln2, (bf16*)(ws + WS_WGU), 1024, 0, 5632 / 32, MAP_GU, scr, r, F.lane); continue; } r -= I_GU;
            if (r < I_D) { p0_transpose_item(w_down, nullptr, 1024, nullptr, (bf16*)(ws + WS_WD), 2816, 0, 1024 / 32, MAP_ID, scr, r, F.lane); continue; } r -= I_D;
            if (r < I_PG) { p0_transpose_item(w_pg, nullptr, 1024, plen, (bf16*)(ws + WS_WPG), 1024, 0, 1024 / 32, MAP_ID, scr, r, F.lane); continue; } r -= I_PG;
            p0_transpose_item(w_pp, nullptr, 1024, nullptr, (bf16*)(ws + WS_WPP), 256, 0, 1024 / 32, MAP_ID, scr, r, F.lane);
        }
    }
    {
        const float* __restrict__ w_pool = a.in[6]; const float* __restrict__ psc = a.in[7]; const float* __restrict__ w_o = a.in[14]; bf16* WO = (bf16*)(ws + WS_WO);
        for (int it = gw; it < 1024; it += NGW) {
            const int kb = it >> 4, nb = it & 15, kk0 = kb * 8, g = kk0 >> 7, n = nb * 64 + F.lane;
            const float* wo = w_o + (size_t)(g * 128) * 1024 + n; const float* wp = w_pool + (size_t)kk0 * 128; const float* sc = psc + g * 128;
            float acc[8];
#pragma unroll
            for (int e = 0; e < 8; ++e) acc[e] = 0.f;
#pragma unroll 16
            for (int j = 0; j < 128; ++j) { const float w = wo[(size_t)j * 1024] * sc[j];
#pragma unroll
                for (int e = 0; e < 8; ++e) acc[e] = fmaf(wp[e * 128 + j], w, acc[e]); }
            v4u o; o.x = pk2(acc[0], acc[1]); o.y = pk2(acc[2], acc[3]); o.z = pk2(acc[4], acc[5]); o.w = pk2(acc[6], acc[7]);
            *(GAS v4u*)(WO + (size_t)n * 1024 + kk0) = o;
        }
    }
    {
        bf16* XB = (bf16*)(ws + WS_XB); bf16* PB = (bf16*)(ws + WS_PB); float* ss1 = (float*)(ws + WS_SS1);
        for (int m0 = 2 * gw; m0 < M; m0 += 2 * NGW) {
            f32x4 v[2][4], pv[2];
#pragma unroll
            for (int r = 0; r < 2; ++r) { const int m = m0 + r;
                const float* xrow = m < MPR ? a.in[0] + (size_t)m * DM : a.in[1] + (size_t)(m - MPR) * DM;
                const float* prow = m < MPR ? a.in[2] + (size_t)m * 256 : a.in[3] + (size_t)(m - MPR) * 256;
                const GAS f32x4* xr = (const GAS f32x4*)xrow + F.lane;
#pragma unroll
                for (int j = 0; j < 4; ++j) v[r][j] = xr[64 * j];
                pv[r] = ((const GAS f32x4*)prow)[F.lane]; }
#pragma unroll
            for (int r = 0; r < 2; ++r) { const int m = m0 + r; float s = 0.f;
#pragma unroll
                for (int j = 0; j < 4; ++j) s += (v[r][j].x * v[r][j].x + v[r][j].y * v[r][j].y) + (v[r][j].z * v[r][j].z + v[r][j].w * v[r][j].w);
                s = wave_sum(s); if (F.lane == 0) ss1[m] = s;
                GAS unsigned long long* o8 = (GAS unsigned long long*)(XB + (size_t)m * DM) + F.lane;
#pragma unroll
                for (int j = 0; j < 4; ++j) o8[64 * j] = (unsigned long long)pk2(v[r][j].x, v[r][j].y) | ((unsigned long long)pk2(v[r][j].z, v[r][j].w) << 32);
                ((GAS unsigned long long*)(PB + (size_t)m * 256))[F.lane] = (unsigned long long)pk2(pv[r].x, pv[r].y) | ((unsigned long long)pk2(pv[r].z, pv[r].w) << 32); }
        }
    }
}
__device__ __forceinline__ void pool_phase(Frame& F, const bf16* Z, bf16* Y) {
    const int gt = F.vcu * (NWAVES * 64) + F.tid, NGT = F.G * NWAVES * 64;
    for (int idx = gt; idx < M * 64; idx += NGT) {
        const int row = idx >> 6, c8 = idx & 63, t = row & (SEQL - 1), w = 2 << (c8 >> 4);
        int lo = t - (w >> 1), hi = lo + w; lo = lo < 0 ? 0 : lo; hi = hi > SEQL ? SEQL : hi;
        const bf16* zb = Z + (size_t)(row - t) * 1280 + c8 * 8;
        float s[8];
#pragma unroll
        for (int e = 0; e < 8; ++e) s[e] = 0.f;
        for (int j = lo; j < hi; ++j) { const v4u wv = *(const GAS v4u*)(zb + (size_t)j * 1280);
            s[0] += __uint_as_float(wv.x << 16); s[1] += __uint_as_float(wv.x & 0xffff0000u); s[2] += __uint_as_float(wv.y << 16); s[3] += __uint_as_float(wv.y & 0xffff0000u);
            s[4] += __uint_as_float(wv.z << 16); s[5] += __uint_as_float(wv.z & 0xffff0000u); s[6] += __uint_as_float(wv.w << 16); s[7] += __uint_as_float(wv.w & 0xffff0000u); }
        const v4u cv = *(const GAS v4u*)(zb + (size_t)t * 1280); const float inv = 1.0f / (float)(hi - lo);
        v4u o; o.x = pk2(s[0] * inv - __uint_as_float(cv.x << 16), s[1] * inv - __uint_as_float(cv.x & 0xffff0000u)); o.y = pk2(s[2] * inv - __uint_as_float(cv.y << 16), s[3] * inv - __uint_as_float(cv.y & 0xffff0000u));
        o.z = pk2(s[4] * inv - __uint_as_float(cv.z << 16), s[5] * inv - __uint_as_float(cv.z & 0xffff0000u)); o.w = pk2(s[6] * inv - __uint_as_float(cv.w << 16), s[7] * inv - __uint_as_float(cv.w & 0xffff0000u));
        *(GAS v4u*)(Y + (size_t)row * 1024 + c8 * 8) = o;
    }
}

__global__ void __launch_bounds__(NWAVES * 64, 2) mega_fwd(Args args) {
    extern __shared__ __attribute__((aligned(16))) unsigned char lds[];
    Frame F;
    F.lds = (LAS unsigned char*)lds; F.MISC = (volatile LAS unsigned*)(F.lds + MISC_OFF);
    F.tid = threadIdx.x; F.lane = F.tid & 63; F.wave = __builtin_amdgcn_readfirstlane(F.tid >> 6);
    F.G = gridDim.x; { const int bx = blockIdx.x; F.vcu = (F.G % 8 == 0) ? (bx % 8) * (F.G / 8) + bx / 8 : bx; }
    unsigned char* ws = args.ws; F.ctl = (gu32*)(ws + WS_CTL);
    for (int u = F.tid; u < (LDS_BYTES - LDSCTL_OFF) / 4; u += NWAVES * 64) ((LAS unsigned*)(F.lds + LDSCTL_OFF))[u] = 0u;
    __syncthreads();
    XcdBarrier bar = xcd_barrier_post((unsigned*)(F.ctl + CW_BAR), F.MISC + 8);
    const int lo = args.ph_lo, hi = args.ph_hi;
#ifndef PHMASK
#define PHMASK 0x1ff
#endif
#define IN(k) (((PHMASK >> (k)) & 1) && lo <= (k) && (k) < hi)
#ifndef REPEAT_MASK
#define REPEAT_MASK 0
#endif
#define REPS(k) for (int rep = 0; rep < 1 + ((REPEAT_MASK >> (k)) & 1); ++rep)
    float* spare = (float*)(ws + 38 * MiB);
#define SEAM(k) do { if (IN(k) && IN((k) + 1)) xcd_barrier(bar); } while (0)
    float* ssz = (float*)(ws + WS_SSZ); float *ss_q = ssz, *ss_kv = ssz + M, *ss2 = ssz + 2 * (size_t)M, *ss3 = ssz + 3 * (size_t)M, *hss = ssz + 5 * (size_t)M;
    float* ss1 = (float*)(ws + WS_SS1); float* ss_kr = ss1 + M; float* krr = (float*)(ws + WS_KRR); const float* tab = (const float*)(ws + WS_TAB);
    float* out = args.out;

    if (IN(0)) REPS(0) { p0_prologue(F, args); } SEAM(0);
    if (IN(1)) REPS(1) {
        pg8::Gemm g{(const pg8::bf16_t*)(ws + WS_XB), (const pg8::bf16_t*)(ws + WS_WIN), M, 1280, 1024, 1024}; pg8::StaticOrder S; S.init(M, 1280, F.G, (int)blockIdx.x);
        pg8::EpiIn E{(pg8::bf16_t*)(ws + WS_Z), ss1, rep ? spare : ss_q, rep ? spare : ss_kv, ss_kr, krr, args.in[13], tab};
        pg8::gemm_phase<pg8::EpiIn, pg8::StaticOrder, true, true>(F.lds + RING_OFF, g, S, E);
    } SEAM(1);
    if (IN(2)) REPS(2) {
#ifndef NOPOOL
        pool_phase(F, (const bf16*)(ws + WS_Z), (bf16*)(ws + WS_Y)); VM_WAIT();
#endif
#ifndef NOQ
        { pg8::Gemm g{(const pg8::bf16_t*)(ws + WS_Z) + 512, (const pg8::bf16_t*)(ws + WS_WQB), M, 768, 384, 1280}; pg8::StaticOrder S; S.init(M, 768, F.G, (int)blockIdx.x);
          pg8::EpiQ E{(pg8::bf16_t*)(ws + WS_Q), ss_q, rep ? spare : hss};
          pg8::gemm_phase<pg8::EpiQ, pg8::StaticOrder, true, true>(F.lds + RING_OFF, g, S, E); }
#endif
#ifndef NOKV
        { pg8::Gemm g{(const pg8::bf16_t*)(ws + WS_Z) + 1024, (const pg8::bf16_t*)(ws + WS_WKVB), M, 1024, 256, 1280}; pg8::StaticOrder S; S.init(M, 1024, F.G, (int)blockIdx.x);
          pg8::EpiKV E{(pg8::bf16_t*)(ws + WS_K), (pg8::bf16_t*)(ws + WS_V), ss_kv, ss_kr, krr, args.in[13]};
          pg8::gemm_phase<pg8::EpiKV, pg8::StaticOrder, true, true>(F.lds + RING_OFF, g, S, E); }
#endif
    } SEAM(2);
    if (IN(3)) REPS(3) {
        const att::AttnArgs A{(const att::bf16_t*)(ws + WS_Q), (const att::bf16_t*)(ws + WS_K), (const att::bf16_t*)(ws + WS_V), hss, args.in[12], tab, (att::bf16_t*)(ws + WS_Y)};
        for (int i = 0; i < 6; ++i) { const int u = i * 256 + F.vcu; if (u < 1536) { const int bh = u >> 3, qb = u & 7; att::attn_unit(A, bh >> 3, bh & 7, qb * 256, (att::LCH*)(F.lds + RING_OFF)); } }
    } SEAM(3);
    if (IN(4)) REPS(4) {
        pg8::Gemm g{(const pg8::bf16_t*)(ws + WS_Y), (const pg8::bf16_t*)(ws + WS_WO), M, 1024, 1024, 1024}; pg8::StaticOrder S; S.init(M, 1024, F.G, (int)blockIdx.x);
        pg8::EpiResX E{args.in[0], args.in[1], (pg8::bf16_t*)(ws + WS_HB), rep ? spare : ss2};
        pg8::gemm_phase<pg8::EpiResX, pg8::StaticOrder, true, true>(F.lds + RING_OFF, g, S, E);
    } SEAM(4);
    if (IN(5)) REPS(5) {
        pg8::Gemm g{(const pg8::bf16_t*)(ws + WS_HB), (const pg8::bf16_t*)(ws + WS_WGU), M, 5632, 1024, 1024}; pg8::StaticOrder S; S.init(M, 5632, F.G, (int)blockIdx.x);
        pg8::EpiSwiglu E{(pg8::bf16_t*)(ws + WS_ACT), ss2};
        pg8::gemm_phase<pg8::EpiSwiglu, pg8::StaticOrder, true, true>(F.lds + RING_OFF, g, S, E);
    } SEAM(5);
    if (IN(6)) {
        pg8::Gemm g{(const pg8::bf16_t*)(ws + WS_ACT), (const pg8::bf16_t*)(ws + WS_WD), M, 1024, 2816, 2816}; pg8::StaticOrder S; S.init(M, 1024, F.G, (int)blockIdx.x);
        pg8::EpiResB E{(pg8::bf16_t*)(ws + WS_HB), ss3};
        pg8::gemm_phase<pg8::EpiResB, pg8::StaticOrder, true, true>(F.lds + RING_OFF, g, S, E);
    } SEAM(6);
    if (IN(7)) REPS(7) {
        pg8::Gemm g{(const pg8::bf16_t*)(ws + WS_PB), (const pg8::bf16_t*)(ws + WS_WPP), M, 1024, 256, 256}; pg8::StaticOrder S; S.init(M, 1024, F.G, (int)blockIdx.x);
        pg8::EpiStore E{(pg8::bf16_t*)(ws + WS_PROJ)};
        pg8::gemm_phase<pg8::EpiStore, pg8::StaticOrder, true, true>(F.lds + RING_OFF, g, S, E);
    } SEAM(7);
    if (IN(8)) {
        pg8::Gemm g{(const pg8::bf16_t*)(ws + WS_HB), (const pg8::bf16_t*)(ws + WS_WPG), M, 1024, 1024, 1024}; pg8::StaticOrder S; S.init(M, 1024, F.G, (int)blockIdx.x);
        pg8::EpiFinal E{out, (const pg8::bf16_t*)(ws + WS_HB), (const pg8::bf16_t*)(ws + WS_PROJ), ss3};
        pg8::gemm_phase<pg8::EpiFinal, pg8::StaticOrder, true, true>(F.lds + RING_OFF, g, S, E);
    }
#undef IN
#undef SEAM
}

static int launch_fast(void* const* d_in, void* d_out, void* d_ws, size_t ws_size, hipStream_t stream, int ph_lo, int ph_hi) {
    static int grid = 0;
    if (grid == 0) {
        if (ws_size < WS_END) { fprintf(stderr, "kernel_launch: workspace too small: %zu < %zu\n", ws_size, (size_t)WS_END); grid = -1; return -1; }
        int dev = 0, cus = 0, per_cu = 0;
        if (hipGetDevice(&dev) != hipSuccess || hipDeviceGetAttribute(&cus, hipDeviceAttributeMultiprocessorCount, dev) != hipSuccess) { grid = -1; return -1; }
        if (hipFuncSetAttribute((const void*)mega_fwd, hipFuncAttributeMaxDynamicSharedMemorySize, LDS_BYTES) != hipSuccess) { fprintf(stderr, "kernel_launch: hipFuncSetAttribute failed\n"); grid = -1; return -1; }
        if (hipOccupancyMaxActiveBlocksPerMultiprocessor(&per_cu, (const void*)mega_fwd, NWAVES * 64, LDS_BYTES) != hipSuccess || per_cu < 1) fprintf(stderr, "kernel_launch: note: occupancy query reports %d\n", per_cu);
        (void)hipGetLastError();
        grid = cus;
    }
    if (grid < 0) return -1;
    if (hipMemsetAsync((char*)d_ws + WS_CTL, 0, CTL_ZERO_BYTES, stream) != hipSuccess) return -1;
    Args a{};
    for (int i = 0; i < 22; ++i) a.in[i] = (const float*)d_in[i];
    a.out = (float*)d_out; a.ws = (unsigned char*)d_ws; a.ph_lo = ph_lo; a.ph_hi = ph_hi;
    hipLaunchKernelGGL(mega_fwd, dim3(grid), dim3(NWAVES * 64), LDS_BYTES, stream, a);
    const hipError_t le = hipPeekAtLastError();
    if (le != hipSuccess) { fprintf(stderr, "kernel_launch: launch failed: %s\n", hipGetErrorName(le)); return -1; }
    return 0;
}

extern "C" void kernel_launch(void* const* d_in, const int* in_sizes, int n_in, void* d_out, int out_size, void* d_ws, size_t ws_size, hipStream_t stream) {
  (void)in_sizes; (void)n_in; (void)out_size;
  launch_fast(d_in, d_out, d_ws, ws_size, stream, 0, NPH);
}
```

```cpp
#include <hip/hip_runtime.h>
#include <cstdio>
#include <cstdint>

namespace pg8 {
#define PG8_LAS __attribute__((address_space(3)))
typedef unsigned short bf16_t;
typedef short bf16x8 __attribute__((ext_vector_type(8)));
typedef float f32x4 __attribute__((ext_vector_type(4)));
typedef unsigned u32x4 __attribute__((ext_vector_type(4)));
constexpr int BM = 256, BK = 64, HALF = 128, HTB = HALF * BK * 2  , STAGE_BYTES = 8 * HTB, NXCD = 8, WGM = 8;

__host__ __device__ __forceinline__ int lds_byte(int r, int c) { const int st = (r >> 4) * 2 + (c >> 5), rr = r & 15, cc = c & 31, ob = rr * 64 + cc * 2; return st * 1024 + (ob ^ (((ob >> 9) & 1) << 5)); }
__host__ __device__ __forceinline__ void stage_rc(int b, int& R, int& C) { const int st = b / 1024, sb = b % 1024, swz = sb ^ (((sb >> 9) & 1) << 5); R = (st >> 1) * 16 + swz / 64; C = (st & 1) * 32 + (swz % 64) / 2; }
__host__ __device__ __forceinline__ int perm32(int rho) { const int n = rho >> 4, i = rho & 15; return 8 * (i >> 2) + 4 * n + (i & 3); }

struct Unit { int pm, pn; };
struct Gemm { const bf16_t* A; const bf16_t* Bt; int M, N, K, lda; const bf16_t* A2 = nullptr; int nsplit = 1 << 30; };

struct StaticOrder {
    int nM, nN, nwg, G, c, rev;
    __host__ __device__ void init(int M, int N, int G_, int c_, int rev_ = 0) { nM = M / BM; nN = N / BM; nwg = nM * nN; G = G_; c = c_; rev = rev_; }
    __host__ __device__ bool next(int i, Unit& u) const {
        long L = (long)i * G + c; if (L >= nwg) return false;
        if (rev) { const int R = nwg / G; if (i < R) L = (long)(R - 1 - i) * G + c; }
        int wgid = (int)L; { const int q = nwg / NXCD, r = nwg % NXCD, xcd = wgid % NXCD, off = wgid / NXCD; wgid = (xcd < r ? xcd * (q + 1) : r * (q + 1) + (xcd - r) * q) + off; }
        const int nig = WGM * nN, gid = wgid / nig, fm = gid * WGM, gsz = (nM - fm) < WGM ? (nM - fm) : WGM;
        u.pm = fm + ((wgid % nig) % gsz); u.pn = (wgid % nig) / gsz; return true;
    }
    __device__ __forceinline__ void a_ready(const Unit&) const {}
    __device__ __forceinline__ void done(const Unit&) const {}
};

__device__ __forceinline__ unsigned cvt_pk_bf16(float lo, float hi) { unsigned r; asm volatile("v_cvt_pk_bf16_f32 %0, %1, %2" : "=v"(r) : "v"(lo), "v"(hi)); return r; }
typedef float f32x2 __attribute__((ext_vector_type(2)));

constexpr int MROWS = 49152, SEQ = 2048, MPROMPT = 32768, ZP = 1280;
constexpr float NEPS = 1e-6f;
__device__ __forceinline__ u32x4 pack8(const f32x4 a, const f32x4 b) { u32x4 w; w.x = cvt_pk_bf16(a[0], a[1]); w.y = cvt_pk_bf16(a[2], a[3]); w.z = cvt_pk_bf16(b[0], b[1]); w.w = cvt_pk_bf16(b[2], b[3]); return w; }
__device__ __forceinline__ float sq8(const f32x4 a, const f32x4 b) { return (a[0] * a[0] + a[1] * a[1]) + (a[2] * a[2] + a[3] * a[3]) + (b[0] * b[0] + b[1] * b[1]) + (b[2] * b[2] + b[3] * b[3]); }
__device__ __forceinline__ float red_fq(float s) { s += __shfl_xor(s, 16); s += __shfl_xor(s, 32); return s; }
__device__ __forceinline__ float bflo(unsigned w) { return __uint_as_float(w << 16); }
__device__ __forceinline__ float bfhi(unsigned w) { return __uint_as_float(w & 0xffff0000u); }
#define EPI_HALF_BEGIN _Pragma("unroll") for (int ai = 0; ai < 2; ++ai) { int rbase = u.pm * BM + ai * HALF + wr * 64 + fr; asm volatile("" : "+v"(rbase) :: "memory");
#define EPI_HALF_END asm volatile("" ::: "memory"); }
#define EPI_M _Pragma("unroll") for (int m = 0; m < 4; ++m)
#define EPI_FENCE asm volatile("" ::: "memory")
__device__ __forceinline__ float rstd(float ss, float inv_n) { return 1.0f / sqrtf(ss * inv_n + NEPS); }

struct EpiIn {
    static constexpr bool PERM = true, AFTER_DRAIN = false;
    bf16_t* z; const float* ss1; float* ss_q; float* ss_kv; float* ss_kr; float* krr; const float* kn_g; const float* tab;
    __device__ __forceinline__ void operator()(const f32x4 (&acc)[2][2][4][2], const Unit& u, int wr, int wc, int fr, int fq) const {
        const int colt = u.pn * BM + wc * 32 + 8 * fq;
        EPI_HALF_BEGIN
            EPI_M { const int row = rbase + 16 * m;
                f32x4 v00 = acc[ai][0][m][0], v01 = acc[ai][0][m][1], v10 = acc[ai][1][m][0], v11 = acc[ai][1][m][1];
                bf16_t* zr = z + (size_t)row * ZP + colt;
                if (u.pn != 3) {
                    *(u32x4*)(zr) = pack8(v00, v01); *(u32x4*)(zr + HALF) = pack8(v10, v11);
                    if (u.pn == 2 || u.pn == 4) { const float s = red_fq(sq8(v00, v01) + sq8(v10, v11)); if (fq == 0) atomicAdd((u.pn == 2 ? ss_q : ss_kv) + row, s); }
                } else {
                    *(u32x4*)(zr) = pack8(v00, v01);
                    { const float s = red_fq(sq8(v00, v01)); if (fq == 0) atomicAdd(ss_q + row, s); }
                    if (wc == 0) {
                        const float s = red_fq(sq8(v10, v11)); if (fq == 0) ss_kr[row] = s;
                        const int t = row & (SEQ - 1); const float* tb = tab + ((size_t)t * 16 + 4 * fq) * 2;
                        const f32x4 cs0 = *(const f32x4*)(tb), cs1 = *(const f32x4*)(tb + 4);
                        const f32x4 g1 = *(const f32x4*)(kn_g + 64 + 4 * fq), g2 = *(const f32x4*)(kn_g + 80 + 4 * fq);
                        f32x4 o0, o1;
                        { const float a = v10[0] * g1[0], b = v10[1] * g2[0]; o0[0] = a * cs0[0] - b * cs0[1]; o0[1] = a * cs0[1] + b * cs0[0]; }
                        { const float a = v10[2] * g1[1], b = v10[3] * g2[1]; o0[2] = a * cs0[2] - b * cs0[3]; o0[3] = a * cs0[3] + b * cs0[2]; }
                        { const float a = v11[0] * g1[2], b = v11[1] * g2[2]; o1[0] = a * cs1[0] - b * cs1[1]; o1[1] = a * cs1[1] + b * cs1[0]; }
                        { const float a = v11[2] * g1[3], b = v11[3] * g2[3]; o1[2] = a * cs1[2] - b * cs1[3]; o1[3] = a * cs1[3] + b * cs1[2]; }
                        float* kr = krr + (size_t)row * 32 + 8 * fq; *(f32x4*)kr = o0; *(f32x4*)(kr + 4) = o1;
                    }
                }
            }
        EPI_HALF_END
    }
};
struct EpiQ {
    static constexpr bool PERM = true, AFTER_DRAIN = false;
    bf16_t* Q; const float* ss_q; float* hss;
    __device__ __forceinline__ void operator()(const f32x4 (&acc)[2][2][4][2], const Unit& u, int wr, int wc, int fr, int fq) const {
        const int s0 = u.pn * 8 + wc, s1 = s0 + 4; const int h0 = s0 / 3, p0 = s0 - 3 * h0, h1 = s1 / 3, p1 = s1 - 3 * h1;
        EPI_HALF_BEGIN
            EPI_M { const int row = rbase + 16 * m;
                const int b = row >> 11, t = row & (SEQ - 1);
                const f32x4 v00 = acc[ai][0][m][0], v01 = acc[ai][0][m][1], v10 = acc[ai][1][m][0], v11 = acc[ai][1][m][1];
                *(u32x4*)(Q + ((size_t)(b * 8 + h0) * SEQ + t) * 96 + p0 * 32 + 8 * fq) = pack8(v00, v01);
                *(u32x4*)(Q + ((size_t)(b * 8 + h1) * SEQ + t) * 96 + p1 * 32 + 8 * fq) = pack8(v10, v11);
                const float q0 = red_fq(sq8(v00, v01)), q1 = red_fq(sq8(v10, v11));
                if (fq == 0) { atomicAdd(hss + (size_t)h0 * MROWS + row, q0); atomicAdd(hss + (size_t)h1 * MROWS + row, q1); }
            }
        EPI_HALF_END
    }
};
struct EpiKV {
    static constexpr bool PERM = true, AFTER_DRAIN = false;
    bf16_t* K; bf16_t* V; const float* ss_kv; const float* ss_kr; const float* krr; const float* kn_g; int pn0;
    __device__ __forceinline__ void operator()(const f32x4 (&acc)[2][2][4][2], const Unit& u, int wr, int wc, int fr, int fq) const {
        const int h = 2 * (u.pn - pn0) + (wc & 1);
        EPI_HALF_BEGIN
            float rsv[4], skr[4]; f32x4 kr0[4], kr1[4];
            EPI_M rsv[m] = ss_kv[rbase + 16 * m];
            if (wc < 2) { EPI_M { skr[m] = ss_kr[rbase + 16 * m]; const float* kr = krr + (size_t)(rbase + 16 * m) * 32 + 8 * fq; kr0[m] = *(const f32x4*)kr; kr1[m] = *(const f32x4*)(kr + 4); } }
            EPI_FENCE;
            EPI_M { const int row = rbase + 16 * m; const float rs = rstd(rsv[m], 1.0f / 256.0f);
                const int b = row >> 11, t = row & (SEQ - 1);
                f32x4 v00 = acc[ai][0][m][0] * rs, v01 = acc[ai][0][m][1] * rs, v10 = acc[ai][1][m][0] * rs, v11 = acc[ai][1][m][1] * rs;
                if (wc >= 2) {
                    bf16_t* vp = V + ((size_t)(b * 8 + h) * SEQ + t) * 64 + 8 * fq;
                    *(u32x4*)(vp) = pack8(v00, v01); *(u32x4*)(vp + 32) = pack8(v10, v11);
                } else {
                    const float tot = red_fq(sq8(v00, v01) + sq8(v10, v11));
                    const float sk = rstd(tot + skr[m], 1.0f / 96.0f);
                    const f32x4 g00 = *(const f32x4*)(kn_g + 8 * fq), g01 = *(const f32x4*)(kn_g + 8 * fq + 4), g10 = *(const f32x4*)(kn_g + 32 + 8 * fq), g11 = *(const f32x4*)(kn_g + 36 + 8 * fq);
                    v00 = v00 * g00 * sk; v01 = v01 * g01 * sk; v10 = v10 * g10 * sk; v11 = v11 * g11 * sk;
                    bf16_t* kp = K + ((size_t)(b * 8 + h) * SEQ + t) * 96 + 8 * fq;
                    *(u32x4*)(kp) = pack8(v00, v01); *(u32x4*)(kp + 32) = pack8(v10, v11);
                    *(u32x4*)(kp + 64) = pack8(kr0[m] * sk, kr1[m] * sk);
                }
            }
        EPI_HALF_END
    }
};
struct EpiQKV {
    static constexpr bool PERM = true, AFTER_DRAIN = false;
    EpiQ q; EpiKV kv;
    __device__ __forceinline__ void operator()(const f32x4 (&acc)[2][2][4][2], const Unit& u, int wr, int wc, int fr, int fq) const {
        if (u.pn < 3) q(acc, u, wr, wc, fr, fq); else kv(acc, u, wr, wc, fr, fq);
    }
};
struct EpiResX {
    static constexpr bool PERM = true, AFTER_DRAIN = false;
    const bf16_t* xn; const float* xinv; bf16_t* hb; float* ss;
    __device__ __forceinline__ void operator()(const f32x4 (&acc)[2][2][4][2], const Unit& u, int wr, int wc, int fr, int fq) const {
        const int colt = u.pn * BM + wc * 32 + 8 * fq;
        EPI_HALF_BEGIN
            u32x4 xw[4][2]; float xs[4];
            EPI_M { const bf16_t* xp = xn + (size_t)(rbase + 16 * m) * 1024 + colt; xw[m][0] = *(const u32x4*)xp; xw[m][1] = *(const u32x4*)(xp + HALF); xs[m] = xinv[rbase + 16 * m]; }
            EPI_FENCE;
            EPI_M { const int row = rbase + 16 * m; float s = 0.f;
#pragma unroll
                for (int bj = 0; bj < 2; ++bj) {
                    const u32x4 w = xw[m][bj];
                    const f32x4 b0 = {bflo(w.x), bfhi(w.x), bflo(w.y), bfhi(w.y)}, b1 = {bflo(w.z), bfhi(w.z), bflo(w.w), bfhi(w.w)};
                    const f32x4 h0 = b0 * xs[m] + acc[ai][bj][m][0], h1 = b1 * xs[m] + acc[ai][bj][m][1];
                    *(u32x4*)(hb + (size_t)row * 1024 + colt + bj * HALF) = pack8(h0, h1);
                    s += sq8(h0, h1);
                }
                s = red_fq(s); if (fq == 0) atomicAdd(ss + row, s);
            }
        EPI_HALF_END
    }
};
struct EpiResB {
    static constexpr bool PERM = true, AFTER_DRAIN = false;
    bf16_t* hb; float* ss;
    __device__ __forceinline__ void operator()(const f32x4 (&acc)[2][2][4][2], const Unit& u, int wr, int wc, int fr, int fq) const {
        const int colt = u.pn * BM + wc * 32 + 8 * fq;
        EPI_HALF_BEGIN
            u32x4 hw[4][2];
            EPI_M { const bf16_t* hp = hb + (size_t)(rbase + 16 * m) * 1024 + colt; hw[m][0] = *(const u32x4*)hp; hw[m][1] = *(const u32x4*)(hp + HALF); }
            EPI_FENCE;
            EPI_M { const int row = rbase + 16 * m; float s = 0.f;
#pragma unroll
                for (int bj = 0; bj < 2; ++bj) {
                    const u32x4 w = hw[m][bj];
                    const f32x4 b0 = {bflo(w.x), bfhi(w.x), bflo(w.y), bfhi(w.y)}, b1 = {bflo(w.z), bfhi(w.z), bflo(w.w), bfhi(w.w)};
                    const f32x4 h0 = b0 + acc[ai][bj][m][0], h1 = b1 + acc[ai][bj][m][1];
                    *(u32x4*)(hb + (size_t)row * 1024 + colt + bj * HALF) = pack8(h0, h1);
                    s += sq8(h0, h1);
                }
                s = red_fq(s); if (fq == 0) atomicAdd(ss + row, s);
            }
        EPI_HALF_END
    }
};
struct EpiSwiglu {
    static constexpr bool PERM = true, AFTER_DRAIN = false;
    bf16_t* act; const float* ss2;
    __device__ __forceinline__ void operator()(const f32x4 (&acc)[2][2][4][2], const Unit& u, int wr, int wc, int fr, int fq) const {
        const int colt = u.pn * HALF + wc * 32 + 8 * fq;
        EPI_HALF_BEGIN
            float rsv[4];
            EPI_M rsv[m] = ss2[rbase + 16 * m];
            EPI_FENCE;
            EPI_M { const int row = rbase + 16 * m; const float rs = rstd(rsv[m], 1.0f / 1024.0f);
                f32x4 a[2];
#pragma unroll
                for (int n = 0; n < 2; ++n) { const f32x4 g = acc[ai][0][m][n] * rs, w = acc[ai][1][m][n] * rs;
#pragma unroll
                    for (int e = 0; e < 4; ++e) a[n][e] = g[e] * __builtin_amdgcn_rcpf(1.0f + __builtin_amdgcn_exp2f(-1.4426950408889634f * g[e])) * w[e]; }
                *(u32x4*)(act + (size_t)row * 2816 + colt) = pack8(a[0], a[1]);
            }
        EPI_HALF_END
    }
};
struct EpiStore {
    static constexpr bool PERM = true, AFTER_DRAIN = false;
    bf16_t* o;
    __device__ __forceinline__ void operator()(const f32x4 (&acc)[2][2][4][2], const Unit& u, int wr, int wc, int fr, int fq) const {
        const int colt = u.pn * BM + wc * 32 + 8 * fq;
        EPI_HALF_BEGIN
            EPI_M { const int row = rbase + 16 * m;
#pragma unroll
                for (int bj = 0; bj < 2; ++bj) *(u32x4*)(o + (size_t)row * 1024 + colt + bj * HALF) = pack8(acc[ai][bj][m][0], acc[ai][bj][m][1]); }
        EPI_HALF_END
    }
};
struct EpiFinal {
    static constexpr bool PERM = true, AFTER_DRAIN = false;
    float* out; const bf16_t* hb; const bf16_t* proj; const float* ss3;
    __device__ __forceinline__ void operator()(const f32x4 (&acc)[2][2][4][2], const Unit& u, int wr, int wc, int fr, int fq) const {
        const int colt = u.pn * BM + wc * 32 + 8 * fq;
        EPI_HALF_BEGIN
            float rsv[4]; u32x4 hw[4][2], pw[4][2];
            EPI_M { const size_t off = (size_t)(rbase + 16 * m) * 1024 + colt; rsv[m] = ss3[rbase + 16 * m];
                hw[m][0] = *(const u32x4*)(hb + off); hw[m][1] = *(const u32x4*)(hb + off + HALF); pw[m][0] = *(const u32x4*)(proj + off); pw[m][1] = *(const u32x4*)(proj + off + HALF); }
            EPI_FENCE;
            EPI_M { const int row = rbase + 16 * m; const float rs = rstd(rsv[m], 1.0f / 1024.0f);
#pragma unroll
                for (int bj = 0; bj < 2; ++bj) {
                    const size_t off = (size_t)row * 1024 + colt + bj * HALF; const u32x4 pj = pw[m][bj], hv = hw[m][bj];
                    f32x4 h0 = {bflo(hv.x), bfhi(hv.x), bflo(hv.y), bfhi(hv.y)}, h1 = {bflo(hv.z), bfhi(hv.z), bflo(hv.w), bfhi(hv.w)};
                    const float pf[8] = {bflo(pj.x), bfhi(pj.x), bflo(pj.y), bfhi(pj.y), bflo(pj.z), bfhi(pj.z), bflo(pj.w), bfhi(pj.w)};
#pragma unroll
                    for (int e = 0; e < 4; ++e) { const float g0 = acc[ai][bj][m][0][e] * rs, g1 = acc[ai][bj][m][1][e] * rs;
                        h0[e] += pf[e] * __builtin_amdgcn_rcpf(1.0f + __builtin_amdgcn_exp2f(-1.4426950408889634f * g0));
                        h1[e] += pf[4 + e] * __builtin_amdgcn_rcpf(1.0f + __builtin_amdgcn_exp2f(-1.4426950408889634f * g1)); }
                    float* o = out + off; *(f32x4*)o = h0; *(f32x4*)(o + 4) = h1;
                }
            }
        EPI_HALF_END
    }
};

struct EpiNull {
    static constexpr bool PERM = true, AFTER_DRAIN = false;
    __device__ __forceinline__ void operator()(const f32x4 (&acc)[2][2][4][2], const Unit& u, int wr, int wc, int fr, int fq) const {
#pragma unroll
        for (int ai = 0; ai < 2; ++ai)
#pragma unroll
            for (int bj = 0; bj < 2; ++bj)
#pragma unroll
                for (int m = 0; m < 4; ++m) { asm volatile("" :: "v"(acc[ai][bj][m][0]), "v"(acc[ai][bj][m][1])); }
    }
};

template <class Epi, class Sched, bool ALIGN_EPI = false, bool SP2 = false>
__device__ __forceinline__ void gemm_phase(PG8_LAS unsigned char* lds, const Gemm g, const Sched& S, const Epi& E) {
    const int tid = threadIdx.x, wid = __builtin_amdgcn_readfirstlane(tid >> 6), lane = tid & 63, wr = wid >> 2, wc = wid & 3, fr = lane & 15, fq = lane >> 4;
    const int K = g.K, nt = K / BK;
    unsigned voffA[2], voffB[2];
#pragma unroll
    for (int i = 0; i < 2; ++i) { int R, C; stage_rc(tid * 16 + i * 8192, R, C); const int Rb = Epi::PERM ? ((R & ~31) + perm32(R & 31)) : R;
        voffA[i] = (unsigned)(R * g.lda + C) * 2u; voffB[i] = (unsigned)(Rb * K + C) * 2u; }
    const size_t kstep = (size_t)(BK * 2);
    const size_t hstepA = (size_t)HALF * g.lda * 2, hstepB = (size_t)HALF * K * 2;
    const size_t tstepA = 2 * hstepA, tstepB = 2 * hstepB;
    const unsigned ldsw = (unsigned)wid * 1024u;
    const int aoff = lds_byte(wr * 64 + fr, fq * 8), boff = lds_byte(wc * 32 + fr, fq * 8);
#define PG8_SA(b, h) (((b) * 2 + (h)) * HTB)
#define PG8_SB(b, h) ((4 + (b) * 2 + (h)) * HTB)
#define PG8_STAGE(bufoff, gbase, voff) do { _Pragma("unroll") for (int _i = 0; _i < 2; ++_i) \
        __builtin_amdgcn_global_load_lds((const unsigned*)((const char*)(gbase) + (voff)[_i]), (PG8_LAS unsigned*)(lds + (bufoff) + ldsw + _i * 8192), 16, 0, 0); } while (0)
#define PG8_LDA(dst, b, h) do { _Pragma("unroll") for (int m = 0; m < 4; ++m) _Pragma("unroll") for (int k = 0; k < 2; ++k) dst[m][k] = *(const PG8_LAS bf16x8*)(lds + PG8_SA(b, h) + aoff + m * 2048 + k * 1024); } while (0)
#define PG8_LDB(dst, b, h) do { _Pragma("unroll") for (int n = 0; n < 2; ++n) _Pragma("unroll") for (int k = 0; k < 2; ++k) dst[n][k] = *(const PG8_LAS bf16x8*)(lds + PG8_SB(b, h) + boff + n * 2048 + k * 1024); } while (0)
#define PG8_MMA(ai, bj, At, Bt) do { __builtin_amdgcn_s_setprio(1); _Pragma("unroll") for (int m = 0; m < 4; ++m) _Pragma("unroll") for (int n = 0; n < 2; ++n) _Pragma("unroll") for (int k = 0; k < 2; ++k) \
        acc[ai][bj][m][n] = __builtin_amdgcn_mfma_f32_16x16x32_bf16(Bt[n][k], At[m][k], acc[ai][bj][m][n], 0, 0, 0); __builtin_amdgcn_s_setprio(0); } while (0)
#define PG8_WAIT_V(n) asm volatile("s_waitcnt vmcnt(" #n ")" ::: "memory")
#define PG8_WAIT_L(n) asm volatile("s_waitcnt lgkmcnt(" #n ")" ::: "memory")
#define PG8_BAR __builtin_amdgcn_s_barrier()
#define PG8_SCHED __builtin_amdgcn_sched_barrier(0)
    Unit cur, nxt; int ui = 0;
    if (!S.next(0, cur)) return;
    f32x4 acc[2][2][4][2];
#pragma unroll
    for (int a = 0; a < 2; ++a)
#pragma unroll
        for (int b = 0; b < 2; ++b)
#pragma unroll
            for (int m = 0; m < 4; ++m)
#pragma unroll
                for (int n = 0; n < 2; ++n) acc[a][b][m][n] = (f32x4){0.f, 0.f, 0.f, 0.f};
    bf16x8 At[4][2], B0[2][2], B1[2][2];
    const char* cA = (const char*)(cur.pn < g.nsplit ? g.A : g.A2) + (size_t)cur.pm * tstepA; const char* cB = (const char*)g.Bt + (size_t)cur.pn * tstepB;
    S.a_ready(cur);
    if constexpr (SP2) {
        PG8_STAGE(PG8_SB(0, 0), cB, voffB); PG8_STAGE(PG8_SB(0, 1), cB + hstepB, voffB); PG8_STAGE(PG8_SA(0, 0), cA, voffA); PG8_STAGE(PG8_SA(0, 1), cA + hstepA, voffA);
        if (wr == 1) PG8_BAR;
        PG8_WAIT_V(2); PG8_BAR;
        PG8_STAGE(PG8_SB(1, 0), cB + kstep, voffB); PG8_STAGE(PG8_SA(1, 0), cA + kstep, voffA); PG8_STAGE(PG8_SB(1, 1), cB + hstepB + kstep, voffB);
        PG8_WAIT_V(6); PG8_BAR;
    } else {
        PG8_STAGE(PG8_SB(0, 0), cB, voffB); PG8_STAGE(PG8_SA(0, 0), cA, voffA); PG8_STAGE(PG8_SB(0, 1), cB + hstepB, voffB); PG8_STAGE(PG8_SA(0, 1), cA + hstepA, voffA);
        if (wr == 1) PG8_BAR;
        PG8_WAIT_V(4); PG8_BAR;
        PG8_STAGE(PG8_SB(1, 0), cB + kstep, voffB); PG8_STAGE(PG8_SA(1, 0), cA + kstep, voffA); PG8_STAGE(PG8_SB(1, 1), cB + hstepB + kstep, voffB);
        PG8_WAIT_V(6); PG8_BAR;
    }
    for (;;) {
        const bool has_next = S.next(ui + 1, nxt);
        const char* nA = has_next ? (const char*)(nxt.pn < g.nsplit ? g.A : g.A2) + (size_t)nxt.pm * tstepA : cA; const char* nB = has_next ? (const char*)g.Bt + (size_t)nxt.pn * tstepB : cB;
#pragma nounroll
        for (int t = 0; t < nt; t += 2) {
            const bool last = (t == nt - 2);
            const char* a1 = cA + (size_t)(t + 1) * kstep;
            const char* a2 = last ? nA : cA + (size_t)(t + 2) * kstep; const char* b2 = last ? nB : cB + (size_t)(t + 2) * kstep;
            const char* a3 = a2 + kstep; const char* b3 = b2 + kstep;
            if (last && has_next) S.a_ready(nxt);
            if constexpr (SP2) {
            PG8_LDB(B0, 0, 0); PG8_LDB(B1, 0, 1); PG8_SCHED; PG8_LDA(At, 0, 0); PG8_STAGE(PG8_SA(1, 1), a1 + hstepA, voffA);
            PG8_WAIT_V(8); PG8_WAIT_L(0); PG8_BAR; PG8_MMA(0, 0, At, B0); PG8_MMA(0, 1, At, B1); PG8_BAR; PG8_SCHED;
            PG8_LDA(At, 0, 1); PG8_STAGE(PG8_SB(0, 0), b2, voffB); PG8_STAGE(PG8_SB(0, 1), b2 + hstepB, voffB); PG8_STAGE(PG8_SA(0, 0), a2, voffA);
            PG8_WAIT_V(8); PG8_WAIT_L(0); PG8_BAR; PG8_MMA(1, 0, At, B0); PG8_MMA(1, 1, At, B1); PG8_BAR; PG8_SCHED;
            PG8_LDB(B0, 1, 0); PG8_LDB(B1, 1, 1); PG8_SCHED; PG8_LDA(At, 1, 0); PG8_STAGE(PG8_SA(0, 1), a2 + hstepA, voffA);
            PG8_WAIT_V(8); PG8_WAIT_L(0); PG8_BAR; PG8_MMA(0, 0, At, B0); PG8_MMA(0, 1, At, B1); PG8_BAR; PG8_SCHED;
            PG8_LDA(At, 1, 1); PG8_STAGE(PG8_SB(1, 0), b3, voffB); PG8_STAGE(PG8_SB(1, 1), b3 + hstepB, voffB); PG8_STAGE(PG8_SA(1, 0), a3, voffA);
            PG8_WAIT_V(8); PG8_WAIT_L(0); PG8_BAR; PG8_MMA(1, 0, At, B0); PG8_MMA(1, 1, At, B1); PG8_BAR; PG8_SCHED;
            } else {
            PG8_LDB(B0, 0, 0); PG8_SCHED; PG8_LDA(At, 0, 0); PG8_STAGE(PG8_SA(1, 1), a1 + hstepA, voffA);
            PG8_WAIT_L(8); PG8_BAR; PG8_WAIT_L(0); PG8_MMA(0, 0, At, B0); PG8_BAR; PG8_SCHED;
            PG8_LDB(B1, 0, 1); PG8_STAGE(PG8_SB(0, 0), b2, voffB);
            PG8_BAR; PG8_WAIT_L(0); PG8_MMA(0, 1, At, B1); PG8_BAR;
            PG8_LDA(At, 0, 1); PG8_STAGE(PG8_SA(0, 0), a2, voffA);
            PG8_BAR; PG8_WAIT_L(0); PG8_MMA(1, 0, At, B0); PG8_BAR; PG8_SCHED;
            PG8_STAGE(PG8_SB(0, 1), b2 + hstepB, voffB);
            PG8_WAIT_V(6); PG8_BAR; PG8_MMA(1, 1, At, B1); PG8_BAR;
            PG8_LDB(B0, 1, 0); PG8_SCHED; PG8_LDA(At, 1, 0); PG8_STAGE(PG8_SA(0, 1), a2 + hstepA, voffA);
            PG8_WAIT_L(8); PG8_BAR; PG8_WAIT_L(0); PG8_MMA(0, 0, At, B0); PG8_BAR; PG8_SCHED;
            PG8_LDB(B1, 1, 1); PG8_STAGE(PG8_SB(1, 0), b3, voffB);
            PG8_BAR; PG8_WAIT_L(0); PG8_MMA(0, 1, At, B1); PG8_BAR;
            PG8_LDA(At, 1, 1); PG8_STAGE(PG8_SA(1, 0), a3, voffA);
            PG8_BAR; PG8_WAIT_L(0); PG8_MMA(1, 0, At, B0); PG8_BAR; PG8_SCHED;
            PG8_STAGE(PG8_SB(1, 1), b3 + hstepB, voffB);
            PG8_WAIT_V(6); PG8_BAR; PG8_MMA(1, 1, At, B1); PG8_BAR;
            }
        }
        if constexpr (ALIGN_EPI) { if (wr == 0) PG8_BAR; }
        if constexpr (!Epi::AFTER_DRAIN) { E(acc, cur, wr, wc, fr, fq); S.done(cur); }
        if (!has_next) break;
#pragma unroll
        for (int a = 0; a < 2; ++a)
#pragma unroll
            for (int b = 0; b < 2; ++b)
#pragma unroll
                for (int m = 0; m < 4; ++m)
#pragma unroll
                    for (int n = 0; n < 2; ++n) acc[a][b][m][n] = (f32x4){0.f, 0.f, 0.f, 0.f};
        cur = nxt; cA = nA; cB = nB; ++ui;
        if constexpr (ALIGN_EPI) { if (wr == 1) PG8_BAR; }
    }
    PG8_WAIT_V(0);
    if constexpr (!ALIGN_EPI) { if (wr == 0) PG8_BAR; }
    PG8_BAR;
    if constexpr (Epi::AFTER_DRAIN) { E.fused(acc, cur, wr, wc, fr, fq, lds, wid, lane); S.done(cur); }
#undef PG8_SA
#undef PG8_SB
#undef PG8_STAGE
#undef PG8_LDA
#undef PG8_LDB
#undef PG8_MMA
#undef PG8_WAIT_V
#undef PG8_WAIT_L
#undef PG8_BAR
#undef PG8_SCHED
}
}

namespace att {
using bf16x8 = __attribute__((ext_vector_type(8))) short;
using s16x4  = __attribute__((ext_vector_type(4))) short;
using f32x16 = __attribute__((ext_vector_type(16))) float;
using f32x4  = __attribute__((ext_vector_type(4))) float;
using u32x4  = __attribute__((ext_vector_type(4))) unsigned;
typedef unsigned short bf16_t;
typedef __attribute__((address_space(3))) char LCH;
typedef __attribute__((address_space(3))) float LFL;
constexpr int NW = 8, QBLK = 32, KVBLK = 64, DQK = 96, DV = 64, SEQ = 2048, MROWS = 49152;
constexpr float SCALE = 0.10206207261596577f;
constexpr float THR = 8.f;
constexpr int KROW = 208;
constexpr int SHM_V = KVBLK * DV * 2, SHM_K = KVBLK * KROW, NSTG = 4, SHM_ATTN = NSTG * SHM_V + NSTG * SHM_K + NW * 64 * 4;
#define SBAR() __builtin_amdgcn_sched_barrier(0)
__device__ __forceinline__ int crow(int r, int hi) { return (r & 3) + 8 * (r >> 2) + 4 * hi; }
__device__ __forceinline__ unsigned cvtpk(float lo, float hi) { unsigned r; asm volatile("v_cvt_pk_bf16_f32 %0, %1, %2" : "=v"(r) : "v"(lo), "v"(hi)); return r; }
__device__ __forceinline__ float bflo(unsigned w) { return __uint_as_float(w << 16); }
__device__ __forceinline__ float bfhi(unsigned w) { return __uint_as_float(w & 0xffff0000u); }

constexpr float THRL = 8.f;
__device__ __forceinline__ void partialSM(f32x16& p0, f32x16& p1, float& mhat, float& alpha, f32x16* o, LFL* al_l, int r32, int hi) {
  float pmax;
  {
#define MX3(a, b, c) __builtin_fmaxf(__builtin_fmaxf((a), (b)), (c))
    const float a0 = MX3(p0[0], p0[1], p0[2]), a1 = MX3(p0[3], p0[4], p0[5]), a2 = MX3(p0[6], p0[7], p0[8]), a3 = MX3(p0[9], p0[10], p0[11]), a4 = MX3(p0[12], p0[13], p0[14]);
    const float a5 = MX3(p1[0], p1[1], p1[2]), a6 = MX3(p1[3], p1[4], p1[5]), a7 = MX3(p1[6], p1[7], p1[8]), a8 = MX3(p1[9], p1[10], p1[11]), a9 = MX3(p1[12], p1[13], p1[14]);
    const float b0 = MX3(a0, a1, a2), b1 = MX3(a3, a4, a5), b2 = MX3(a6, a7, a8), b3 = MX3(a9, p0[15], p1[15]);
    pmax = __builtin_fmaxf(__builtin_fmaxf(b0, b1), __builtin_fmaxf(b2, b3));
#undef MX3
  }
  { auto rr = __builtin_amdgcn_permlane32_swap(__float_as_uint(pmax), __float_as_uint(pmax), false, false);
    pmax = fmaxf(__uint_as_float(rr[0]), __uint_as_float(rr[1])); }
  f32x16 e0;
#pragma unroll
  for (int r = 0; r < 16; ++r) e0[r] = __builtin_amdgcn_exp2f(p0[r]);
  alpha = 1.f;
  if (__builtin_expect(__any(pmax > THRL), 0)) {
    const float dl = fmaxf(pmax, 0.f); mhat += dl;
#pragma unroll
    for (int r = 0; r < 16; ++r) { p1[r] -= dl; e0[r] = __builtin_amdgcn_exp2f(p0[r] - dl); }
    alpha = __builtin_amdgcn_exp2f(-dl);
    if (hi == 0) al_l[r32] = alpha; asm volatile("s_waitcnt lgkmcnt(0)" ::: "memory");
#pragma unroll
    for (int d = 0; d < 2; ++d)
#pragma unroll
      for (int r = 0; r < 16; ++r) o[d][r] *= al_l[crow(r, hi)];
  }
  p0 = e0;
}
__device__ __forceinline__ void finishSM(f32x16& p0, f32x16& p1, float alpha, float& l_reg, bf16x8& pa0, bf16x8& pa1, bf16x8& pa2, bf16x8& pa3) {
#pragma unroll
  for (int r = 0; r < 16; ++r) p1[r] = __builtin_amdgcn_exp2f(p1[r]);
  float ps;
  { float s0 = p0[0] + p0[1], s1 = p0[2] + p0[3], s2 = p1[0] + p1[1], s3 = p1[2] + p1[3];
#pragma unroll
    for (int r = 4; r < 16; r += 4) { s0 += p0[r] + p0[r + 1]; s1 += p0[r + 2] + p0[r + 3]; s2 += p1[r] + p1[r + 1]; s3 += p1[r + 2] + p1[r + 3]; }
    ps = (s0 + s1) + (s2 + s3); }
  l_reg = l_reg * alpha + ps;
#define PK4(P, BASE, OUT) do { u32x4 w = {cvtpk(P[BASE + 0], P[BASE + 1]), cvtpk(P[BASE + 2], P[BASE + 3]), cvtpk(P[BASE + 4], P[BASE + 5]), cvtpk(P[BASE + 6], P[BASE + 7])}; OUT = *reinterpret_cast<bf16x8*>(&w); } while (0)
  PK4(p0, 0, pa0); PK4(p0, 8, pa1); PK4(p1, 0, pa2); PK4(p1, 8, pa3);
#undef PK4
}
template <int VAR = 0> __device__ __forceinline__ void qkt(f32x16& p0, f32x16& p1, const LCH* Ks, const bf16x8* qr, float nm, int r32, int hi) {
#pragma unroll
  for (int r = 0; r < 16; ++r) { p0[r] = nm; p1[r] = nm; }
  if (VAR == 5) {
#pragma unroll
    for (int d0 = 0; d0 < 6; ++d0) { p0 = __builtin_amdgcn_mfma_f32_32x32x16_bf16(qr[5 - d0], qr[d0], p0, 0, 0, 0); p1 = __builtin_amdgcn_mfma_f32_32x32x16_bf16(qr[(d0 + 1) % 6], qr[d0], p1, 0, 0, 0); }
    return; }
#pragma unroll
  for (int d0 = 0; d0 < 6; ++d0) { const int cb = (d0 * 16 + hi * 8) * 2;
    const bf16x8 b0 = *(const __attribute__((address_space(3))) bf16x8*)(Ks + r32 * KROW + cb);
    const bf16x8 b1 = *(const __attribute__((address_space(3))) bf16x8*)(Ks + (32 + r32) * KROW + cb);
    p0 = __builtin_amdgcn_mfma_f32_32x32x16_bf16(b0, qr[d0], p0, 0, 0, 0);
    p1 = __builtin_amdgcn_mfma_f32_32x32x16_bf16(b1, qr[d0], p1, 0, 0, 0); }
}
__device__ __forceinline__ int v_st(int k, int c) { const int kk = k; return ((kk >> 3) * 2 + (c >> 5)) * 512 + ((kk & 7) * 32 + (c & 31)) * 2; }
__device__ __forceinline__ int v_rd_base(int lane) { return ((lane & 3) << 3) | (((lane >> 2) & 3) << 6) | (((lane >> 4) & 1) << 5) | (((lane >> 5) & 1) << 8); }
constexpr int v_rd_off(int d0, int ks, int half) { return d0 * 512 + ks * 2048 + half * 1024; }
typedef short v4i16_t __attribute__((ext_vector_type(4)));
__device__ __forceinline__ s16x4 vtr(const LCH* p) { return __builtin_bit_cast(s16x4, __builtin_amdgcn_ds_read_tr16_b64_v4i16((__attribute__((address_space(3))) v4i16_t*)p)); }
template <int VAR = 0> __device__ __forceinline__ void pv_d0(f32x16* o, const LCH* vb, bf16x8 pa0, bf16x8 pa1, bf16x8 pa2, bf16x8 pa3) {
  if (VAR == 5) { o[0] = __builtin_amdgcn_mfma_f32_32x32x16_bf16(pa0, pa1, o[0], 0, 0, 0); o[1] = __builtin_amdgcn_mfma_f32_32x32x16_bf16(pa0, pa2, o[1], 0, 0, 0); o[0] = __builtin_amdgcn_mfma_f32_32x32x16_bf16(pa1, pa3, o[0], 0, 0, 0); o[1] = __builtin_amdgcn_mfma_f32_32x32x16_bf16(pa1, pa0, o[1], 0, 0, 0);
    o[0] = __builtin_amdgcn_mfma_f32_32x32x16_bf16(pa2, pa1, o[0], 0, 0, 0); o[1] = __builtin_amdgcn_mfma_f32_32x32x16_bf16(pa2, pa3, o[1], 0, 0, 0); o[0] = __builtin_amdgcn_mfma_f32_32x32x16_bf16(pa3, pa0, o[0], 0, 0, 0); o[1] = __builtin_amdgcn_mfma_f32_32x32x16_bf16(pa3, pa2, o[1], 0, 0, 0); return; }
#define PK(L, H) (bf16x8){L[0], L[1], L[2], L[3], H[0], H[1], H[2], H[3]}
#define PVSTEP(ks, pa) do { const s16x4 l0 = vtr(vb + v_rd_off(0, ks, 0)), h0 = vtr(vb + v_rd_off(0, ks, 1)), l1 = vtr(vb + v_rd_off(1, ks, 0)), h1 = vtr(vb + v_rd_off(1, ks, 1)); \
    o[0] = __builtin_amdgcn_mfma_f32_32x32x16_bf16(pa, PK(l0, h0), o[0], 0, 0, 0); o[1] = __builtin_amdgcn_mfma_f32_32x32x16_bf16(pa, PK(l1, h1), o[1], 0, 0, 0); } while (0)
  PVSTEP(0, pa0); PVSTEP(1, pa1); PVSTEP(2, pa2); PVSTEP(3, pa3);
#undef PVSTEP
#undef PK
}
struct AttnArgs { const bf16_t* Q; const bf16_t* K; const bf16_t* V; const float* ss_q; const float* hss; const float* qn_g; const float* tab; bf16_t* Y; };
template <int VAR> __device__ __forceinline__ void attn_phase(const AttnArgs& A, int vcu, int G, LCH* lds, int flags) {
  const int tid = threadIdx.x, wid = tid >> 6, lane = tid & 63, r32 = lane & 31, hi = lane >> 5;
  LCH* V_lds = lds; LCH* K_lds = lds + NSTG * SHM_V;
  LFL* ws = (LFL*)(lds + NSTG * SHM_V + NSTG * SHM_K) + wid * 64; LFL* li_l = ws; LFL* al_l = ws + 32;
  const int kc0 = tid, kc1 = tid < 256 ? tid + 512 : tid; const bool k2 = tid < 256;
  const int kr0 = kc0 / 12, kch0 = kc0 - 12 * kr0, kr1 = kc1 / 12, kch1 = kc1 - 12 * kr1;
  const int kg0 = kr0 * DQK + kch0 * 8, kg1 = kr1 * DQK + kch1 * 8, kl0 = kr0 * KROW + kch0 * 16, kl1 = kr1 * KROW + kch1 * 16;
  const int vk = tid >> 3, vc = (tid & 7) * 8, vg = vk * DV + vc, vl = v_st(vk, vc);
  const LCH* vb0 = V_lds + v_rd_base(lane);
  struct { bf16x8 v, k0, k1; } sr_;
  const bf16_t* Kh; const bf16_t* Vh;
#define SLOAD(key0) do { sr_.v = *reinterpret_cast<const bf16x8*>(Vh + (size_t)(key0) * DV + vg); sr_.k0 = *reinterpret_cast<const bf16x8*>(Kh + (size_t)(key0) * DQK + kg0); \
    sr_.k1 = *reinterpret_cast<const bf16x8*>(Kh + (size_t)(key0) * DQK + kg1); } while (0)
#define SWRITE(st) do { *(__attribute__((address_space(3))) bf16x8*)(V_lds + (st) * SHM_V + vl) = sr_.v; *(__attribute__((address_space(3))) bf16x8*)(K_lds + (st) * SHM_K + kl0) = sr_.k0; if (k2) *(__attribute__((address_space(3))) bf16x8*)(K_lds + (st) * SHM_K + kl1) = sr_.k1; } while (0)
  float ssq_, hss_;
#define PREFETCH(uu) do { const int bh_ = (uu) >> 3, b_ = bh_ >> 3, h_ = bh_ & 7, t_ = ((uu) & 7) * 256 + wid * QBLK + r32; const size_t mrow_ = (size_t)b_ * SEQ + t_; \
    ssq_ = A.ss_q[mrow_]; hss_ = A.hss[(size_t)h_ * MROWS + mrow_]; \
    Kh = A.K + (size_t)bh_ * SEQ * DQK; Vh = A.V + (size_t)bh_ * SEQ * DV; SLOAD(0); } while (0)
#define RESC(a) do { if (__any((a) < 1.f)) { if (hi == 0) al_l[r32] = (a); asm volatile("s_waitcnt lgkmcnt(0)" ::: "memory"); \
    _Pragma("unroll") for (int d = 0; d < 2; ++d) _Pragma("unroll") for (int r = 0; r < 16; ++r) o[d][r] *= al_l[crow(r, hi)]; } } while (0)
  int u = vcu; if (u >= 1536) return;
  PREFETCH(u);
  for (;;) {
  const int bh = u >> 3, b = bh >> 3, h = bh & 7, q0 = (u & 7) * 256;
  u32x4 qw[6]; { const bf16_t* Qw_ = A.Q + ((size_t)bh * SEQ + q0 + wid * QBLK + r32) * DQK + hi * 8;
#pragma unroll
    for (int d0 = 0; d0 < 6; ++d0) qw[d0] = *reinterpret_cast<const u32x4*>(Qw_ + d0 * 16); }
  float mhat = 0.f, l_reg = 0; f32x16 o[2] = {}; bf16x8 qr[6];
  {
    const float rq = 1.0f / sqrtf(ssq_ * (1.0f / 384.0f) + 1e-6f);
    const float sq = (SCALE * 1.4426950408889634f) * rq / sqrtf(hss_ * rq * rq * (1.0f / 96.0f) + 1e-6f);
#pragma unroll
    for (int d0 = 0; d0 < 4; ++d0) {
      const u32x4 w = qw[d0];
      const f32x4 g0 = *reinterpret_cast<const f32x4*>(A.qn_g + d0 * 16 + hi * 8), g1 = *reinterpret_cast<const f32x4*>(A.qn_g + d0 * 16 + hi * 8 + 4);
      u32x4 o4; o4.x = cvtpk(bflo(w.x) * g0[0] * sq, bfhi(w.x) * g0[1] * sq); o4.y = cvtpk(bflo(w.y) * g0[2] * sq, bfhi(w.y) * g0[3] * sq);
      o4.z = cvtpk(bflo(w.z) * g1[0] * sq, bfhi(w.z) * g1[1] * sq); o4.w = cvtpk(bflo(w.w) * g1[2] * sq, bfhi(w.w) * g1[3] * sq);
      qr[d0] = *reinterpret_cast<bf16x8*>(&o4);
    }
#pragma unroll
    for (int d0 = 4; d0 < 6; ++d0) {
      const u32x4 w = qw[d0];
      const int i0 = 8 * (d0 - 4) + 4 * hi;
      const f32x4 g1 = *reinterpret_cast<const f32x4*>(A.qn_g + 64 + i0), g2 = *reinterpret_cast<const f32x4*>(A.qn_g + 80 + i0);
      const float* tb = A.tab + ((size_t)(q0 + wid * QBLK + r32) * 16 + i0) * 2; const f32x4 cs0 = *reinterpret_cast<const f32x4*>(tb), cs1 = *reinterpret_cast<const f32x4*>(tb + 4);
      const unsigned ww[4] = {w.x, w.y, w.z, w.w}; const float cc[4] = {cs0[0], cs0[2], cs1[0], cs1[2]}, sn[4] = {cs0[1], cs0[3], cs1[1], cs1[3]};
      unsigned ow[4];
#pragma unroll
      for (int jj = 0; jj < 4; ++jj) { const float a = bflo(ww[jj]) * g1[jj] * sq, bb = bfhi(ww[jj]) * g2[jj] * sq; ow[jj] = cvtpk(a * cc[jj] - bb * sn[jj], a * sn[jj] + bb * cc[jj]); }
      u32x4 o4 = {ow[0], ow[1], ow[2], ow[3]}; qr[d0] = *reinterpret_cast<bf16x8*>(&o4);
    }
  }
  f32x16 pA0, pA1, pB0, pB1; float alA, alB; bf16x8 pa0, pa1, pa2, pa3; const int NT = (flags & 16) ? SEQ / KVBLK / 2 : SEQ / KVBLK;
  SWRITE(0); SLOAD(KVBLK); __syncthreads();
  qkt(pA0, pA1, K_lds, qr, -mhat, r32, hi); partialSM(pA0, pA1, mhat, alA, o, al_l, r32, hi);
  SWRITE(1); SLOAD(2 * KVBLK); __syncthreads();
#define XPART(PC0, PC1, PP0, PP1, alP_, j_) do { \
    if (VAR != 4) { if ((j_) + 1 < NT) SWRITE(((j_) + 1) & 3); if ((j_) + 2 < NT) SLOAD(((j_) + 2) * KVBLK); } SBAR(); \
    if (VAR == 7 && wid >= 4) { asm volatile("" : "+v"(PC0), "+v"(PC1)); } else if (VAR != 3) qkt<VAR>(PC0, PC1, K_lds + ((j_) & 3) * SHM_K, qr, -mhat, r32, hi); else { asm volatile("" : "+v"(PC0), "+v"(PC1)); } \
    if (VAR == 7 && wid >= 4) { asm volatile("" : "+v"(pa0), "+v"(pa1), "+v"(pa2), "+v"(pa3)); } else if (VAR != 1) finishSM(PP0, PP1, alP_, l_reg, pa0, pa1, pa2, pa3); else { asm volatile("" : "+v"(PP0), "+v"(PP1)); asm volatile("" : "+v"(pa0), "+v"(pa1), "+v"(pa2), "+v"(pa3)); } SBAR(); } while (0)
#define YPART(PC0, PC1, alC_, j_) do { \
    if (VAR == 7 && wid >= 4) { asm volatile("" : "+v"(o[0]), "+v"(o[1])); } else if (VAR != 2) pv_d0<VAR>(o, vb0 + (((j_) - 1) & 3) * SHM_V, pa0, pa1, pa2, pa3); else { asm volatile("" : "+v"(o[0]), "+v"(o[1])); } \
    if (VAR == 7 && wid >= 4) { alC_ = 1.f; } else if (VAR != 1) { partialSM(PC0, PC1, mhat, alC_, o, al_l, r32, hi); } else { asm volatile("" : "+v"(PC0), "+v"(PC1)); alC_ = 1.f; } } while (0)
#define LOOPBAR() do { if (VAR != 6) __syncthreads(); } while (0)
  if (wid < 4) {
    for (int j = 1; j + 1 < NT; j += 2) {
      XPART(pB0, pB1, pA0, pA1, alA, j); YPART(pB0, pB1, alB, j); LOOPBAR();
      XPART(pA0, pA1, pB0, pB1, alB, j + 1); YPART(pA0, pA1, alA, j + 1); LOOPBAR();
    }
    XPART(pB0, pB1, pA0, pA1, alA, NT - 1); YPART(pB0, pB1, alB, NT - 1); LOOPBAR();
  } else {
    for (int j = 1; j + 1 < NT; j += 2) {
      XPART(pB0, pB1, pA0, pA1, alA, j); LOOPBAR(); YPART(pB0, pB1, alB, j);
      XPART(pA0, pA1, pB0, pB1, alB, j + 1); LOOPBAR(); YPART(pA0, pA1, alA, j + 1);
    }
    XPART(pB0, pB1, pA0, pA1, alA, NT - 1); LOOPBAR(); YPART(pB0, pB1, alB, NT - 1);
  }
#undef LOOPBAR
#undef XPART
#undef YPART
  finishSM(pB0, pB1, alB, l_reg, pa0, pa1, pa2, pa3); SBAR();
  pv_d0(o, vb0 + ((NT - 1) & 3) * SHM_V, pa0, pa1, pa2, pa3);
  const int un = u + G; bf16_t* Yw = A.Y + ((size_t)b * SEQ + q0 + wid * QBLK) * 1024 + 512 + h * DV;
  if (un < 1536) PREFETCH(un);
  { auto rr = __builtin_amdgcn_permlane32_swap(__float_as_uint(l_reg), __float_as_uint(l_reg), false, false); l_reg = __uint_as_float(rr[0]) + __uint_as_float(rr[1]); }
  if (hi == 0) li_l[r32] = l_reg; asm volatile("s_waitcnt lgkmcnt(0)" ::: "memory");
  float rli[16];
#pragma unroll
  for (int r = 0; r < 16; ++r) rli[r] = __builtin_amdgcn_rcpf(li_l[crow(r, hi)]);
#pragma unroll
  for (int r = 0; r < 16; ++r) { const int orow = crow(r, hi);
#pragma unroll
    for (int d0 = 0; d0 < 2; ++d0) { const unsigned pk = cvtpk(o[d0][r] * rli[r], 0.f); Yw[(size_t)orow * 1024 + d0 * 32 + r32] = (bf16_t)(pk & 0xffffu); } }
  __syncthreads();
  if (un >= 1536) break;
  u = un;
  }
#undef SLOAD
#undef SWRITE
#undef PREFETCH
#undef RESC
}
#undef SBAR
}

constexpr int NWAVES = 8;
constexpr int M = 49152, DM = 1024, SEQL = 2048, MPR = 32768, NPH = 9;
constexpr size_t MiB = 1u << 20;
constexpr size_t WS_CTL = 0, CTL_ZERO_BYTES = 1 * MiB;
constexpr size_t WS_TAB = 1 * MiB;
constexpr size_t WS_SSZ = 2 * MiB, SSZ_BYTES = 13 * (size_t)M * 4;
constexpr size_t WS_SS1 = 5 * MiB;
constexpr size_t WS_KRR = 6 * MiB;
constexpr size_t WS_WIN = 12 * MiB, WS_WQB = WS_WIN + 1280 * 1024 * 2, WS_WKVB = WS_WQB + 768 * 384 * 2, WS_WO = 16 * MiB, WS_WGU = 18 * MiB, WS_WD = 29 * MiB, WS_WPG = 35 * MiB, WS_WPP = 37 * MiB;
constexpr size_t WS_PB = 40 * MiB;
constexpr size_t WS_Z = 64 * MiB;
constexpr size_t WS_XB = 184 * MiB;
constexpr size_t WS_Q = 184 * MiB, WS_K = 256 * MiB, WS_V = 328 * MiB, WS_Y = 376 * MiB;
constexpr size_t WS_HB = 64 * MiB;
constexpr size_t WS_ACT = 184 * MiB;
constexpr size_t WS_PROJ = 184 * MiB;
constexpr size_t WS_END = 472 * MiB;
static_assert(WS_WKVB + 1024 * 256 * 2 <= WS_WO && WS_WGU + (size_t)5632 * 1024 * 2 <= WS_WD && WS_WD + (size_t)1024 * 2816 * 2 <= WS_WPG && WS_WPP + 1024 * 256 * 2 <= WS_PB, "weight map");
static_assert(WS_SSZ + SSZ_BYTES <= WS_SS1 && WS_SS1 + 2 * (size_t)M * 4 <= WS_KRR && WS_KRR + (size_t)M * 32 * 4 <= WS_WIN, "small arrays map");
constexpr int CW_TMO = 0, CW_BAR = 4096;
constexpr int RING_OFF = 0, RING_BYTES = 131072, LDSCTL_OFF = RING_BYTES, MISC_OFF = LDSCTL_OFF + 320, LDS_BYTES = 147456;

#define GAS __attribute__((address_space(1)))
#define LAS __attribute__((address_space(3)))
typedef unsigned short bf16;
typedef unsigned v4u __attribute__((ext_vector_type(4)));
typedef float f32x4 __attribute__((ext_vector_type(4)));
typedef GAS unsigned gu32;
#define RLX_AGENT __ATOMIC_RELAXED, __HIP_MEMORY_SCOPE_AGENT
#define LDS_WAIT() asm volatile("s_waitcnt lgkmcnt(0)" ::: "memory")
#define VM_WAIT() asm volatile("s_waitcnt vmcnt(0)" ::: "memory")
__device__ __forceinline__ unsigned f2bf(float f) { unsigned u = __builtin_bit_cast(unsigned, f); return (u + 0x7fffu + ((u >> 16) & 1u)) >> 16; }
__device__ __forceinline__ unsigned pk2(float lo, float hi) { return f2bf(lo) | (f2bf(hi) << 16); }

#define XB_TMO      128
#define XB_XCNT(j)  (256  + 64 * (j))
#define XB_XSUB(j)  (1280 + 64 * (j))
#define XB_XGEN(j)  (2304 + 64 * (j))
#define XB_TOP      3328
#define XB_TOPGEN   3392
#define XCD_BAR_WORDS 3456
#define XB_SPIN_CAP (1u << 18)

__device__ __forceinline__ unsigned xb_ld(unsigned* p)              { return __hip_atomic_load(p, __ATOMIC_RELAXED, __HIP_MEMORY_SCOPE_AGENT); }
__device__ __forceinline__ unsigned xb_add(unsigned* p, unsigned v) { return __hip_atomic_fetch_add(p, v, __ATOMIC_RELAXED, __HIP_MEMORY_SCOPE_AGENT); }
__device__ __forceinline__ unsigned xb_xcc_id() { return (unsigned)__builtin_amdgcn_s_getreg((3 << 11) | 20) & 0xFu; }
#define XB_SPIN(cond, bar) do { unsigned _sp = 0; while (cond) { __builtin_amdgcn_s_sleep(1); \
    if ((++_sp & 255u) == 0u) { if (xb_ld(&(bar)[XB_TMO])) break; if (_sp > XB_SPIN_CAP) { atomicAdd(&(bar)[XB_TMO], 1u); break; } } } } while (0)

struct XcdBarrier {
    unsigned* bar; unsigned x;
    volatile LAS unsigned* st;
};

__device__ __forceinline__ XcdBarrier xcd_barrier_post(unsigned* bar, volatile LAS unsigned* st) {
    XcdBarrier b; b.bar = bar; b.x = xb_xcc_id(); b.st = st;
    if (threadIdx.x == 0) (void)xb_add(&bar[XB_XCNT(b.x)], 1u);
    return b;
}
__device__ __forceinline__ void xcd_barrier_complete(unsigned* bar, unsigned x, unsigned& nloc, unsigned& nx) {
    const unsigned G = gridDim.x * gridDim.y * gridDim.z;
    unsigned sum, cnt, mine, sp = 0u;
    for (;;) {
        sum = 0u; cnt = 0u; mine = 0u;
#pragma unroll
        for (unsigned j = 0; j < 16; ++j) { const unsigned c = xb_ld(&bar[XB_XCNT(j)]); sum += c; cnt += (c > 0u) ? 1u : 0u; mine = (j == x) ? c : mine; }
        if (sum == G) break;
        __builtin_amdgcn_s_sleep(1);
        if ((++sp & 255u) == 0u) { if (xb_ld(&bar[XB_TMO])) break; if (sp > XB_SPIN_CAP) { atomicAdd(&bar[XB_TMO], 1u); break; } }
    }
    nloc = mine > 0u ? mine : 1u; nx = cnt > 0u ? cnt : 1u;
}

__device__ __forceinline__ void xcd_barrier(const XcdBarrier& b) {
    asm volatile("s_waitcnt vmcnt(0)" ::: "memory");
    __syncthreads();
    if (threadIdx.x == 0) {
        unsigned* bar = b.bar;
        __builtin_amdgcn_s_waitcnt(0);
        unsigned nloc = b.st[0], nx = b.st[1];
        if (nloc == 0u) { xcd_barrier_complete(bar, b.x, nloc, nx); b.st[0] = nloc; b.st[1] = nx; }
        const unsigned old = xb_add(&bar[XB_XSUB(b.x)], 1u);
        const unsigned gen = old / nloc;
        if (old + 1u == (gen + 1u) * nloc) {
            __builtin_amdgcn_fence(__ATOMIC_RELEASE, "agent");
            asm volatile("s_waitcnt vmcnt(0)" ::: "memory");
            const unsigned og = xb_add(&bar[XB_TOP], 1u);
            const unsigned tg = og / nx;
            if (og + 1u == (tg + 1u) * nx) xb_add(&bar[XB_TOPGEN], 1u);
            else XB_SPIN(xb_ld(&bar[XB_TOPGEN]) == tg, bar);
            __builtin_amdgcn_fence(__ATOMIC_ACQUIRE, "agent");
            xb_add(&bar[XB_XGEN(b.x)], 1u);
            asm volatile("s_waitcnt vmcnt(0)" ::: "memory");
        } else {
            XB_SPIN(xb_ld(&bar[XB_XGEN(b.x)]) == gen, bar);
            __builtin_amdgcn_fence(__ATOMIC_ACQUIRE, "agent");
            asm volatile("s_waitcnt vmcnt(0)" ::: "memory");
        }
    }
    __syncthreads();
}


struct Frame {
    LAS unsigned char* lds; volatile LAS unsigned* MISC; gu32* ctl;
    int tid, lane, wave, vcu, G;
};
struct Args { const float* in[22]; float* out; unsigned char* ws; int ph_lo, ph_hi, p0mask, pad; };

__device__ __forceinline__ float wave_sum(float v) {
#pragma unroll
    for (int o = 1; o < 64; o <<= 1) v += __shfl_xor(v, o);
    return v;
}
enum { MAP_ID = 0, MAP_IN = 1, MAP_QB = 2, MAP_KVB = 3, MAP_GU = 4 };
__device__ __forceinline__ int map_col(int map, int n) {
    if (map == MAP_IN) { if (n < 896) return n; if (n < 928) { const int i = n - 896, pr = i >> 1; return 1152 + ((i & 1) ? 16 + pr : pr); } if (n < 1024) return -1; return 896 + (n - 1024); }
    if (map == MAP_QB) { const int slab = n >> 5, c = n & 31, head = slab / 3, part = slab - 3 * head; const int lg = part < 2 ? part * 32 + c : 64 + ((c & 1) ? 16 + (c >> 1) : (c >> 1)); return head * 96 + lg; }
    if (map == MAP_KVB) { const int t = n >> 8, r = n & 255, bj = r >> 7, wc = (r >> 5) & 3, c = r & 31; return (2 * t + (wc & 1)) * 128 + (wc >> 1) * 64 + bj * 32 + c; }
    if (map == MAP_GU) { const int pn = n >> 8, r = n & 255; return ((r >> 7) ? 2816 : 0) + pn * 128 + (r & 127); }
    return n;
}
__device__ __forceinline__ void p0_transpose_item(const float* W, const float* W2, int ldw, const float* gain, bf16* WT, int ldt, int kdst0, int nblk, int map, LAS float* scr, int item, int lane) {
    const int kb = item / nblk, nb = item - kb * nblk, k0 = 64 * kb, n0 = 32 * nb;
    int col = map_col(map, n0 + (lane & 31)); const float* src = W; if (map == MAP_GU && col >= 2816) { col -= 2816; src = W2; }
    const float msk = col < 0 ? 0.f : 1.f; col = col < 0 ? 0 : col;
    const float* sp = src + (size_t)(k0 + (lane >> 5)) * ldw + col;
    float v[32];
#pragma unroll
    for (int i = 0; i < 32; ++i) v[i] = sp[(size_t)(2 * i) * ldw];
    if (gain) {
        const float* gp = gain + k0 + (lane >> 5);
#pragma unroll
        for (int i = 0; i < 32; ++i) v[i] *= gp[2 * i];
    }
#pragma unroll
    for (int i = 0; i < 32; ++i) scr[(2 * i + (lane >> 5)) * 33 + (lane & 31)] = v[i] * msk;
    LDS_WAIT(); asm volatile("" ::: "memory");
    const int c = lane & 7;
#pragma unroll
    for (int j = 0; j < 4; ++j) { const int n = (lane >> 3) + 8 * j; const LAS float* s = scr + (8 * c) * 33 + n;
        v4u o; o.x = pk2(s[0 * 33], s[1 * 33]); o.y = pk2(s[2 * 33], s[3 * 33]); o.z = pk2(s[4 * 33], s[5 * 33]); o.w = pk2(s[6 * 33], s[7 * 33]);
        *(GAS v4u*)(WT + (size_t)(n0 + n) * ldt + kdst0 + k0 + 8 * c) = o; }
    LDS_WAIT(); asm volatile("" ::: "memory");
}
__device__ __forceinline__ void p0_prologue(Frame& F, const Args& a) {
    unsigned char* ws = a.ws;
    LAS float* scr = (LAS float*)(F.lds + RING_OFF + F.wave * 16384);
    constexpr int AW0 = 4, AW = NWAVES - AW0;
    const int pm_ = a.p0mask;
    if (F.wave >= AW0) {
    const int gw = F.vcu * AW + (F.wave - AW0), NGW = F.G * AW;
    const int gt = gw * 64 + F.lane, NGT = NGW * 64;
    if (pm_ & 1) { v4u* zp = (v4u*)(ws + WS_SSZ); const v4u zz = {0u, 0u, 0u, 0u}; for (int i = gt; i < (int)(SSZ_BYTES / 16); i += NGT) zp[i] = zz; }
    if (pm_ & 1) { float* tab = (float*)(ws + WS_TAB); for (int i = gt; i < SEQL * 16; i += NGT) { const int t = i >> 4, f = i & 15; const float ang = (float)t * powf(10000.0f, -(float)(2 * f) / 32.0f); tab[2 * i] = cosf(ang); tab[2 * i + 1] = sinf(ang); } }
    if (pm_ & 2) {
        const float *ln1 = a.in[4], *w_in = a.in[5], *qan = a.in[8], *w_qb = a.in[9], *kvan = a.in[10], *w_kvb = a.in[11], *w_o = a.in[14], *ln2 = a.in[15], *w_gate = a.in[16], *w_up = a.in[17], *w_down = a.in[18], *plen = a.in[19], *w_pg = a.in[20], *w_pp = a.in[21];
        constexpr int I_IN = (1024 / 64) * (1280 / 32), I_QB = (384 / 64) * (768 / 32), I_KVB = (256 / 64) * (1024 / 32), I_O = (512 / 64) * (1024 / 32), I_GU = (1024 / 64) * (5632 / 32), I_D = (2816 / 64) * (1024 / 32), I_PG = (1024 / 64) * (1024 / 32), I_PP = (256 / 64) * (1024 / 32);
        constexpr int NITEMS = I_IN + I_QB + I_KVB + I_O + I_GU + I_D + I_PG + I_PP;
        for (int it = gw; it < NITEMS; it += NGW) {
            int r = it;
            if (r < I_IN) { p0_transpose_item(w_in, nullptr, 1184, ln1, (bf16*)(ws + WS_WIN), 1024, 0, 1280 / 32, MAP_IN, scr, r, F.lane); continue; } r -= I_IN;
            if (r < I_QB) { p0_transpose_item(w_qb, nullptr, 768, qan, (bf16*)(ws + WS_WQB), 384, 0, 768 / 32, MAP_QB, scr, r, F.lane); continue; } r -= I_QB;
            if (r < I_KVB) { p0_transpose_item(w_kvb, nullptr, 1024, kvan, (bf16*)(ws + WS_WKVB), 256, 0, 1024 / 32, MAP_KVB, scr, r, F.lane); continue; } r -= I_KVB;
            if (r < I_O) { p0_transpose_item(w_o + (size_t)512 * 1024, nullptr, 1024, nullptr, (bf16*)(ws + WS_WO), 1024, 512, 1024 / 32, MAP_ID, scr, r, F.lane); continue; } r -= I_O;
            if (r < I_GU) { p0_transpose_item(w_gate, w_up, 2816, ln2, (bf16*)(ws + WS_WGU), 1024, 0, 5632 / 32, MAP_GU, scr, r, F.lane); continue; } r -= I_GU;
            if (r < I_D) { p0_transpose_item(w_down, nullptr, 1024, nullptr, (bf16*)(ws + WS_WD), 2816, 0, 1024 / 32, MAP_ID, scr, r, F.lane); continue; } r -= I_D;
            if (r < I_PG) { p0_transpose_item(w_pg, nullptr, 1024, plen, (bf16*)(ws + WS_WPG), 1024, 0, 1024 / 32, MAP_ID, scr, r, F.lane); continue; } r -= I_PG;
            p0_transpose_item(w_pp, nullptr, 1024, nullptr, (bf16*)(ws + WS_WPP), 256, 0, 1024 / 32, MAP_ID, scr, r, F.lane);
        }
    }
    if (pm_ & 4) {
        const float* w_pool = a.in[6]; const float* psc = a.in[7]; const float* w_o = a.in[14]; bf16* WO = (bf16*)(ws + WS_WO);
        for (int it = gw; it < 512; it += NGW) {
            const int kb = it >> 4, nb = it & 15, kk0 = kb * 16, g = kk0 >> 7, n = nb * 64 + F.lane;
            const float* wo = w_o + (size_t)(g * 128) * 1024 + n; const float* wp = w_pool + (size_t)kk0 * 128; const float* sc = psc + g * 128;
            { float t[32];
#pragma unroll
                for (int i = 0; i < 32; ++i) t[i] = wp[i * 64 + F.lane];
                const float s0 = sc[F.lane], s1 = sc[64 + F.lane];
#pragma unroll
                for (int i = 0; i < 32; ++i) scr[i * 64 + F.lane] = t[i] * ((i & 1) ? s1 : s0); }
            LDS_WAIT(); asm volatile("" ::: "memory");
            float acc[16];
#pragma unroll
            for (int e = 0; e < 16; ++e) acc[e] = 0.f;
#pragma unroll 1
            for (int j0 = 0; j0 < 128; j0 += 32) {
                float w[32];
#pragma unroll
                for (int j = 0; j < 32; ++j) w[j] = wo[(size_t)(j0 + j) * 1024];
#pragma unroll
                for (int j = 0; j < 32; j += 4)
#pragma unroll
                    for (int e = 0; e < 16; ++e) { const f32x4 av = *(const LAS f32x4*)(scr + e * 128 + j0 + j);
                        acc[e] = fmaf(av.x, w[j], acc[e]); acc[e] = fmaf(av.y, w[j + 1], acc[e]); acc[e] = fmaf(av.z, w[j + 2], acc[e]); acc[e] = fmaf(av.w, w[j + 3], acc[e]); }
            }
            v4u o0, o1; o0.x = pk2(acc[0], acc[1]); o0.y = pk2(acc[2], acc[3]); o0.z = pk2(acc[4], acc[5]); o0.w = pk2(acc[6], acc[7]); o1.x = pk2(acc[8], acc[9]); o1.y = pk2(acc[10], acc[11]); o1.z = pk2(acc[12], acc[13]); o1.w = pk2(acc[14], acc[15]);
            *(GAS v4u*)(WO + (size_t)n * 1024 + kk0) = o0; *(GAS v4u*)(WO + (size_t)n * 1024 + kk0 + 8) = o1;
            LDS_WAIT(); asm volatile("" ::: "memory");
        }
    }
    }
    if (pm_ & 8) {
        bf16* XB = (bf16*)a.out; bf16* PB = (bf16*)(ws + WS_PB); float* xinv = (float*)(ws + WS_SS1);
        volatile LAS int* ctr = (volatile LAS int*)(F.lds + LDSCTL_OFF + 64);
        const int ppb = (M / 2) / F.G, pbase = F.vcu * ppb, ptot = (F.vcu == F.G - 1) ? (M / 2) - pbase : ppb;
        for (;;) {
            int pr = 0; if (F.lane == 0) pr = __hip_atomic_fetch_add((LAS int*)ctr, 1, __ATOMIC_RELAXED, __HIP_MEMORY_SCOPE_WORKGROUP);
            pr = __builtin_amdgcn_readfirstlane(pr); if (pr >= ptot) break;
            const int m0 = 2 * (pbase + pr);
            f32x4 v[2][4], pv[2];
#pragma unroll
            for (int r = 0; r < 2; ++r) { const int m = m0 + r;
                const float* xrow = m < MPR ? a.in[0] + (size_t)m * DM : a.in[1] + (size_t)(m - MPR) * DM;
                const float* prow = m < MPR ? a.in[2] + (size_t)m * 256 : a.in[3] + (size_t)(m - MPR) * 256;
                const GAS f32x4* xr = (const GAS f32x4*)xrow + F.lane;
#pragma unroll
                for (int j = 0; j < 4; ++j) v[r][j] = xr[64 * j];
                pv[r] = ((const GAS f32x4*)prow)[F.lane]; }
#pragma unroll
            for (int r = 0; r < 2; ++r) { const int m = m0 + r; float s = 0.f;
#pragma unroll
                for (int j = 0; j < 4; ++j) s += (v[r][j].x * v[r][j].x + v[r][j].y * v[r][j].y) + (v[r][j].z * v[r][j].z + v[r][j].w * v[r][j].w);
                s = wave_sum(s); const float rs = 1.0f / sqrtf(s * (1.0f / 1024.0f) + 1e-6f);
                if (F.lane == 0) xinv[m] = sqrtf(s * (1.0f / 1024.0f) + 1e-6f);
                GAS unsigned long long* o8 = (GAS unsigned long long*)(XB + (size_t)m * DM) + F.lane;
#pragma unroll
                for (int j = 0; j < 4; ++j) o8[64 * j] = (unsigned long long)pk2(v[r][j].x * rs, v[r][j].y * rs) | ((unsigned long long)pk2(v[r][j].z * rs, v[r][j].w * rs) << 32);
                ((GAS unsigned long long*)(PB + (size_t)m * 256))[F.lane] = (unsigned long long)pk2(pv[r].x, pv[r].y) | ((unsigned long long)pk2(pv[r].z, pv[r].w) << 32); }
        }
    }
}
template <int W, int R> __device__ __forceinline__ void pool_quad(const bf16* Z, bf16* Y, int row0, int c8) {
    const int t0 = row0 & (SEQL - 1), lo = t0 - W / 2; const bf16* zb = Z + (size_t)(row0 - t0) * 1280 + c8 * 8;
    v4u wv[W + R - 1];
#pragma unroll
    for (int i = 0; i < W + R - 1; ++i) { const int j = lo + i; const bool ok = j >= 0 && j < SEQL; wv[i] = *(const GAS v4u*)(zb + (size_t)(ok ? j : t0) * 1280); if (!ok) wv[i] = (v4u){0u, 0u, 0u, 0u}; }
#define PF(VV, e) (((e) & 1) ? __uint_as_float(((e) >> 1) == 0 ? (VV).x & 0xffff0000u : ((e) >> 1) == 1 ? (VV).y & 0xffff0000u : ((e) >> 1) == 2 ? (VV).z & 0xffff0000u : (VV).w & 0xffff0000u) \
                            : __uint_as_float(((e) >> 1) == 0 ? (VV).x << 16 : ((e) >> 1) == 1 ? (VV).y << 16 : ((e) >> 1) == 2 ? (VV).z << 16 : (VV).w << 16))
    float s[8];
#pragma unroll
    for (int e = 0; e < 8; ++e) { s[e] = 0.f;
#pragma unroll
        for (int i = 0; i < W; ++i) s[e] += PF(wv[i], e); }
#pragma unroll
    for (int r = 0; r < R; ++r) {
        if (r > 0) {
#pragma unroll
            for (int e = 0; e < 8; ++e) s[e] += PF(wv[W + r - 1], e) - PF(wv[r - 1], e); }
        const int t = t0 + r, a = t - W / 2, b = a + W; const float inv = 1.0f / (float)((b > SEQL ? SEQL : b) - (a < 0 ? 0 : a)); const v4u cv = wv[r + W / 2];
        v4u o; o.x = pk2(s[0] * inv - PF(cv, 0), s[1] * inv - PF(cv, 1)); o.y = pk2(s[2] * inv - PF(cv, 2), s[3] * inv - PF(cv, 3)); o.z = pk2(s[4] * inv - PF(cv, 4), s[5] * inv - PF(cv, 5)); o.w = pk2(s[6] * inv - PF(cv, 6), s[7] * inv - PF(cv, 7));
        *(GAS v4u*)(Y + (size_t)(row0 + r) * 1024 + c8 * 8) = o;
    }
#undef PF
}
__device__ __forceinline__ void pool_phase(Frame& F, const bf16* Z, bf16* Y) {
    const int gw = F.vcu * NWAVES + F.wave, NGW = F.G * NWAVES;
    constexpr int R = 8;
    for (int wi = gw; wi < M / R; wi += NGW) {
        const int g = (wi + (wi >> 11)) & 3, row0 = ((wi >> 2) * 4 + (F.lane >> 4)) * R, c8 = g * 16 + (F.lane & 15);
        if (g == 0) pool_quad<2, R>(Z, Y, row0, c8); else if (g == 1) pool_quad<4, R>(Z, Y, row0, c8); else if (g == 2) pool_quad<8, R>(Z, Y, row0, c8); else pool_quad<16, R>(Z, Y, row0, c8);
    }
}

__global__ void __launch_bounds__(NWAVES * 64, 2) mega_fwd(Args args) {
    extern __shared__ __attribute__((aligned(16))) unsigned char lds[];
    Frame F;
    F.lds = (LAS unsigned char*)lds; F.MISC = (volatile LAS unsigned*)(F.lds + MISC_OFF);
    F.tid = threadIdx.x; F.lane = F.tid & 63; F.wave = __builtin_amdgcn_readfirstlane(F.tid >> 6);
    F.G = gridDim.x; { const int bx = blockIdx.x; F.vcu = (F.G % 8 == 0) ? (bx % 8) * (F.G / 8) + bx / 8 : bx; }
    unsigned char* ws = args.ws; F.ctl = (gu32*)(ws + WS_CTL);
    for (int u = F.tid; u < (LDS_BYTES - LDSCTL_OFF) / 4; u += NWAVES * 64) ((LAS unsigned*)(F.lds + LDSCTL_OFF))[u] = 0u;
    __syncthreads();
    XcdBarrier bar = xcd_barrier_post((unsigned*)(F.ctl + CW_BAR), F.MISC + 8);
    const int lo = args.ph_lo, hi = args.ph_hi;
#ifdef TS_BUILD
    unsigned long long* tsb = (unsigned long long*)(ws + 39 * MiB); int nts = 0;
#define STAMP() do { if (blockIdx.x == 0 && F.tid == 0) tsb[nts] = __builtin_amdgcn_s_memrealtime(); ++nts; } while (0)
#else
#define STAMP() do {} while (0)
#endif
    STAMP();
#ifndef PHMASK
#define PHMASK 0x1ff
#endif
#define IN(k) (((PHMASK >> (k)) & 1) && lo <= (k) && (k) < hi)
#ifndef REPEAT_MASK
#define REPEAT_MASK 0
#endif
#define REPS(k) for (int rep = 0; rep < 1 + ((REPEAT_MASK >> (k)) & 1); ++rep)
    float* spare = (float*)(ws + 38 * MiB);
#define SEAM(k) do { if (IN(k) && IN((k) + 1)) xcd_barrier(bar); STAMP(); } while (0)
    float* ssz = (float*)(ws + WS_SSZ); float *ss_q = ssz, *ss_kv = ssz + M, *ss2 = ssz + 2 * (size_t)M, *ss3 = ssz + 3 * (size_t)M, *hss = ssz + 5 * (size_t)M;
    float* ss1 = (float*)(ws + WS_SS1); float* ss_kr = ss1 + M; float* krr = (float*)(ws + WS_KRR); const float* tab = (const float*)(ws + WS_TAB);
    float* out = args.out;

    if (IN(0)) REPS(0) { p0_prologue(F, args); } SEAM(0);
    if (IN(1)) REPS(1) {
        pg8::Gemm g{(const pg8::bf16_t*)out, (const pg8::bf16_t*)(ws + WS_WIN), M, 1280, 1024, 1024}; pg8::StaticOrder S; S.init(M, 1280, F.G, (int)blockIdx.x);
        pg8::EpiIn E{(pg8::bf16_t*)(ws + WS_Z), ss1, rep ? spare : ss_q, rep ? spare : ss_kv, ss_kr, krr, args.in[13], tab};
        pg8::gemm_phase<pg8::EpiIn, pg8::StaticOrder, true, true>(F.lds + RING_OFF, g, S, E);
    } SEAM(1);
    if (IN(2)) {
        REPS(9) { pool_phase(F, (const bf16*)(ws + WS_Z), (bf16*)(ws + WS_Y)); VM_WAIT(); }
        REPS(10) { pg8::Gemm g{(const pg8::bf16_t*)(ws + WS_Z) + 512, (const pg8::bf16_t*)(ws + WS_WQB), M, 768, 384, 1280}; pg8::StaticOrder S; S.init(M, 768, F.G, (int)blockIdx.x);
          pg8::EpiQ E{(pg8::bf16_t*)(ws + WS_Q), ss_q, rep ? spare : hss};
          pg8::gemm_phase<pg8::EpiQ, pg8::StaticOrder, true, true>(F.lds + RING_OFF, g, S, E); }
        REPS(11) { pg8::Gemm g{(const pg8::bf16_t*)(ws + WS_Z) + 1024, (const pg8::bf16_t*)(ws + WS_WKVB), M, 1024, 256, 1280}; pg8::StaticOrder S; S.init(M, 1024, F.G, (int)blockIdx.x);
          pg8::EpiKV E{(pg8::bf16_t*)(ws + WS_K), (pg8::bf16_t*)(ws + WS_V), ss_kv, ss_kr, krr, args.in[13], 0};
          pg8::gemm_phase<pg8::EpiKV, pg8::StaticOrder, true, true>(F.lds + RING_OFF, g, S, E); }
    } SEAM(2);
    if (IN(3)) REPS(3) {
        const att::AttnArgs A{(const att::bf16_t*)(ws + WS_Q), (const att::bf16_t*)(ws + WS_K), (const att::bf16_t*)(ws + WS_V), ss_q, hss, args.in[12], tab, (att::bf16_t*)(ws + WS_Y)};
        { const int var_ = args.p0mask >> 5; att::LCH* al_ = (att::LCH*)(F.lds + RING_OFF);
#ifdef ATTN_VARIANTS
          if (var_ == 1) att::attn_phase<1>(A, F.vcu, F.G, al_, args.p0mask); else if (var_ == 2) att::attn_phase<2>(A, F.vcu, F.G, al_, args.p0mask); else if (var_ == 3) att::attn_phase<3>(A, F.vcu, F.G, al_, args.p0mask); else if (var_ == 4) att::attn_phase<4>(A, F.vcu, F.G, al_, args.p0mask); else
#endif
          att::attn_phase<0>(A, F.vcu, F.G, al_, args.p0mask); (void)var_; }
    } SEAM(3);
    if (IN(4)) REPS(4) {
        pg8::Gemm g{(const pg8::bf16_t*)(ws + WS_Y), (const pg8::bf16_t*)(ws + WS_WO), M, 1024, 1024, 1024}; pg8::StaticOrder S; S.init(M, 1024, F.G, (int)blockIdx.x);
        pg8::EpiResX E{(const pg8::bf16_t*)out, ss1, (pg8::bf16_t*)(ws + WS_HB), rep ? spare : ss2};
        pg8::gemm_phase<pg8::EpiResX, pg8::StaticOrder, true, true>(F.lds + RING_OFF, g, S, E);
    } SEAM(4);
    if (IN(5)) REPS(5) {
        pg8::Gemm g{(const pg8::bf16_t*)(ws + WS_HB), (const pg8::bf16_t*)(ws + WS_WGU), M, 5632, 1024, 1024}; pg8::StaticOrder S; S.init(M, 5632, F.G, (int)blockIdx.x);
        pg8::EpiSwiglu E{(pg8::bf16_t*)(ws + WS_ACT), ss2};
        pg8::gemm_phase<pg8::EpiSwiglu, pg8::StaticOrder, true, true>(F.lds + RING_OFF, g, S, E);
    } SEAM(5);
    if (IN(6)) {
        pg8::Gemm g{(const pg8::bf16_t*)(ws + WS_ACT), (const pg8::bf16_t*)(ws + WS_WD), M, 1024, 2816, 2816}; pg8::StaticOrder S; S.init(M, 1024, F.G, (int)blockIdx.x, 1);
        pg8::EpiResB E{(pg8::bf16_t*)(ws + WS_HB), ss3};
        pg8::gemm_phase<pg8::EpiResB, pg8::StaticOrder, true, true>(F.lds + RING_OFF, g, S, E);
    } SEAM(6);
    if (IN(7)) REPS(7) {
        pg8::Gemm g{(const pg8::bf16_t*)(ws + WS_PB), (const pg8::bf16_t*)(ws + WS_WPP), M, 1024, 256, 256}; pg8::StaticOrder S; S.init(M, 1024, F.G, (int)blockIdx.x);
        pg8::EpiStore E{(pg8::bf16_t*)(ws + WS_PROJ)};
        pg8::gemm_phase<pg8::EpiStore, pg8::StaticOrder, true, true>(F.lds + RING_OFF, g, S, E);
    }
    if (IN(7) && IN(8)) { VM_WAIT(); __syncthreads(); } STAMP();
    if (IN(8)) {
        pg8::Gemm g{(const pg8::bf16_t*)(ws + WS_HB), (const pg8::bf16_t*)(ws + WS_WPG), M, 1024, 1024, 1024}; pg8::StaticOrder S; S.init(M, 1024, F.G, (int)blockIdx.x);
        pg8::EpiFinal E{out, (const pg8::bf16_t*)(ws + WS_HB), (const pg8::bf16_t*)(ws + WS_PROJ), ss3};
        pg8::gemm_phase<pg8::EpiFinal, pg8::StaticOrder, true, true>(F.lds + RING_OFF, g, S, E);
    }
    STAMP();
#undef IN
#undef SEAM
}

static int launch_fast(void* const* d_in, void* d_out, void* d_ws, size_t ws_size, hipStream_t stream, int ph_lo, int ph_hi, int p0mask = 15) {
    static int grid = 0;
    if (grid == 0) {
        if (ws_size < WS_END) { fprintf(stderr, "kernel_launch: workspace too small: %zu < %zu\n", ws_size, (size_t)WS_END); grid = -1; return -1; }
        int dev = 0, cus = 0, per_cu = 0;
        if (hipGetDevice(&dev) != hipSuccess || hipDeviceGetAttribute(&cus, hipDeviceAttributeMultiprocessorCount, dev) != hipSuccess) { grid = -1; return -1; }
        if (hipFuncSetAttribute((const void*)mega_fwd, hipFuncAttributeMaxDynamicSharedMemorySize, LDS_BYTES) != hipSuccess) { fprintf(stderr, "kernel_launch: hipFuncSetAttribute failed\n"); grid = -1; return -1; }
        if (hipOccupancyMaxActiveBlocksPerMultiprocessor(&per_cu, (const void*)mega_fwd, NWAVES * 64, LDS_BYTES) != hipSuccess || per_cu < 1) fprintf(stderr, "kernel_launch: note: occupancy query reports %d\n", per_cu);
        (void)hipGetLastError();
        grid = cus;
    }
    if (grid < 0) return -1;
    if (hipMemsetAsync((char*)d_ws + WS_CTL, 0, CTL_ZERO_BYTES, stream) != hipSuccess) return -1;
    Args a{};
    for (int i = 0; i < 22; ++i) a.in[i] = (const float*)d_in[i];
    a.out = (float*)d_out; a.ws = (unsigned char*)d_ws; a.ph_lo = ph_lo; a.ph_hi = ph_hi; a.p0mask = p0mask;
    hipLaunchKernelGGL(mega_fwd, dim3(grid), dim3(NWAVES * 64), LDS_BYTES, stream, a);
    const hipError_t le = hipPeekAtLastError();
    if (le != hipSuccess) { fprintf(stderr, "kernel_launch: launch failed: %s\n", hipGetErrorName(le)); return -1; }
    return 0;
}

extern "C" void kernel_launch(void* const* d_in, const int* in_sizes, int n_in, void* d_out, int out_size, void* d_ws, size_t ws_size, hipStream_t stream) {
  (void)in_sizes; (void)n_in; (void)out_size;
  launch_fast(d_in, d_out, d_ws, ws_size, stream, 0, NPH);
}
```

```cpp
#include <hip/hip_runtime.h>
#include <cstdio>
#include <cstdint>

namespace pg8 {
#define PG8_LAS __attribute__((address_space(3)))
typedef unsigned short bf16_t;
typedef short bf16x8 __attribute__((ext_vector_type(8)));
typedef float f32x4 __attribute__((ext_vector_type(4)));
typedef unsigned u32x4 __attribute__((ext_vector_type(4)));
constexpr int BM = 256, BK = 64, HALF = 128, HTB = HALF * BK * 2  , STAGE_BYTES = 8 * HTB, NXCD = 8, WGM = 8;

__host__ __device__ __forceinline__ int lds_byte(int r, int c) { const int st = (r >> 4) * 2 + (c >> 5), rr = r & 15, cc = c & 31, ob = rr * 64 + cc * 2; return st * 1024 + (ob ^ (((ob >> 9) & 1) << 5)); }
__host__ __device__ __forceinline__ void stage_rc(int b, int& R, int& C) { const int st = b / 1024, sb = b % 1024, swz = sb ^ (((sb >> 9) & 1) << 5); R = (st >> 1) * 16 + swz / 64; C = (st & 1) * 32 + (swz % 64) / 2; }
__host__ __device__ __forceinline__ int perm32(int rho) { const int n = rho >> 4, i = rho & 15; return 8 * (i >> 2) + 4 * n + (i & 3); }

struct Unit { int pm, pn; };
struct Gemm { const bf16_t* A; const bf16_t* Bt; int M, N, K, lda; const bf16_t* A2 = nullptr; int nsplit = 1 << 30; };

struct StaticOrder {
    int nM, nN, nwg, G, c, rev;
    __host__ __device__ void init(int M, int N, int G_, int c_, int rev_ = 0) { nM = M / BM; nN = N / BM; nwg = nM * nN; G = G_; c = c_; rev = rev_; }
    __host__ __device__ bool next(int i, Unit& u) const {
        long L = (long)i * G + c; if (L >= nwg) return false;
        if (rev) { const int R = nwg / G; if (i < R) L = (long)(R - 1 - i) * G + c; }
        int wgid = (int)L; { const int q = nwg / NXCD, r = nwg % NXCD, xcd = wgid % NXCD, off = wgid / NXCD; wgid = (xcd < r ? xcd * (q + 1) : r * (q + 1) + (xcd - r) * q) + off; }
        const int nig = WGM * nN, gid = wgid / nig, fm = gid * WGM, gsz = (nM - fm) < WGM ? (nM - fm) : WGM;
        u.pm = fm + ((wgid % nig) % gsz); u.pn = (wgid % nig) / gsz; return true;
    }
    __device__ __forceinline__ void a_ready(const Unit&) const {}
    __device__ __forceinline__ void done(const Unit&) const {}
};

__device__ __forceinline__ unsigned cvt_pk_bf16(float lo, float hi) { unsigned r; asm volatile("v_cvt_pk_bf16_f32 %0, %1, %2" : "=v"(r) : "v"(lo), "v"(hi)); return r; }
typedef float f32x2 __attribute__((ext_vector_type(2)));

constexpr int MROWS = 49152, SEQ = 2048, MPROMPT = 32768, ZP = 1280;
constexpr float NEPS = 1e-6f;
__device__ __forceinline__ u32x4 pack8(const f32x4 a, const f32x4 b) { u32x4 w; w.x = cvt_pk_bf16(a[0], a[1]); w.y = cvt_pk_bf16(a[2], a[3]); w.z = cvt_pk_bf16(b[0], b[1]); w.w = cvt_pk_bf16(b[2], b[3]); return w; }
__device__ __forceinline__ float sq8(const f32x4 a, const f32x4 b) { return (a[0] * a[0] + a[1] * a[1]) + (a[2] * a[2] + a[3] * a[3]) + (b[0] * b[0] + b[1] * b[1]) + (b[2] * b[2] + b[3] * b[3]); }
__device__ __forceinline__ float red_fq(float s) { s += __shfl_xor(s, 16); s += __shfl_xor(s, 32); return s; }
__device__ __forceinline__ float bflo(unsigned w) { return __uint_as_float(w << 16); }
__device__ __forceinline__ float bfhi(unsigned w) { return __uint_as_float(w & 0xffff0000u); }
#define EPI_HALF_BEGIN _Pragma("unroll") for (int ai = 0; ai < 2; ++ai) { int rbase = u.pm * BM + ai * HALF + wr * 64 + fr; asm volatile("" : "+v"(rbase) :: "memory");
#define EPI_HALF_END asm volatile("" ::: "memory"); }
#define EPI_M _Pragma("unroll") for (int m = 0; m < 4; ++m)
#define EPI_FENCE asm volatile("" ::: "memory")
__device__ __forceinline__ float rstd(float ss, float inv_n) { return 1.0f / sqrtf(ss * inv_n + NEPS); }

struct EpiIn {
    static constexpr bool PERM = true, AFTER_DRAIN = false;
    bf16_t* z; const float* ss1; float* ss_q; float* ss_kv; float* ss_kr; float* krr; const float* kn_g; const float* tab;
    __device__ __forceinline__ void operator()(const f32x4 (&acc)[2][2][4][2], const Unit& u, int wr, int wc, int fr, int fq) const {
        const int colt = u.pn * BM + wc * 32 + 8 * fq;
        EPI_HALF_BEGIN
            EPI_M { const int row = rbase + 16 * m;
                f32x4 v00 = acc[ai][0][m][0], v01 = acc[ai][0][m][1], v10 = acc[ai][1][m][0], v11 = acc[ai][1][m][1];
                bf16_t* zr = z + (size_t)row * ZP + colt;
                if (u.pn != 3) {
                    *(u32x4*)(zr) = pack8(v00, v01); *(u32x4*)(zr + HALF) = pack8(v10, v11);
                    if (u.pn == 2 || u.pn == 4) { const float s = red_fq(sq8(v00, v01) + sq8(v10, v11)); if (fq == 0) atomicAdd((u.pn == 2 ? ss_q : ss_kv) + row, s); }
                } else {
                    *(u32x4*)(zr) = pack8(v00, v01);
                    { const float s = red_fq(sq8(v00, v01)); if (fq == 0) atomicAdd(ss_q + row, s); }
                    if (wc == 0) {
                        const float s = red_fq(sq8(v10, v11)); if (fq == 0) ss_kr[row] = s;
                        const int t = row & (SEQ - 1); const float* tb = tab + ((size_t)t * 16 + 4 * fq) * 2;
                        const f32x4 cs0 = *(const f32x4*)(tb), cs1 = *(const f32x4*)(tb + 4);
                        const f32x4 g1 = *(const f32x4*)(kn_g + 64 + 4 * fq), g2 = *(const f32x4*)(kn_g + 80 + 4 * fq);
                        f32x4 o0, o1;
                        { const float a = v10[0] * g1[0], b = v10[1] * g2[0]; o0[0] = a * cs0[0] - b * cs0[1]; o0[1] = a * cs0[1] + b * cs0[0]; }
                        { const float a = v10[2] * g1[1], b = v10[3] * g2[1]; o0[2] = a * cs0[2] - b * cs0[3]; o0[3] = a * cs0[3] + b * cs0[2]; }
                        { const float a = v11[0] * g1[2], b = v11[1] * g2[2]; o1[0] = a * cs1[0] - b * cs1[1]; o1[1] = a * cs1[1] + b * cs1[0]; }
                        { const float a = v11[2] * g1[3], b = v11[3] * g2[3]; o1[2] = a * cs1[2] - b * cs1[3]; o1[3] = a * cs1[3] + b * cs1[2]; }
                        float* kr = krr + (size_t)row * 32 + 8 * fq; *(f32x4*)kr = o0; *(f32x4*)(kr + 4) = o1;
                    }
                }
            }
        EPI_HALF_END
    }
};
struct EpiQ {
    static constexpr bool PERM = true, AFTER_DRAIN = false;
    bf16_t* Q; const float* ss_q; float* hss;
    __device__ __forceinline__ void operator()(const f32x4 (&acc)[2][2][4][2], const Unit& u, int wr, int wc, int fr, int fq) const {
        const int s0 = u.pn * 8 + wc, s1 = s0 + 4; const int h0 = s0 / 3, p0 = s0 - 3 * h0, h1 = s1 / 3, p1 = s1 - 3 * h1;
        EPI_HALF_BEGIN
            EPI_M { const int row = rbase + 16 * m;
                const int b = row >> 11, t = row & (SEQ - 1);
                const f32x4 v00 = acc[ai][0][m][0], v01 = acc[ai][0][m][1], v10 = acc[ai][1][m][0], v11 = acc[ai][1][m][1];
                *(u32x4*)(Q + ((size_t)(b * 8 + h0) * SEQ + t) * 96 + p0 * 32 + 8 * fq) = pack8(v00, v01);
                *(u32x4*)(Q + ((size_t)(b * 8 + h1) * SEQ + t) * 96 + p1 * 32 + 8 * fq) = pack8(v10, v11);
                const float q0 = red_fq(sq8(v00, v01)), q1 = red_fq(sq8(v10, v11));
                if (fq == 0) { atomicAdd(hss + (size_t)h0 * MROWS + row, q0); atomicAdd(hss + (size_t)h1 * MROWS + row, q1); }
            }
        EPI_HALF_END
    }
};
struct EpiKV {
    static constexpr bool PERM = true, AFTER_DRAIN = false;
    bf16_t* K; bf16_t* V; const float* ss_kv; const float* ss_kr; const float* krr; const float* kn_g; int pn0;
    __device__ __forceinline__ void operator()(const f32x4 (&acc)[2][2][4][2], const Unit& u, int wr, int wc, int fr, int fq) const {
        const int h = 2 * (u.pn - pn0) + (wc & 1);
        EPI_HALF_BEGIN
            float rsv[4], skr[4]; f32x4 kr0[4], kr1[4];
            EPI_M rsv[m] = ss_kv[rbase + 16 * m];
            if (wc < 2) { EPI_M { skr[m] = ss_kr[rbase + 16 * m]; const float* kr = krr + (size_t)(rbase + 16 * m) * 32 + 8 * fq; kr0[m] = *(const f32x4*)kr; kr1[m] = *(const f32x4*)(kr + 4); } }
            EPI_FENCE;
            EPI_M { const int row = rbase + 16 * m; const float rs = rstd(rsv[m], 1.0f / 256.0f);
                const int b = row >> 11, t = row & (SEQ - 1);
                f32x4 v00 = acc[ai][0][m][0] * rs, v01 = acc[ai][0][m][1] * rs, v10 = acc[ai][1][m][0] * rs, v11 = acc[ai][1][m][1] * rs;
                if (wc >= 2) {
                    bf16_t* vp = V + ((size_t)(b * 8 + h) * SEQ + t) * 64 + 8 * fq;
                    *(u32x4*)(vp) = pack8(v00, v01); *(u32x4*)(vp + 32) = pack8(v10, v11);
                } else {
                    const float tot = red_fq(sq8(v00, v01) + sq8(v10, v11));
                    const float sk = rstd(tot + skr[m], 1.0f / 96.0f);
                    const f32x4 g00 = *(const f32x4*)(kn_g + 8 * fq), g01 = *(const f32x4*)(kn_g + 8 * fq + 4), g10 = *(const f32x4*)(kn_g + 32 + 8 * fq), g11 = *(const f32x4*)(kn_g + 36 + 8 * fq);
                    v00 = v00 * g00 * sk; v01 = v01 * g01 * sk; v10 = v10 * g10 * sk; v11 = v11 * g11 * sk;
                    bf16_t* kp = K + ((size_t)(b * 8 + h) * SEQ + t) * 96 + 8 * fq;
                    *(u32x4*)(kp) = pack8(v00, v01); *(u32x4*)(kp + 32) = pack8(v10, v11);
                    *(u32x4*)(kp + 64) = pack8(kr0[m] * sk, kr1[m] * sk);
                }
            }
        EPI_HALF_END
    }
};
struct EpiQKV {
    static constexpr bool PERM = true, AFTER_DRAIN = false;
    EpiQ q; EpiKV kv;
    __device__ __forceinline__ void operator()(const f32x4 (&acc)[2][2][4][2], const Unit& u, int wr, int wc, int fr, int fq) const {
        if (u.pn < 3) q(acc, u, wr, wc, fr, fq); else kv(acc, u, wr, wc, fr, fq);
    }
};
struct EpiResX {
    static constexpr bool PERM = true, AFTER_DRAIN = false;
    const bf16_t* xn; const float* xinv; bf16_t* hb; float* ss;
    __device__ __forceinline__ void operator()(const f32x4 (&acc)[2][2][4][2], const Unit& u, int wr, int wc, int fr, int fq) const {
        const int colt = u.pn * BM + wc * 32 + 8 * fq;
        EPI_HALF_BEGIN
            u32x4 xw[4][2]; float xs[4];
            EPI_M { const bf16_t* xp = xn + (size_t)(rbase + 16 * m) * 1024 + colt; xw[m][0] = *(const u32x4*)xp; xw[m][1] = *(const u32x4*)(xp + HALF); xs[m] = xinv[rbase + 16 * m]; }
            EPI_FENCE;
            EPI_M { const int row = rbase + 16 * m; float s = 0.f;
#pragma unroll
                for (int bj = 0; bj < 2; ++bj) {
                    const u32x4 w = xw[m][bj];
                    const f32x4 b0 = {bflo(w.x), bfhi(w.x), bflo(w.y), bfhi(w.y)}, b1 = {bflo(w.z), bfhi(w.z), bflo(w.w), bfhi(w.w)};
                    const f32x4 h0 = b0 * xs[m] + acc[ai][bj][m][0], h1 = b1 * xs[m] + acc[ai][bj][m][1];
                    *(u32x4*)(hb + (size_t)row * 1024 + colt + bj * HALF) = pack8(h0, h1);
                    s += sq8(h0, h1);
                }
                s = red_fq(s); if (fq == 0) atomicAdd(ss + row, s);
            }
        EPI_HALF_END
    }
};
struct EpiResB {
    static constexpr bool PERM = true, AFTER_DRAIN = false;
    bf16_t* hb; float* ss;
    __device__ __forceinline__ void operator()(const f32x4 (&acc)[2][2][4][2], const Unit& u, int wr, int wc, int fr, int fq) const {
        const int colt = u.pn * BM + wc * 32 + 8 * fq;
        EPI_HALF_BEGIN
            u32x4 hw[4][2];
            EPI_M { const bf16_t* hp = hb + (size_t)(rbase + 16 * m) * 1024 + colt; hw[m][0] = *(const u32x4*)hp; hw[m][1] = *(const u32x4*)(hp + HALF); }
            EPI_FENCE;
            EPI_M { const int row = rbase + 16 * m; float s = 0.f;
#pragma unroll
                for (int bj = 0; bj < 2; ++bj) {
                    const u32x4 w = hw[m][bj];
                    const f32x4 b0 = {bflo(w.x), bfhi(w.x), bflo(w.y), bfhi(w.y)}, b1 = {bflo(w.z), bfhi(w.z), bflo(w.w), bfhi(w.w)};
                    const f32x4 h0 = b0 + acc[ai][bj][m][0], h1 = b1 + acc[ai][bj][m][1];
                    *(u32x4*)(hb + (size_t)row * 1024 + colt + bj * HALF) = pack8(h0, h1);
                    s += sq8(h0, h1);
                }
                s = red_fq(s); if (fq == 0) atomicAdd(ss + row, s);
            }
        EPI_HALF_END
    }
};
struct EpiSwiglu {
    static constexpr bool PERM = true, AFTER_DRAIN = false;
    bf16_t* act; const float* ss2;
    __device__ __forceinline__ void operator()(const f32x4 (&acc)[2][2][4][2], const Unit& u, int wr, int wc, int fr, int fq) const {
        const int colt = u.pn * HALF + wc * 32 + 8 * fq;
        EPI_HALF_BEGIN
            float rsv[4];
            EPI_M rsv[m] = ss2[rbase + 16 * m];
            EPI_FENCE;
            EPI_M { const int row = rbase + 16 * m; const float rs = rstd(rsv[m], 1.0f / 1024.0f);
                f32x4 a[2];
#pragma unroll
                for (int n = 0; n < 2; ++n) { const f32x4 g = acc[ai][0][m][n] * rs, w = acc[ai][1][m][n] * rs;
#pragma unroll
                    for (int e = 0; e < 4; ++e) a[n][e] = g[e] * __builtin_amdgcn_rcpf(1.0f + __builtin_amdgcn_exp2f(-1.4426950408889634f * g[e])) * w[e]; }
                *(u32x4*)(act + (size_t)row * 2816 + colt) = pack8(a[0], a[1]);
            }
        EPI_HALF_END
    }
};
struct EpiStore {
    static constexpr bool PERM = true, AFTER_DRAIN = false;
    bf16_t* o;
    __device__ __forceinline__ void operator()(const f32x4 (&acc)[2][2][4][2], const Unit& u, int wr, int wc, int fr, int fq) const {
        const int colt = u.pn * BM + wc * 32 + 8 * fq;
        EPI_HALF_BEGIN
            EPI_M { const int row = rbase + 16 * m;
#pragma unroll
                for (int bj = 0; bj < 2; ++bj) *(u32x4*)(o + (size_t)row * 1024 + colt + bj * HALF) = pack8(acc[ai][bj][m][0], acc[ai][bj][m][1]); }
        EPI_HALF_END
    }
};
struct EpiFinal {
    static constexpr bool PERM = true, AFTER_DRAIN = false;
    float* out; const bf16_t* hb; const bf16_t* proj; const float* ss3;
    __device__ __forceinline__ void operator()(const f32x4 (&acc)[2][2][4][2], const Unit& u, int wr, int wc, int fr, int fq) const {
        const int colt = u.pn * BM + wc * 32 + 8 * fq;
        EPI_HALF_BEGIN
            float rsv[4]; u32x4 hw[4][2], pw[4][2];
            EPI_M { const size_t off = (size_t)(rbase + 16 * m) * 1024 + colt; rsv[m] = ss3[rbase + 16 * m];
                hw[m][0] = *(const u32x4*)(hb + off); hw[m][1] = *(const u32x4*)(hb + off + HALF); pw[m][0] = *(const u32x4*)(proj + off); pw[m][1] = *(const u32x4*)(proj + off + HALF); }
            EPI_FENCE;
            EPI_M { const int row = rbase + 16 * m; const float rs = rstd(rsv[m], 1.0f / 1024.0f);
#pragma unroll
                for (int bj = 0; bj < 2; ++bj) {
                    const size_t off = (size_t)row * 1024 + colt + bj * HALF; const u32x4 pj = pw[m][bj], hv = hw[m][bj];
                    f32x4 h0 = {bflo(hv.x), bfhi(hv.x), bflo(hv.y), bfhi(hv.y)}, h1 = {bflo(hv.z), bfhi(hv.z), bflo(hv.w), bfhi(hv.w)};
                    const float pf[8] = {bflo(pj.x), bfhi(pj.x), bflo(pj.y), bfhi(pj.y), bflo(pj.z), bfhi(pj.z), bflo(pj.w), bfhi(pj.w)};
#pragma unroll
                    for (int e = 0; e < 4; ++e) { const float g0 = acc[ai][bj][m][0][e] * rs, g1 = acc[ai][bj][m][1][e] * rs;
                        h0[e] += pf[e] * __builtin_amdgcn_rcpf(1.0f + __builtin_amdgcn_exp2f(-1.4426950408889634f * g0));
                        h1[e] += pf[4 + e] * __builtin_amdgcn_rcpf(1.0f + __builtin_amdgcn_exp2f(-1.4426950408889634f * g1)); }
                    float* o = out + off; *(f32x4*)o = h0; *(f32x4*)(o + 4) = h1;
                }
            }
        EPI_HALF_END
    }
};

struct EpiNull {
    static constexpr bool PERM = true, AFTER_DRAIN = false;
    __device__ __forceinline__ void operator()(const f32x4 (&acc)[2][2][4][2], const Unit& u, int wr, int wc, int fr, int fq) const {
#pragma unroll
        for (int ai = 0; ai < 2; ++ai)
#pragma unroll
            for (int bj = 0; bj < 2; ++bj)
#pragma unroll
                for (int m = 0; m < 4; ++m) { asm volatile("" :: "v"(acc[ai][bj][m][0]), "v"(acc[ai][bj][m][1])); }
    }
};

template <class Epi, class Sched, bool ALIGN_EPI = false, bool SP2 = false>
__device__ __forceinline__ void gemm_phase(PG8_LAS unsigned char* lds, const Gemm g, const Sched& S, const Epi& E) {
    const int tid = threadIdx.x, wid = __builtin_amdgcn_readfirstlane(tid >> 6), lane = tid & 63, wr = wid >> 2, wc = wid & 3, fr = lane & 15, fq = lane >> 4;
    const int K = g.K, nt = K / BK;
    unsigned voffA[2], voffB[2];
#pragma unroll
    for (int i = 0; i < 2; ++i) { int R, C; stage_rc(tid * 16 + i * 8192, R, C); const int Rb = Epi::PERM ? ((R & ~31) + perm32(R & 31)) : R;
        voffA[i] = (unsigned)(R * g.lda + C) * 2u; voffB[i] = (unsigned)(Rb * K + C) * 2u; }
    const size_t kstep = (size_t)(BK * 2);
    const size_t hstepA = (size_t)HALF * g.lda * 2, hstepB = (size_t)HALF * K * 2;
    const size_t tstepA = 2 * hstepA, tstepB = 2 * hstepB;
    const unsigned ldsw = (unsigned)wid * 1024u;
    const int aoff = lds_byte(wr * 64 + fr, fq * 8), boff = lds_byte(wc * 32 + fr, fq * 8);
#define PG8_SA(b, h) (((b) * 2 + (h)) * HTB)
#define PG8_SB(b, h) ((4 + (b) * 2 + (h)) * HTB)
#define PG8_STAGE(bufoff, gbase, voff) do { _Pragma("unroll") for (int _i = 0; _i < 2; ++_i) \
        __builtin_amdgcn_global_load_lds((const unsigned*)((const char*)(gbase) + (voff)[_i]), (PG8_LAS unsigned*)(lds + (bufoff) + ldsw + _i * 8192), 16, 0, 0); } while (0)
#define PG8_LDA(dst, b, h) do { _Pragma("unroll") for (int m = 0; m < 4; ++m) _Pragma("unroll") for (int k = 0; k < 2; ++k) dst[m][k] = *(const PG8_LAS bf16x8*)(lds + PG8_SA(b, h) + aoff + m * 2048 + k * 1024); } while (0)
#define PG8_LDB(dst, b, h) do { _Pragma("unroll") for (int n = 0; n < 2; ++n) _Pragma("unroll") for (int k = 0; k < 2; ++k) dst[n][k] = *(const PG8_LAS bf16x8*)(lds + PG8_SB(b, h) + boff + n * 2048 + k * 1024); } while (0)
#define PG8_MMA(ai, bj, At, Bt) do { __builtin_amdgcn_s_setprio(1); _Pragma("unroll") for (int m = 0; m < 4; ++m) _Pragma("unroll") for (int n = 0; n < 2; ++n) _Pragma("unroll") for (int k = 0; k < 2; ++k) \
        acc[ai][bj][m][n] = __builtin_amdgcn_mfma_f32_16x16x32_bf16(Bt[n][k], At[m][k], acc[ai][bj][m][n], 0, 0, 0); __builtin_amdgcn_s_setprio(0); } while (0)
#define PG8_WAIT_V(n) asm volatile("s_waitcnt vmcnt(" #n ")" ::: "memory")
#define PG8_WAIT_L(n) asm volatile("s_waitcnt lgkmcnt(" #n ")" ::: "memory")
#define PG8_BAR __builtin_amdgcn_s_barrier()
#define PG8_SCHED __builtin_amdgcn_sched_barrier(0)
    Unit cur, nxt; int ui = 0;
    if (!S.next(0, cur)) return;
    f32x4 acc[2][2][4][2];
#pragma unroll
    for (int a = 0; a < 2; ++a)
#pragma unroll
        for (int b = 0; b < 2; ++b)
#pragma unroll
            for (int m = 0; m < 4; ++m)
#pragma unroll
                for (int n = 0; n < 2; ++n) acc[a][b][m][n] = (f32x4){0.f, 0.f, 0.f, 0.f};
    bf16x8 At[4][2], B0[2][2], B1[2][2];
    const char* cA = (const char*)(cur.pn < g.nsplit ? g.A : g.A2) + (size_t)cur.pm * tstepA; const char* cB = (const char*)g.Bt + (size_t)cur.pn * tstepB;
    S.a_ready(cur);
    if constexpr (SP2) {
        PG8_STAGE(PG8_SB(0, 0), cB, voffB); PG8_STAGE(PG8_SB(0, 1), cB + hstepB, voffB); PG8_STAGE(PG8_SA(0, 0), cA, voffA); PG8_STAGE(PG8_SA(0, 1), cA + hstepA, voffA);
        if (wr == 1) PG8_BAR;
        PG8_WAIT_V(2); PG8_BAR;
        PG8_STAGE(PG8_SB(1, 0), cB + kstep, voffB); PG8_STAGE(PG8_SA(1, 0), cA + kstep, voffA); PG8_STAGE(PG8_SB(1, 1), cB + hstepB + kstep, voffB);
        PG8_WAIT_V(6); PG8_BAR;
    } else {
        PG8_STAGE(PG8_SB(0, 0), cB, voffB); PG8_STAGE(PG8_SA(0, 0), cA, voffA); PG8_STAGE(PG8_SB(0, 1), cB + hstepB, voffB); PG8_STAGE(PG8_SA(0, 1), cA + hstepA, voffA);
        if (wr == 1) PG8_BAR;
        PG8_WAIT_V(4); PG8_BAR;
        PG8_STAGE(PG8_SB(1, 0), cB + kstep, voffB); PG8_STAGE(PG8_SA(1, 0), cA + kstep, voffA); PG8_STAGE(PG8_SB(1, 1), cB + hstepB + kstep, voffB);
        PG8_WAIT_V(6); PG8_BAR;
    }
    for (;;) {
        const bool has_next = S.next(ui + 1, nxt);
        const char* nA = has_next ? (const char*)(nxt.pn < g.nsplit ? g.A : g.A2) + (size_t)nxt.pm * tstepA : cA; const char* nB = has_next ? (const char*)g.Bt + (size_t)nxt.pn * tstepB : cB;
#pragma nounroll
        for (int t = 0; t < nt; t += 2) {
            const bool last = (t == nt - 2);
            const char* a1 = cA + (size_t)(t + 1) * kstep;
            const char* a2 = last ? nA : cA + (size_t)(t + 2) * kstep; const char* b2 = last ? nB : cB + (size_t)(t + 2) * kstep;
            const char* a3 = a2 + kstep; const char* b3 = b2 + kstep;
            if (last && has_next) S.a_ready(nxt);
            if constexpr (SP2) {
            PG8_LDB(B0, 0, 0); PG8_LDB(B1, 0, 1); PG8_SCHED; PG8_LDA(At, 0, 0); PG8_STAGE(PG8_SA(1, 1), a1 + hstepA, voffA);
            PG8_WAIT_V(8); PG8_WAIT_L(0); PG8_BAR; PG8_MMA(0, 0, At, B0); PG8_MMA(0, 1, At, B1); PG8_BAR; PG8_SCHED;
            PG8_LDA(At, 0, 1); PG8_STAGE(PG8_SB(0, 0), b2, voffB); PG8_STAGE(PG8_SB(0, 1), b2 + hstepB, voffB); PG8_STAGE(PG8_SA(0, 0), a2, voffA);
            PG8_WAIT_V(8); PG8_WAIT_L(0); PG8_BAR; PG8_MMA(1, 0, At, B0); PG8_MMA(1, 1, At, B1); PG8_BAR; PG8_SCHED;
            PG8_LDB(B0, 1, 0); PG8_LDB(B1, 1, 1); PG8_SCHED; PG8_LDA(At, 1, 0); PG8_STAGE(PG8_SA(0, 1), a2 + hstepA, voffA);
            PG8_WAIT_V(8); PG8_WAIT_L(0); PG8_BAR; PG8_MMA(0, 0, At, B0); PG8_MMA(0, 1, At, B1); PG8_BAR; PG8_SCHED;
            PG8_LDA(At, 1, 1); PG8_STAGE(PG8_SB(1, 0), b3, voffB); PG8_STAGE(PG8_SB(1, 1), b3 + hstepB, voffB); PG8_STAGE(PG8_SA(1, 0), a3, voffA);
            PG8_WAIT_V(8); PG8_WAIT_L(0); PG8_BAR; PG8_MMA(1, 0, At, B0); PG8_MMA(1, 1, At, B1); PG8_BAR; PG8_SCHED;
            } else {
            PG8_LDB(B0, 0, 0); PG8_SCHED; PG8_LDA(At, 0, 0); PG8_STAGE(PG8_SA(1, 1), a1 + hstepA, voffA);
            PG8_WAIT_L(8); PG8_BAR; PG8_WAIT_L(0); PG8_MMA(0, 0, At, B0); PG8_BAR; PG8_SCHED;
            PG8_LDB(B1, 0, 1); PG8_STAGE(PG8_SB(0, 0), b2, voffB);
            PG8_BAR; PG8_WAIT_L(0); PG8_MMA(0, 1, At, B1); PG8_BAR;
            PG8_LDA(At, 0, 1); PG8_STAGE(PG8_SA(0, 0), a2, voffA);
            PG8_BAR; PG8_WAIT_L(0); PG8_MMA(1, 0, At, B0); PG8_BAR; PG8_SCHED;
            PG8_STAGE(PG8_SB(0, 1), b2 + hstepB, voffB);
            PG8_WAIT_V(6); PG8_BAR; PG8_MMA(1, 1, At, B1); PG8_BAR;
            PG8_LDB(B0, 1, 0); PG8_SCHED; PG8_LDA(At, 1, 0); PG8_STAGE(PG8_SA(0, 1), a2 + hstepA, voffA);
            PG8_WAIT_L(8); PG8_BAR; PG8_WAIT_L(0); PG8_MMA(0, 0, At, B0); PG8_BAR; PG8_SCHED;
            PG8_LDB(B1, 1, 1); PG8_STAGE(PG8_SB(1, 0), b3, voffB);
            PG8_BAR; PG8_WAIT_L(0); PG8_MMA(0, 1, At, B1); PG8_BAR;
            PG8_LDA(At, 1, 1); PG8_STAGE(PG8_SA(1, 0), a3, voffA);
            PG8_BAR; PG8_WAIT_L(0); PG8_MMA(1, 0, At, B0); PG8_BAR; PG8_SCHED;
            PG8_STAGE(PG8_SB(1, 1), b3 + hstepB, voffB);
            PG8_WAIT_V(6); PG8_BAR; PG8_MMA(1, 1, At, B1); PG8_BAR;
            }
        }
        if constexpr (ALIGN_EPI) { if (wr == 0) PG8_BAR; }
        if constexpr (!Epi::AFTER_DRAIN) { E(acc, cur, wr, wc, fr, fq); S.done(cur); }
        if (!has_next) break;
#pragma unroll
        for (int a = 0; a < 2; ++a)
#pragma unroll
            for (int b = 0; b < 2; ++b)
#pragma unroll
                for (int m = 0; m < 4; ++m)
#pragma unroll
                    for (int n = 0; n < 2; ++n) acc[a][b][m][n] = (f32x4){0.f, 0.f, 0.f, 0.f};
        cur = nxt; cA = nA; cB = nB; ++ui;
        if constexpr (ALIGN_EPI) { if (wr == 1) PG8_BAR; }
    }
    PG8_WAIT_V(0);
    if constexpr (!ALIGN_EPI) { if (wr == 0) PG8_BAR; }
    PG8_BAR;
    if constexpr (Epi::AFTER_DRAIN) { E.fused(acc, cur, wr, wc, fr, fq, lds, wid, lane); S.done(cur); }
#undef PG8_SA
#undef PG8_SB
#undef PG8_STAGE
#undef PG8_LDA
#undef PG8_LDB
#undef PG8_MMA
#undef PG8_WAIT_V
#undef PG8_WAIT_L
#undef PG8_BAR
#undef PG8_SCHED
}
}

namespace att {
using bf16x8 = __attribute__((ext_vector_type(8))) short;
using s16x4  = __attribute__((ext_vector_type(4))) short;
using f32x16 = __attribute__((ext_vector_type(16))) float;
using f32x4  = __attribute__((ext_vector_type(4))) float;
using u32x4  = __attribute__((ext_vector_type(4))) unsigned;
typedef unsigned short bf16_t;
typedef __attribute__((address_space(3))) char LCH;
typedef __attribute__((address_space(3))) float LFL;
constexpr int NW = 8, QBLK = 32, KVBLK = 64, DQK = 96, DV = 64, SEQ = 2048, MROWS = 49152;
constexpr float SCALE = 0.10206207261596577f;
constexpr float THR = 8.f;
constexpr int KROW = 208;
constexpr int SHM_V = KVBLK * DV * 2, SHM_K = KVBLK * KROW, NSTG = 4, SHM_ATTN = NSTG * SHM_V + NSTG * SHM_K + NW * 64 * 4;
#define SBAR() __builtin_amdgcn_sched_barrier(0)
__device__ __forceinline__ int crow(int r, int hi) { return (r & 3) + 8 * (r >> 2) + 4 * hi; }
__device__ __forceinline__ unsigned cvtpk(float lo, float hi) { unsigned r; asm volatile("v_cvt_pk_bf16_f32 %0, %1, %2" : "=v"(r) : "v"(lo), "v"(hi)); return r; }
__device__ __forceinline__ float bflo(unsigned w) { return __uint_as_float(w << 16); }
__device__ __forceinline__ float bfhi(unsigned w) { return __uint_as_float(w & 0xffff0000u); }

constexpr float THRL = 8.f;
__device__ __forceinline__ void partialSM(f32x16& p0, f32x16& p1, float& mhat, float& alpha, f32x16* o, LFL* al_l, int r32, int hi) {
  float pmax;
  {
#define MX3(a, b, c) __builtin_fmaxf(__builtin_fmaxf((a), (b)), (c))
    const float a0 = MX3(p0[0], p0[1], p0[2]), a1 = MX3(p0[3], p0[4], p0[5]), a2 = MX3(p0[6], p0[7], p0[8]), a3 = MX3(p0[9], p0[10], p0[11]), a4 = MX3(p0[12], p0[13], p0[14]);
    const float a5 = MX3(p1[0], p1[1], p1[2]), a6 = MX3(p1[3], p1[4], p1[5]), a7 = MX3(p1[6], p1[7], p1[8]), a8 = MX3(p1[9], p1[10], p1[11]), a9 = MX3(p1[12], p1[13], p1[14]);
    const float b0 = MX3(a0, a1, a2), b1 = MX3(a3, a4, a5), b2 = MX3(a6, a7, a8), b3 = MX3(a9, p0[15], p1[15]);
    pmax = __builtin_fmaxf(__builtin_fmaxf(b0, b1), __builtin_fmaxf(b2, b3));
#undef MX3
  }
  { auto rr = __builtin_amdgcn_permlane32_swap(__float_as_uint(pmax), __float_as_uint(pmax), false, false);
    pmax = fmaxf(__uint_as_float(rr[0]), __uint_as_float(rr[1])); }
  f32x16 e0;
#pragma unroll
  for (int r = 0; r < 16; ++r) e0[r] = __builtin_amdgcn_exp2f(p0[r]);
  alpha = 1.f;
  if (__builtin_expect(__any(pmax > THRL), 0)) {
    const float dl = fmaxf(pmax, 0.f); mhat += dl;
#pragma unroll
    for (int r = 0; r < 16; ++r) { p1[r] -= dl; e0[r] = __builtin_amdgcn_exp2f(p0[r] - dl); }
    alpha = __builtin_amdgcn_exp2f(-dl);
    if (hi == 0) al_l[r32] = alpha; asm volatile("s_waitcnt lgkmcnt(0)" ::: "memory");
#pragma unroll
    for (int d = 0; d < 2; ++d)
#pragma unroll
      for (int r = 0; r < 16; ++r) o[d][r] *= al_l[crow(r, hi)];
  }
  p0 = e0;
}
__device__ __forceinline__ void finishSM(f32x16& p0, f32x16& p1, float alpha, float& l_reg, bf16x8& pa0, bf16x8& pa1, bf16x8& pa2, bf16x8& pa3) {
#pragma unroll
  for (int r = 0; r < 16; ++r) p1[r] = __builtin_amdgcn_exp2f(p1[r]);
  float ps;
  { float s0 = p0[0] + p0[1], s1 = p0[2] + p0[3], s2 = p1[0] + p1[1], s3 = p1[2] + p1[3];
#pragma unroll
    for (int r = 4; r < 16; r += 4) { s0 += p0[r] + p0[r + 1]; s1 += p0[r + 2] + p0[r + 3]; s2 += p1[r] + p1[r + 1]; s3 += p1[r + 2] + p1[r + 3]; }
    ps = (s0 + s1) + (s2 + s3); }
  l_reg = l_reg * alpha + ps;
#define PK4(P, BASE, OUT) do { u32x4 w = {cvtpk(P[BASE + 0], P[BASE + 1]), cvtpk(P[BASE + 2], P[BASE + 3]), cvtpk(P[BASE + 4], P[BASE + 5]), cvtpk(P[BASE + 6], P[BASE + 7])}; OUT = *reinterpret_cast<bf16x8*>(&w); } while (0)
  PK4(p0, 0, pa0); PK4(p0, 8, pa1); PK4(p1, 0, pa2); PK4(p1, 8, pa3);
#undef PK4
}
template <int VAR = 0> __device__ __forceinline__ void qkt(f32x16& p0, f32x16& p1, const LCH* Ks, const bf16x8* qr, float nm, int r32, int hi) {
#pragma unroll
  for (int r = 0; r < 16; ++r) { p0[r] = nm; p1[r] = nm; }
  if (VAR == 5) {
#pragma unroll
    for (int d0 = 0; d0 < 6; ++d0) { p0 = __builtin_amdgcn_mfma_f32_32x32x16_bf16(qr[5 - d0], qr[d0], p0, 0, 0, 0); p1 = __builtin_amdgcn_mfma_f32_32x32x16_bf16(qr[(d0 + 1) % 6], qr[d0], p1, 0, 0, 0); }
    return; }
#pragma unroll
  for (int d0 = 0; d0 < 6; ++d0) { const int cb = (d0 * 16 + hi * 8) * 2;
    const bf16x8 b0 = *(const __attribute__((address_space(3))) bf16x8*)(Ks + r32 * KROW + cb);
    const bf16x8 b1 = *(const __attribute__((address_space(3))) bf16x8*)(Ks + (32 + r32) * KROW + cb);
    p0 = __builtin_amdgcn_mfma_f32_32x32x16_bf16(b0, qr[d0], p0, 0, 0, 0);
    p1 = __builtin_amdgcn_mfma_f32_32x32x16_bf16(b1, qr[d0], p1, 0, 0, 0); }
}
__device__ __forceinline__ int v_st(int k, int c) { const int kk = k; return ((kk >> 3) * 2 + (c >> 5)) * 512 + ((kk & 7) * 32 + (c & 31)) * 2; }
__device__ __forceinline__ int v_rd_base(int lane) { return ((lane & 3) << 3) | (((lane >> 2) & 3) << 6) | (((lane >> 4) & 1) << 5) | (((lane >> 5) & 1) << 8); }
constexpr int v_rd_off(int d0, int ks, int half) { return d0 * 512 + ks * 2048 + half * 1024; }
typedef short v4i16_t __attribute__((ext_vector_type(4)));
__device__ __forceinline__ s16x4 vtr(const LCH* p) { return __builtin_bit_cast(s16x4, __builtin_amdgcn_ds_read_tr16_b64_v4i16((__attribute__((address_space(3))) v4i16_t*)p)); }
template <int VAR = 0> __device__ __forceinline__ void pv_d0(f32x16* o, const LCH* vb, bf16x8 pa0, bf16x8 pa1, bf16x8 pa2, bf16x8 pa3) {
  if (VAR == 5) { o[0] = __builtin_amdgcn_mfma_f32_32x32x16_bf16(pa0, pa1, o[0], 0, 0, 0); o[1] = __builtin_amdgcn_mfma_f32_32x32x16_bf16(pa0, pa2, o[1], 0, 0, 0); o[0] = __builtin_amdgcn_mfma_f32_32x32x16_bf16(pa1, pa3, o[0], 0, 0, 0); o[1] = __builtin_amdgcn_mfma_f32_32x32x16_bf16(pa1, pa0, o[1], 0, 0, 0);
    o[0] = __builtin_amdgcn_mfma_f32_32x32x16_bf16(pa2, pa1, o[0], 0, 0, 0); o[1] = __builtin_amdgcn_mfma_f32_32x32x16_bf16(pa2, pa3, o[1], 0, 0, 0); o[0] = __builtin_amdgcn_mfma_f32_32x32x16_bf16(pa3, pa0, o[0], 0, 0, 0); o[1] = __builtin_amdgcn_mfma_f32_32x32x16_bf16(pa3, pa2, o[1], 0, 0, 0); return; }
#define PK(L, H) (bf16x8){L[0], L[1], L[2], L[3], H[0], H[1], H[2], H[3]}
#define PVSTEP(ks, pa) do { const s16x4 l0 = vtr(vb + v_rd_off(0, ks, 0)), h0 = vtr(vb + v_rd_off(0, ks, 1)), l1 = vtr(vb + v_rd_off(1, ks, 0)), h1 = vtr(vb + v_rd_off(1, ks, 1)); \
    o[0] = __builtin_amdgcn_mfma_f32_32x32x16_bf16(pa, PK(l0, h0), o[0], 0, 0, 0); o[1] = __builtin_amdgcn_mfma_f32_32x32x16_bf16(pa, PK(l1, h1), o[1], 0, 0, 0); } while (0)
  PVSTEP(0, pa0); PVSTEP(1, pa1); PVSTEP(2, pa2); PVSTEP(3, pa3);
#undef PVSTEP
#undef PK
}
struct AttnArgs { const bf16_t* Q; const bf16_t* K; const bf16_t* V; const float* ss_q; const float* hss; const float* qn_g; const float* tab; bf16_t* Y; };
template <int VAR> __device__ __forceinline__ void attn_phase(const AttnArgs& A, int vcu, int G, LCH* lds, int flags) {
  const int tid = threadIdx.x, wid = tid >> 6, lane = tid & 63, r32 = lane & 31, hi = lane >> 5;
  LCH* V_lds = lds; LCH* K_lds = lds + NSTG * SHM_V;
  LFL* ws = (LFL*)(lds + NSTG * SHM_V + NSTG * SHM_K) + wid * 64; LFL* li_l = ws; LFL* al_l = ws + 32;
  const int kc0 = tid, kc1 = tid < 256 ? tid + 512 : tid; const bool k2 = tid < 256;
  const int kr0 = kc0 / 12, kch0 = kc0 - 12 * kr0, kr1 = kc1 / 12, kch1 = kc1 - 12 * kr1;
  const int kg0 = kr0 * DQK + kch0 * 8, kg1 = kr1 * DQK + kch1 * 8, kl0 = kr0 * KROW + kch0 * 16, kl1 = kr1 * KROW + kch1 * 16;
  const int vk = tid >> 3, vc = (tid & 7) * 8, vg = vk * DV + vc, vl = v_st(vk, vc);
  const LCH* vb0 = V_lds + v_rd_base(lane);
  struct { bf16x8 v, k0, k1; } sr_;
  const bf16_t* Kh; const bf16_t* Vh;
#define SLOAD(key0) do { sr_.v = *reinterpret_cast<const bf16x8*>(Vh + (size_t)(key0) * DV + vg); sr_.k0 = *reinterpret_cast<const bf16x8*>(Kh + (size_t)(key0) * DQK + kg0); \
    sr_.k1 = *reinterpret_cast<const bf16x8*>(Kh + (size_t)(key0) * DQK + kg1); } while (0)
#define SWRITE(st) do { *(__attribute__((address_space(3))) bf16x8*)(V_lds + (st) * SHM_V + vl) = sr_.v; *(__attribute__((address_space(3))) bf16x8*)(K_lds + (st) * SHM_K + kl0) = sr_.k0; if (k2) *(__attribute__((address_space(3))) bf16x8*)(K_lds + (st) * SHM_K + kl1) = sr_.k1; } while (0)
  float ssq_, hss_;
#define PREFETCH(uu) do { const int bh_ = (uu) >> 3, b_ = bh_ >> 3, h_ = bh_ & 7, t_ = ((uu) & 7) * 256 + wid * QBLK + r32; const size_t mrow_ = (size_t)b_ * SEQ + t_; \
    ssq_ = A.ss_q[mrow_]; hss_ = A.hss[(size_t)h_ * MROWS + mrow_]; \
    Kh = A.K + (size_t)bh_ * SEQ * DQK; Vh = A.V + (size_t)bh_ * SEQ * DV; SLOAD(0); } while (0)
#define RESC(a) do { if (__any((a) < 1.f)) { if (hi == 0) al_l[r32] = (a); asm volatile("s_waitcnt lgkmcnt(0)" ::: "memory"); \
    _Pragma("unroll") for (int d = 0; d < 2; ++d) _Pragma("unroll") for (int r = 0; r < 16; ++r) o[d][r] *= al_l[crow(r, hi)]; } } while (0)
  int u = vcu; if (u >= 1536) return;
  PREFETCH(u);
  for (;;) {
  const int bh = u >> 3, b = bh >> 3, h = bh & 7, q0 = (u & 7) * 256;
  u32x4 qw[6]; { const bf16_t* Qw_ = A.Q + ((size_t)bh * SEQ + q0 + wid * QBLK + r32) * DQK + hi * 8;
#pragma unroll
    for (int d0 = 0; d0 < 6; ++d0) qw[d0] = *reinterpret_cast<const u32x4*>(Qw_ + d0 * 16); }
  float mhat = 0.f, l_reg = 0; f32x16 o[2] = {}; bf16x8 qr[6];
  {
    const float rq = 1.0f / sqrtf(ssq_ * (1.0f / 384.0f) + 1e-6f);
    const float sq = (SCALE * 1.4426950408889634f) * rq / sqrtf(hss_ * rq * rq * (1.0f / 96.0f) + 1e-6f);
#pragma unroll
    for (int d0 = 0; d0 < 4; ++d0) {
      const u32x4 w = qw[d0];
      const f32x4 g0 = *reinterpret_cast<const f32x4*>(A.qn_g + d0 * 16 + hi * 8), g1 = *reinterpret_cast<const f32x4*>(A.qn_g + d0 * 16 + hi * 8 + 4);
      u32x4 o4; o4.x = cvtpk(bflo(w.x) * g0[0] * sq, bfhi(w.x) * g0[1] * sq); o4.y = cvtpk(bflo(w.y) * g0[2] * sq, bfhi(w.y) * g0[3] * sq);
      o4.z = cvtpk(bflo(w.z) * g1[0] * sq, bfhi(w.z) * g1[1] * sq); o4.w = cvtpk(bflo(w.w) * g1[2] * sq, bfhi(w.w) * g1[3] * sq);
      qr[d0] = *reinterpret_cast<bf16x8*>(&o4);
    }
#pragma unroll
    for (int d0 = 4; d0 < 6; ++d0) {
      const u32x4 w = qw[d0];
      const int i0 = 8 * (d0 - 4) + 4 * hi;
      const f32x4 g1 = *reinterpret_cast<const f32x4*>(A.qn_g + 64 + i0), g2 = *reinterpret_cast<const f32x4*>(A.qn_g + 80 + i0);
      const float* tb = A.tab + ((size_t)(q0 + wid * QBLK + r32) * 16 + i0) * 2; const f32x4 cs0 = *reinterpret_cast<const f32x4*>(tb), cs1 = *reinterpret_cast<const f32x4*>(tb + 4);
      const unsigned ww[4] = {w.x, w.y, w.z, w.w}; const float cc[4] = {cs0[0], cs0[2], cs1[0], cs1[2]}, sn[4] = {cs0[1], cs0[3], cs1[1], cs1[3]};
      unsigned ow[4];
#pragma unroll
      for (int jj = 0; jj < 4; ++jj) { const float a = bflo(ww[jj]) * g1[jj] * sq, bb = bfhi(ww[jj]) * g2[jj] * sq; ow[jj] = cvtpk(a * cc[jj] - bb * sn[jj], a * sn[jj] + bb * cc[jj]); }
      u32x4 o4 = {ow[0], ow[1], ow[2], ow[3]}; qr[d0] = *reinterpret_cast<bf16x8*>(&o4);
    }
  }
  f32x16 pA0, pA1, pB0, pB1; float alA, alB; bf16x8 pa0, pa1, pa2, pa3; const int NT = (flags & 16) ? SEQ / KVBLK / 2 : SEQ / KVBLK;
  SWRITE(0); SLOAD(KVBLK); __syncthreads();
  qkt(pA0, pA1, K_lds, qr, -mhat, r32, hi); partialSM(pA0, pA1, mhat, alA, o, al_l, r32, hi);
  SWRITE(1); SLOAD(2 * KVBLK); __syncthreads();
#define XPART(PC0, PC1, PP0, PP1, alP_, j_) do { \
    if (VAR != 4) { if ((j_) + 1 < NT) SWRITE(((j_) + 1) & 3); if ((j_) + 2 < NT) SLOAD(((j_) + 2) * KVBLK); } SBAR(); \
    if (VAR == 7 && wid >= 4) { asm volatile("" : "+v"(PC0), "+v"(PC1)); } else if (VAR != 3) qkt<VAR>(PC0, PC1, K_lds + ((j_) & 3) * SHM_K, qr, -mhat, r32, hi); else { asm volatile("" : "+v"(PC0), "+v"(PC1)); } \
    if (VAR == 7 && wid >= 4) { asm volatile("" : "+v"(pa0), "+v"(pa1), "+v"(pa2), "+v"(pa3)); } else if (VAR != 1) finishSM(PP0, PP1, alP_, l_reg, pa0, pa1, pa2, pa3); else { asm volatile("" : "+v"(PP0), "+v"(PP1)); asm volatile("" : "+v"(pa0), "+v"(pa1), "+v"(pa2), "+v"(pa3)); } SBAR(); } while (0)
#define YPART(PC0, PC1, alC_, j_) do { \
    if (VAR == 7 && wid >= 4) { asm volatile("" : "+v"(o[0]), "+v"(o[1])); } else if (VAR != 2) pv_d0<VAR>(o, vb0 + (((j_) - 1) & 3) * SHM_V, pa0, pa1, pa2, pa3); else { asm volatile("" : "+v"(o[0]), "+v"(o[1])); } \
    if (VAR == 7 && wid >= 4) { alC_ = 1.f; } else if (VAR != 1) { partialSM(PC0, PC1, mhat, alC_, o, al_l, r32, hi); } else { asm volatile("" : "+v"(PC0), "+v"(PC1)); alC_ = 1.f; } } while (0)
#define LOOPBAR() do { if (VAR != 6) __syncthreads(); } while (0)
  if (wid < 4) {
    for (int j = 1; j + 1 < NT; j += 2) {
      XPART(pB0, pB1, pA0, pA1, alA, j); YPART(pB0, pB1, alB, j); LOOPBAR();
      XPART(pA0, pA1, pB0, pB1, alB, j + 1); YPART(pA0, pA1, alA, j + 1); LOOPBAR();
    }
    XPART(pB0, pB1, pA0, pA1, alA, NT - 1); YPART(pB0, pB1, alB, NT - 1); LOOPBAR();
  } else {
    for (int j = 1; j + 1 < NT; j += 2) {
      XPART(pB0, pB1, pA0, pA1, alA, j); LOOPBAR(); YPART(pB0, pB1, alB, j);
      XPART(pA0, pA1, pB0, pB1, alB, j + 1); LOOPBAR(); YPART(pA0, pA1, alA, j + 1);
    }
    XPART(pB0, pB1, pA0, pA1, alA, NT - 1); LOOPBAR(); YPART(pB0, pB1, alB, NT - 1);
  }
#undef LOOPBAR
#undef XPART
#undef YPART
  finishSM(pB0, pB1, alB, l_reg, pa0, pa1, pa2, pa3); SBAR();
  pv_d0(o, vb0 + ((NT - 1) & 3) * SHM_V, pa0, pa1, pa2, pa3);
  const int un = u + G; bf16_t* Yw = A.Y + ((size_t)b * SEQ + q0 + wid * QBLK) * 1024 + 512 + h * DV;
  if (un < 1536) PREFETCH(un);
  { auto rr = __builtin_amdgcn_permlane32_swap(__float_as_uint(l_reg), __float_as_uint(l_reg), false, false); l_reg = __uint_as_float(rr[0]) + __uint_as_float(rr[1]); }
  if (hi == 0) li_l[r32] = l_reg; asm volatile("s_waitcnt lgkmcnt(0)" ::: "memory");
  float rli[16];
#pragma unroll
  for (int r = 0; r < 16; ++r) rli[r] = __builtin_amdgcn_rcpf(li_l[crow(r, hi)]);
#pragma unroll
  for (int r = 0; r < 16; ++r) { const int orow = crow(r, hi);
#pragma unroll
    for (int d0 = 0; d0 < 2; ++d0) { const unsigned pk = cvtpk(o[d0][r] * rli[r], 0.f); Yw[(size_t)orow * 1024 + d0 * 32 + r32] = (bf16_t)(pk & 0xffffu); } }
  __syncthreads();
  if (un >= 1536) break;
  u = un;
  }
#undef SLOAD
#undef SWRITE
#undef PREFETCH
#undef RESC
}
#undef SBAR
}

constexpr int NWAVES = 8;
constexpr int M = 49152, DM = 1024, SEQL = 2048, MPR = 32768, NPH = 9;
constexpr size_t MiB = 1u << 20;
constexpr size_t WS_CTL = 0, CTL_ZERO_BYTES = 1 * MiB;
constexpr size_t WS_TAB = 1 * MiB;
constexpr size_t WS_SSZ = 2 * MiB, SSZ_BYTES = 13 * (size_t)M * 4;
constexpr size_t WS_SS1 = 5 * MiB;
constexpr size_t WS_KRR = 6 * MiB;
constexpr size_t WS_WIN = 12 * MiB, WS_WQB = WS_WIN + 1280 * 1024 * 2, WS_WKVB = WS_WQB + 768 * 384 * 2, WS_WO = 16 * MiB, WS_WGU = 18 * MiB, WS_WD = 29 * MiB, WS_WPG = 35 * MiB, WS_WPP = 37 * MiB;
constexpr size_t WS_PB = 40 * MiB;
constexpr size_t WS_Z = 64 * MiB;
constexpr size_t WS_XB = 184 * MiB;
constexpr size_t WS_Q = 184 * MiB, WS_K = 256 * MiB, WS_V = 328 * MiB, WS_Y = 376 * MiB;
constexpr size_t WS_HB = 64 * MiB;
constexpr size_t WS_ACT = 184 * MiB;
constexpr size_t WS_PROJ = 184 * MiB;
constexpr size_t WS_END = 472 * MiB;
static_assert(WS_WKVB + 1024 * 256 * 2 <= WS_WO && WS_WGU + (size_t)5632 * 1024 * 2 <= WS_WD && WS_WD + (size_t)1024 * 2816 * 2 <= WS_WPG && WS_WPP + 1024 * 256 * 2 <= WS_PB, "weight map");
static_assert(WS_SSZ + SSZ_BYTES <= WS_SS1 && WS_SS1 + 2 * (size_t)M * 4 <= WS_KRR && WS_KRR + (size_t)M * 32 * 4 <= WS_WIN, "small arrays map");
constexpr int CW_TMO = 0, CW_BAR = 4096;
constexpr int RING_OFF = 0, RING_BYTES = 131072, LDSCTL_OFF = RING_BYTES, MISC_OFF = LDSCTL_OFF + 320, LDS_BYTES = 147456;

#define GAS __attribute__((address_space(1)))
#define LAS __attribute__((address_space(3)))
typedef unsigned short bf16;
typedef unsigned v4u __attribute__((ext_vector_type(4)));
typedef float f32x4 __attribute__((ext_vector_type(4)));
typedef GAS unsigned gu32;
#define RLX_AGENT __ATOMIC_RELAXED, __HIP_MEMORY_SCOPE_AGENT
#define LDS_WAIT() asm volatile("s_waitcnt lgkmcnt(0)" ::: "memory")
#define VM_WAIT() asm volatile("s_waitcnt vmcnt(0)" ::: "memory")
__device__ __forceinline__ unsigned f2bf(float f) { unsigned u = __builtin_bit_cast(unsigned, f); return (u + 0x7fffu + ((u >> 16) & 1u)) >> 16; }
__device__ __forceinline__ unsigned pk2(float lo, float hi) { return f2bf(lo) | (f2bf(hi) << 16); }

#define XB_TMO      128
#define XB_XCNT(j)  (256  + 64 * (j))
#define XB_XSUB(j)  (1280 + 64 * (j))
#define XB_XGEN(j)  (2304 + 64 * (j))
#define XB_TOP      3328
#define XB_TOPGEN   3392
#define XCD_BAR_WORDS 3456
#define XB_SPIN_CAP (1u << 18)

__device__ __forceinline__ unsigned xb_ld(unsigned* p)              { return __hip_atomic_load(p, __ATOMIC_RELAXED, __HIP_MEMORY_SCOPE_AGENT); }
__device__ __forceinline__ unsigned xb_add(unsigned* p, unsigned v) { return __hip_atomic_fetch_add(p, v, __ATOMIC_RELAXED, __HIP_MEMORY_SCOPE_AGENT); }
__device__ __forceinline__ unsigned xb_xcc_id() { return (unsigned)__builtin_amdgcn_s_getreg((3 << 11) | 20) & 0xFu; }
#define XB_SPIN(cond, bar) do { unsigned _sp = 0; while (cond) { __builtin_amdgcn_s_sleep(1); \
    if ((++_sp & 255u) == 0u) { if (xb_ld(&(bar)[XB_TMO])) break; if (_sp > XB_SPIN_CAP) { atomicAdd(&(bar)[XB_TMO], 1u); break; } } } } while (0)

struct XcdBarrier {
    unsigned* bar; unsigned x;
    volatile LAS unsigned* st;
};

__device__ __forceinline__ XcdBarrier xcd_barrier_post(unsigned* bar, volatile LAS unsigned* st) {
    XcdBarrier b; b.bar = bar; b.x = xb_xcc_id(); b.st = st;
    if (threadIdx.x == 0) (void)xb_add(&bar[XB_XCNT(b.x)], 1u);
    return b;
}
__device__ __forceinline__ void xcd_barrier_complete(unsigned* bar, unsigned x, unsigned& nloc, unsigned& nx) {
    const unsigned G = gridDim.x * gridDim.y * gridDim.z;
    unsigned sum, cnt, mine, sp = 0u;
    for (;;) {
        sum = 0u; cnt = 0u; mine = 0u;
#pragma unroll
        for (unsigned j = 0; j < 16; ++j) { const unsigned c = xb_ld(&bar[XB_XCNT(j)]); sum += c; cnt += (c > 0u) ? 1u : 0u; mine = (j == x) ? c : mine; }
        if (sum == G) break;
        __builtin_amdgcn_s_sleep(1);
        if ((++sp & 255u) == 0u) { if (xb_ld(&bar[XB_TMO])) break; if (sp > XB_SPIN_CAP) { atomicAdd(&bar[XB_TMO], 1u); break; } }
    }
    nloc = mine > 0u ? mine : 1u; nx = cnt > 0u ? cnt : 1u;
}

__device__ __forceinline__ void xcd_barrier(const XcdBarrier& b) {
    asm volatile("s_waitcnt vmcnt(0)" ::: "memory");
    __syncthreads();
    if (threadIdx.x == 0) {
        unsigned* bar = b.bar;
        __builtin_amdgcn_s_waitcnt(0);
        unsigned nloc = b.st[0], nx = b.st[1];
        if (nloc == 0u) { xcd_barrier_complete(bar, b.x, nloc, nx); b.st[0] = nloc; b.st[1] = nx; }
        const unsigned old = xb_add(&bar[XB_XSUB(b.x)], 1u);
        const unsigned gen = old / nloc;
        if (old + 1u == (gen + 1u) * nloc) {
            __builtin_amdgcn_fence(__ATOMIC_RELEASE, "agent");
            asm volatile("s_waitcnt vmcnt(0)" ::: "memory");
            const unsigned og = xb_add(&bar[XB_TOP], 1u);
            const unsigned tg = og / nx;
            if (og + 1u == (tg + 1u) * nx) xb_add(&bar[XB_TOPGEN], 1u);
            else XB_SPIN(xb_ld(&bar[XB_TOPGEN]) == tg, bar);
            __builtin_amdgcn_fence(__ATOMIC_ACQUIRE, "agent");
            xb_add(&bar[XB_XGEN(b.x)], 1u);
            asm volatile("s_waitcnt vmcnt(0)" ::: "memory");
        } else {
            XB_SPIN(xb_ld(&bar[XB_XGEN(b.x)]) == gen, bar);
            __builtin_amdgcn_fence(__ATOMIC_ACQUIRE, "agent");
            asm volatile("s_waitcnt vmcnt(0)" ::: "memory");
        }
    }
    __syncthreads();
}


struct Frame {
    LAS unsigned char* lds; volatile LAS unsigned* MISC; gu32* ctl;
    int tid, lane, wave, vcu, G;
};
struct Args { const float* in[22]; float* out; unsigned char* ws; int ph_lo, ph_hi, p0mask, pad; };

__device__ __forceinline__ float wave_sum(float v) {
#pragma unroll
    for (int o = 1; o < 64; o <<= 1) v += __shfl_xor(v, o);
    return v;
}
enum { MAP_ID = 0, MAP_IN = 1, MAP_QB = 2, MAP_KVB = 3, MAP_GU = 4 };
__device__ __forceinline__ int map_col(int map, int n) {
    if (map == MAP_IN) { if (n < 896) return n; if (n < 928) { const int i = n - 896, pr = i >> 1; return 1152 + ((i & 1) ? 16 + pr : pr); } if (n < 1024) return -1; return 896 + (n - 1024); }
    if (map == MAP_QB) { const int slab = n >> 5, c = n & 31, head = slab / 3, part = slab - 3 * head; const int lg = part < 2 ? part * 32 + c : 64 + ((c & 1) ? 16 + (c >> 1) : (c >> 1)); return head * 96 + lg; }
    if (map == MAP_KVB) { const int t = n >> 8, r = n & 255, bj = r >> 7, wc = (r >> 5) & 3, c = r & 31; return (2 * t + (wc & 1)) * 128 + (wc >> 1) * 64 + bj * 32 + c; }
    if (map == MAP_GU) { const int pn = n >> 8, r = n & 255; return ((r >> 7) ? 2816 : 0) + pn * 128 + (r & 127); }
    return n;
}
__device__ __forceinline__ void p0_transpose_item(const float* W, const float* W2, int ldw, const float* gain, bf16* WT, int ldt, int kdst0, int nblk, int map, LAS float* scr, int item, int lane) {
    const int kb = item / nblk, nb = item - kb * nblk, k0 = 64 * kb, n0 = 32 * nb;
    int col = map_col(map, n0 + (lane & 31)); const float* src = W; if (map == MAP_GU && col >= 2816) { col -= 2816; src = W2; }
    const float msk = col < 0 ? 0.f : 1.f; col = col < 0 ? 0 : col;
    const float* sp = src + (size_t)(k0 + (lane >> 5)) * ldw + col;
    float v[32];
#pragma unroll
    for (int i = 0; i < 32; ++i) v[i] = sp[(size_t)(2 * i) * ldw];
    if (gain) {
        const float* gp = gain + k0 + (lane >> 5);
#pragma unroll
        for (int i = 0; i < 32; ++i) v[i] *= gp[2 * i];
    }
#pragma unroll
    for (int i = 0; i < 32; ++i) scr[(2 * i + (lane >> 5)) * 33 + (lane & 31)] = v[i] * msk;
    LDS_WAIT(); asm volatile("" ::: "memory");
    const int c = lane & 7;
#pragma unroll
    for (int j = 0; j < 4; ++j) { const int n = (lane >> 3) + 8 * j; const LAS float* s = scr + (8 * c) * 33 + n;
        v4u o; o.x = pk2(s[0 * 33], s[1 * 33]); o.y = pk2(s[2 * 33], s[3 * 33]); o.z = pk2(s[4 * 33], s[5 * 33]); o.w = pk2(s[6 * 33], s[7 * 33]);
        *(GAS v4u*)(WT + (size_t)(n0 + n) * ldt + kdst0 + k0 + 8 * c) = o; }
    LDS_WAIT(); asm volatile("" ::: "memory");
}
__device__ __forceinline__ void p0_prologue(Frame& F, const Args& a) {
    unsigned char* ws = a.ws;
    LAS float* scr = (LAS float*)(F.lds + RING_OFF + F.wave * 16384);
    constexpr int AW0 = 4, AW = NWAVES - AW0;
    const int pm_ = a.p0mask;
    if (F.wave >= AW0) {
    const int gw = F.vcu * AW + (F.wave - AW0), NGW = F.G * AW;
    const int gt = gw * 64 + F.lane, NGT = NGW * 64;
    if (pm_ & 1) { v4u* zp = (v4u*)(ws + WS_SSZ); const v4u zz = {0u, 0u, 0u, 0u}; for (int i = gt; i < (int)(SSZ_BYTES / 16); i += NGT) zp[i] = zz; }
    if (pm_ & 1) { float* tab = (float*)(ws + WS_TAB); for (int i = gt; i < SEQL * 16; i += NGT) { const int t = i >> 4, f = i & 15; const float ang = (float)t * powf(10000.0f, -(float)(2 * f) / 32.0f); tab[2 * i] = cosf(ang); tab[2 * i + 1] = sinf(ang); } }
    if (pm_ & 2) {
        const float *ln1 = a.in[4], *w_in = a.in[5], *qan = a.in[8], *w_qb = a.in[9], *kvan = a.in[10], *w_kvb = a.in[11], *w_o = a.in[14], *ln2 = a.in[15], *w_gate = a.in[16], *w_up = a.in[17], *w_down = a.in[18], *plen = a.in[19], *w_pg = a.in[20], *w_pp = a.in[21];
        constexpr int I_IN = (1024 / 64) * (1280 / 32), I_QB = (384 / 64) * (768 / 32), I_KVB = (256 / 64) * (1024 / 32), I_O = (512 / 64) * (1024 / 32), I_GU = (1024 / 64) * (5632 / 32), I_D = (2816 / 64) * (1024 / 32), I_PG = (1024 / 64) * (1024 / 32), I_PP = (256 / 64) * (1024 / 32);
        constexpr int NITEMS = I_IN + I_QB + I_KVB + I_O + I_GU + I_D + I_PG + I_PP;
        for (int it = gw; it < NITEMS; it += NGW) {
            int r = it;
            if (r < I_IN) { p0_transpose_item(w_in, nullptr, 1184, ln1, (bf16*)(ws + WS_WIN), 1024, 0, 1280 / 32, MAP_IN, scr, r, F.lane); continue; } r -= I_IN;
            if (r < I_QB) { p0_transpose_item(w_qb, nullptr, 768, qan, (bf16*)(ws + WS_WQB), 384, 0, 768 / 32, MAP_QB, scr, r, F.lane); continue; } r -= I_QB;
            if (r < I_KVB) { p0_transpose_item(w_kvb, nullptr, 1024, kvan, (bf16*)(ws + WS_WKVB), 256, 0, 1024 / 32, MAP_KVB, scr, r, F.lane); continue; } r -= I_KVB;
            if (r < I_O) { p0_transpose_item(w_o + (size_t)512 * 1024, nullptr, 1024, nullptr, (bf16*)(ws + WS_WO), 1024, 512, 1024 / 32, MAP_ID, scr, r, F.lane); continue; } r -= I_O;
            if (r < I_GU) { p0_transpose_item(w_gate, w_up, 2816, ln2, (bf16*)(ws + WS_WGU), 1024, 0, 5632 / 32, MAP_GU, scr, r, F.lane); continue; } r -= I_GU;
            if (r < I_D) { p0_transpose_item(w_down, nullptr, 1024, nullptr, (bf16*)(ws + WS_WD), 2816, 0, 1024 / 32, MAP_ID, scr, r, F.lane); continue; } r -= I_D;
            if (r < I_PG) { p0_transpose_item(w_pg, nullptr, 1024, plen, (bf16*)(ws + WS_WPG), 1024, 0, 1024 / 32, MAP_ID, scr, r, F.lane); continue; } r -= I_PG;
            p0_transpose_item(w_pp, nullptr, 1024, nullptr, (bf16*)(ws + WS_WPP), 256, 0, 1024 / 32, MAP_ID, scr, r, F.lane);
        }
    }
    if (pm_ & 4) {
        const float* w_pool = a.in[6]; const float* psc = a.in[7]; const float* w_o = a.in[14]; bf16* WO = (bf16*)(ws + WS_WO);
        for (int it = gw; it < 512; it += NGW) {
            const int kb = it >> 4, nb = it & 15, kk0 = kb * 16, g = kk0 >> 7, n = nb * 64 + F.lane;
            const float* wo = w_o + (size_t)(g * 128) * 1024 + n; const float* wp = w_pool + (size_t)kk0 * 128; const float* sc = psc + g * 128;
            { float t[32];
#pragma unroll
                for (int i = 0; i < 32; ++i) t[i] = wp[i * 64 + F.lane];
                const float s0 = sc[F.lane], s1 = sc[64 + F.lane];
#pragma unroll
                for (int i = 0; i < 32; ++i) scr[i * 64 + F.lane] = t[i] * ((i & 1) ? s1 : s0); }
            LDS_WAIT(); asm volatile("" ::: "memory");
            float acc[16];
#pragma unroll
            for (int e = 0; e < 16; ++e) acc[e] = 0.f;
#pragma unroll 1
            for (int j0 = 0; j0 < 128; j0 += 32) {
                float w[32];
#pragma unroll
                for (int j = 0; j < 32; ++j) w[j] = wo[(size_t)(j0 + j) * 1024];
#pragma unroll
                for (int j = 0; j < 32; j += 4)
#pragma unroll
                    for (int e = 0; e < 16; ++e) { const f32x4 av = *(const LAS f32x4*)(scr + e * 128 + j0 + j);
                        acc[e] = fmaf(av.x, w[j], acc[e]); acc[e] = fmaf(av.y, w[j + 1], acc[e]); acc[e] = fmaf(av.z, w[j + 2], acc[e]); acc[e] = fmaf(av.w, w[j + 3], acc[e]); }
            }
            v4u o0, o1; o0.x = pk2(acc[0], acc[1]); o0.y = pk2(acc[2], acc[3]); o0.z = pk2(acc[4], acc[5]); o0.w = pk2(acc[6], acc[7]); o1.x = pk2(acc[8], acc[9]); o1.y = pk2(acc[10], acc[11]); o1.z = pk2(acc[12], acc[13]); o1.w = pk2(acc[14], acc[15]);
            *(GAS v4u*)(WO + (size_t)n * 1024 + kk0) = o0; *(GAS v4u*)(WO + (size_t)n * 1024 + kk0 + 8) = o1;
            LDS_WAIT(); asm volatile("" ::: "memory");
        }
    }
    }
    if (pm_ & 8) {
        bf16* XB = (bf16*)a.out; bf16* PB = (bf16*)(ws + WS_PB); float* xinv = (float*)(ws + WS_SS1);
        volatile LAS int* ctr = (volatile LAS int*)(F.lds + LDSCTL_OFF + 64);
        const int ppb = (M / 2) / F.G, pbase = F.vcu * ppb, ptot = (F.vcu == F.G - 1) ? (M / 2) - pbase : ppb;
        for (;;) {
            int pr = 0; if (F.lane == 0) pr = __hip_atomic_fetch_add((LAS int*)ctr, 1, __ATOMIC_RELAXED, __HIP_MEMORY_SCOPE_WORKGROUP);
            pr = __builtin_amdgcn_readfirstlane(pr); if (pr >= ptot) break;
            const int m0 = 2 * (pbase + pr);
            f32x4 v[2][4], pv[2];
#pragma unroll
            for (int r = 0; r < 2; ++r) { const int m = m0 + r;
                const float* xrow = m < MPR ? a.in[0] + (size_t)m * DM : a.in[1] + (size_t)(m - MPR) * DM;
                const float* prow = m < MPR ? a.in[2] + (size_t)m * 256 : a.in[3] + (size_t)(m - MPR) * 256;
                const GAS f32x4* xr = (const GAS f32x4*)xrow + F.lane;
#pragma unroll
                for (int j = 0; j < 4; ++j) v[r][j] = __builtin_nontemporal_load(xr + 64 * j);
                pv[r] = __builtin_nontemporal_load((const GAS f32x4*)prow + F.lane); }
#pragma unroll
            for (int r = 0; r < 2; ++r) { const int m = m0 + r; float s = 0.f;
#pragma unroll
                for (int j = 0; j < 4; ++j) s += (v[r][j].x * v[r][j].x + v[r][j].y * v[r][j].y) + (v[r][j].z * v[r][j].z + v[r][j].w * v[r][j].w);
                s = wave_sum(s); const float rs = 1.0f / sqrtf(s * (1.0f / 1024.0f) + 1e-6f);
                if (F.lane == 0) xinv[m] = sqrtf(s * (1.0f / 1024.0f) + 1e-6f);
                GAS unsigned long long* o8 = (GAS unsigned long long*)(XB + (size_t)m * DM) + F.lane;
#pragma unroll
                for (int j = 0; j < 4; ++j) o8[64 * j] = (unsigned long long)pk2(v[r][j].x * rs, v[r][j].y * rs) | ((unsigned long long)pk2(v[r][j].z * rs, v[r][j].w * rs) << 32);
                ((GAS unsigned long long*)(PB + (size_t)m * 256))[F.lane] = (unsigned long long)pk2(pv[r].x, pv[r].y) | ((unsigned long long)pk2(pv[r].z, pv[r].w) << 32); }
        }
    }
}
template <int W, int R> __device__ __forceinline__ void pool_quad(const bf16* Z, bf16* Y, int row0, int c8) {
    const int t0 = row0 & (SEQL - 1), lo = t0 - W / 2; const bf16* zb = Z + (size_t)(row0 - t0) * 1280 + c8 * 8;
    v4u wv[W + R - 1];
#pragma unroll
    for (int i = 0; i < W + R - 1; ++i) { const int j = lo + i; const bool ok = j >= 0 && j < SEQL; wv[i] = *(const GAS v4u*)(zb + (size_t)(ok ? j : t0) * 1280); if (!ok) wv[i] = (v4u){0u, 0u, 0u, 0u}; }
#define PF(VV, e) (((e) & 1) ? __uint_as_float(((e) >> 1) == 0 ? (VV).x & 0xffff0000u : ((e) >> 1) == 1 ? (VV).y & 0xffff0000u : ((e) >> 1) == 2 ? (VV).z & 0xffff0000u : (VV).w & 0xffff0000u) \
                            : __uint_as_float(((e) >> 1) == 0 ? (VV).x << 16 : ((e) >> 1) == 1 ? (VV).y << 16 : ((e) >> 1) == 2 ? (VV).z << 16 : (VV).w << 16))
    float s[8];
#pragma unroll
    for (int e = 0; e < 8; ++e) { s[e] = 0.f;
#pragma unroll
        for (int i = 0; i < W; ++i) s[e] += PF(wv[i], e); }
#pragma unroll
    for (int r = 0; r < R; ++r) {
        if (r > 0) {
#pragma unroll
            for (int e = 0; e < 8; ++e) s[e] += PF(wv[W + r - 1], e) - PF(wv[r - 1], e); }
        const int t = t0 + r, a = t - W / 2, b = a + W; const float inv = 1.0f / (float)((b > SEQL ? SEQL : b) - (a < 0 ? 0 : a)); const v4u cv = wv[r + W / 2];
        v4u o; o.x = pk2(s[0] * inv - PF(cv, 0), s[1] * inv - PF(cv, 1)); o.y = pk2(s[2] * inv - PF(cv, 2), s[3] * inv - PF(cv, 3)); o.z = pk2(s[4] * inv - PF(cv, 4), s[5] * inv - PF(cv, 5)); o.w = pk2(s[6] * inv - PF(cv, 6), s[7] * inv - PF(cv, 7));
        *(GAS v4u*)(Y + (size_t)(row0 + r) * 1024 + c8 * 8) = o;
    }
#undef PF
}
__device__ __forceinline__ void pool_phase(Frame& F, const bf16* Z, bf16* Y) {
    const int gw = F.vcu * NWAVES + F.wave, NGW = F.G * NWAVES;
    constexpr int R = 8;
    for (int wi = gw; wi < M / R; wi += NGW) {
        const int g = (wi + (wi >> 11)) & 3, row0 = ((wi >> 2) * 4 + (F.lane >> 4)) * R, c8 = g * 16 + (F.lane & 15);
        if (g == 0) pool_quad<2, R>(Z, Y, row0, c8); else if (g == 1) pool_quad<4, R>(Z, Y, row0, c8); else if (g == 2) pool_quad<8, R>(Z, Y, row0, c8); else pool_quad<16, R>(Z, Y, row0, c8);
    }
}

__global__ void __launch_bounds__(NWAVES * 64, 2) mega_fwd(Args args) {
    extern __shared__ __attribute__((aligned(16))) unsigned char lds[];
    Frame F;
    F.lds = (LAS unsigned char*)lds; F.MISC = (volatile LAS unsigned*)(F.lds + MISC_OFF);
    F.tid = threadIdx.x; F.lane = F.tid & 63; F.wave = __builtin_amdgcn_readfirstlane(F.tid >> 6);
    F.G = gridDim.x; { const int bx = blockIdx.x; F.vcu = (F.G % 8 == 0) ? (bx % 8) * (F.G / 8) + bx / 8 : bx; }
    unsigned char* ws = args.ws; F.ctl = (gu32*)(ws + WS_CTL);
    for (int u = F.tid; u < (LDS_BYTES - LDSCTL_OFF) / 4; u += NWAVES * 64) ((LAS unsigned*)(F.lds + LDSCTL_OFF))[u] = 0u;
    __syncthreads();
    XcdBarrier bar = xcd_barrier_post((unsigned*)(F.ctl + CW_BAR), F.MISC + 8);
    const int lo = args.ph_lo, hi = args.ph_hi;
#ifdef TS_BUILD
    unsigned long long* tsb = (unsigned long long*)(ws + 39 * MiB); int nts = 0;
#define STAMP() do { if (blockIdx.x == 0 && F.tid == 0) tsb[nts] = __builtin_amdgcn_s_memrealtime(); ++nts; } while (0)
#else
#define STAMP() do {} while (0)
#endif
    STAMP();
#ifndef PHMASK
#define PHMASK 0x1ff
#endif
#define IN(k) (((PHMASK >> (k)) & 1) && lo <= (k) && (k) < hi)
#ifndef REPEAT_MASK
#define REPEAT_MASK 0
#endif
#define REPS(k) for (int rep = 0; rep < 1 + ((REPEAT_MASK >> (k)) & 1); ++rep)
    float* spare = (float*)(ws + 38 * MiB);
#define SEAM(k) do { if (IN(k) && IN((k) + 1)) xcd_barrier(bar); STAMP(); } while (0)
    float* ssz = (float*)(ws + WS_SSZ); float *ss_q = ssz, *ss_kv = ssz + M, *ss2 = ssz + 2 * (size_t)M, *ss3 = ssz + 3 * (size_t)M, *hss = ssz + 5 * (size_t)M;
    float* ss1 = (float*)(ws + WS_SS1); float* ss_kr = ss1 + M; float* krr = (float*)(ws + WS_KRR); const float* tab = (const float*)(ws + WS_TAB);
    float* out = args.out;

    if (IN(0)) REPS(0) { p0_prologue(F, args); } SEAM(0);
    if (IN(1)) REPS(1) {
        pg8::Gemm g{(const pg8::bf16_t*)out, (const pg8::bf16_t*)(ws + WS_WIN), M, 1280, 1024, 1024}; pg8::StaticOrder S; S.init(M, 1280, F.G, (int)blockIdx.x);
        pg8::EpiIn E{(pg8::bf16_t*)(ws + WS_Z), ss1, rep ? spare : ss_q, rep ? spare : ss_kv, ss_kr, krr, args.in[13], tab};
        pg8::gemm_phase<pg8::EpiIn, pg8::StaticOrder, true, true>(F.lds + RING_OFF, g, S, E);
    } SEAM(1);
    if (IN(2)) {
        REPS(9) { pool_phase(F, (const bf16*)(ws + WS_Z), (bf16*)(ws + WS_Y)); VM_WAIT(); }
        REPS(10) { pg8::Gemm g{(const pg8::bf16_t*)(ws + WS_Z) + 512, (const pg8::bf16_t*)(ws + WS_WQB), M, 768, 384, 1280}; pg8::StaticOrder S; S.init(M, 768, F.G, (int)blockIdx.x);
          pg8::EpiQ E{(pg8::bf16_t*)(ws + WS_Q), ss_q, rep ? spare : hss};
          pg8::gemm_phase<pg8::EpiQ, pg8::StaticOrder, true, true>(F.lds + RING_OFF, g, S, E); }
        REPS(11) { pg8::Gemm g{(const pg8::bf16_t*)(ws + WS_Z) + 1024, (const pg8::bf16_t*)(ws + WS_WKVB), M, 1024, 256, 1280}; pg8::StaticOrder S; S.init(M, 1024, F.G, (int)blockIdx.x);
          pg8::EpiKV E{(pg8::bf16_t*)(ws + WS_K), (pg8::bf16_t*)(ws + WS_V), ss_kv, ss_kr, krr, args.in[13], 0};
          pg8::gemm_phase<pg8::EpiKV, pg8::StaticOrder, true, true>(F.lds + RING_OFF, g, S, E); }
    } SEAM(2);
    if (IN(3)) REPS(3) {
        const att::AttnArgs A{(const att::bf16_t*)(ws + WS_Q), (const att::bf16_t*)(ws + WS_K), (const att::bf16_t*)(ws + WS_V), ss_q, hss, args.in[12], tab, (att::bf16_t*)(ws + WS_Y)};
        { const int var_ = args.p0mask >> 5; att::LCH* al_ = (att::LCH*)(F.lds + RING_OFF);
#ifdef ATTN_VARIANTS
          if (var_ == 1) att::attn_phase<1>(A, F.vcu, F.G, al_, args.p0mask); else if (var_ == 2) att::attn_phase<2>(A, F.vcu, F.G, al_, args.p0mask); else if (var_ == 3) att::attn_phase<3>(A, F.vcu, F.G, al_, args.p0mask); else if (var_ == 4) att::attn_phase<4>(A, F.vcu, F.G, al_, args.p0mask); else
#endif
          att::attn_phase<0>(A, F.vcu, F.G, al_, args.p0mask); (void)var_; }
    } SEAM(3);
    if (IN(4)) REPS(4) {
        pg8::Gemm g{(const pg8::bf16_t*)(ws + WS_Y), (const pg8::bf16_t*)(ws + WS_WO), M, 1024, 1024, 1024}; pg8::StaticOrder S; S.init(M, 1024, F.G, (int)blockIdx.x);
        pg8::EpiResX E{(const pg8::bf16_t*)out, ss1, (pg8::bf16_t*)(ws + WS_HB), rep ? spare : ss2};
        pg8::gemm_phase<pg8::EpiResX, pg8::StaticOrder, true, true>(F.lds + RING_OFF, g, S, E);
    } SEAM(4);
    if (IN(5)) REPS(5) {
        pg8::Gemm g{(const pg8::bf16_t*)(ws + WS_HB), (const pg8::bf16_t*)(ws + WS_WGU), M, 5632, 1024, 1024}; pg8::StaticOrder S; S.init(M, 5632, F.G, (int)blockIdx.x);
        pg8::EpiSwiglu E{(pg8::bf16_t*)(ws + WS_ACT), ss2};
        pg8::gemm_phase<pg8::EpiSwiglu, pg8::StaticOrder, true, true>(F.lds + RING_OFF, g, S, E);
    } SEAM(5);
    if (IN(6)) {
        pg8::Gemm g{(const pg8::bf16_t*)(ws + WS_ACT), (const pg8::bf16_t*)(ws + WS_WD), M, 1024, 2816, 2816}; pg8::StaticOrder S; S.init(M, 1024, F.G, (int)blockIdx.x, 1);
        pg8::EpiResB E{(pg8::bf16_t*)(ws + WS_HB), ss3};
        pg8::gemm_phase<pg8::EpiResB, pg8::StaticOrder, true, true>(F.lds + RING_OFF, g, S, E);
    } SEAM(6);
    if (IN(7)) REPS(7) {
        pg8::Gemm g{(const pg8::bf16_t*)(ws + WS_PB), (const pg8::bf16_t*)(ws + WS_WPP), M, 1024, 256, 256}; pg8::StaticOrder S; S.init(M, 1024, F.G, (int)blockIdx.x);
        pg8::EpiStore E{(pg8::bf16_t*)(ws + WS_PROJ)};
        pg8::gemm_phase<pg8::EpiStore, pg8::StaticOrder, true, true>(F.lds + RING_OFF, g, S, E);
    }
    if (IN(7) && IN(8)) { VM_WAIT(); __syncthreads(); } STAMP();
    if (IN(8)) {
        pg8::Gemm g{(const pg8::bf16_t*)(ws + WS_HB), (const pg8::bf16_t*)(ws + WS_WPG), M, 1024, 1024, 1024}; pg8::StaticOrder S; S.init(M, 1024, F.G, (int)blockIdx.x);
        pg8::EpiFinal E{out, (const pg8::bf16_t*)(ws + WS_HB), (const pg8::bf16_t*)(ws + WS_PROJ), ss3};
        pg8::gemm_phase<pg8::EpiFinal, pg8::StaticOrder, true, true>(F.lds + RING_OFF, g, S, E);
    }
    STAMP();
#undef IN
#undef SEAM
}

static int launch_fast(void* const* d_in, void* d_out, void* d_ws, size_t ws_size, hipStream_t stream, int ph_lo, int ph_hi, int p0mask = 15) {
    static int grid = 0;
    if (grid == 0) {
        if (ws_size < WS_END) { fprintf(stderr, "kernel_launch: workspace too small: %zu < %zu\n", ws_size, (size_t)WS_END); grid = -1; return -1; }
        int dev = 0, cus = 0, per_cu = 0;
        if (hipGetDevice(&dev) != hipSuccess || hipDeviceGetAttribute(&cus, hipDeviceAttributeMultiprocessorCount, dev) != hipSuccess) { grid = -1; return -1; }
        if (hipFuncSetAttribute((const void*)mega_fwd, hipFuncAttributeMaxDynamicSharedMemorySize, LDS_BYTES) != hipSuccess) { fprintf(stderr, "kernel_launch: hipFuncSetAttribute failed\n"); grid = -1; return -1; }
        if (hipOccupancyMaxActiveBlocksPerMultiprocessor(&per_cu, (const void*)mega_fwd, NWAVES * 64, LDS_BYTES) != hipSuccess || per_cu < 1) fprintf(stderr, "kernel_launch: note: occupancy query reports %d\n", per_cu);
        (void)hipGetLastError();
        grid = cus;
    }
    if (grid < 0) return -1;
    if (hipMemsetAsync((char*)d_ws + WS_CTL, 0, CTL_ZERO_BYTES, stream) != hipSuccess) return -1;
    Args a{};
    for (int i = 0; i < 22; ++i) a.in[i] = (const float*)d_in[i];
    a.out = (float*)d_out; a.ws = (unsigned char*)d_ws; a.ph_lo = ph_lo; a.ph_hi = ph_hi; a.p0mask = p0mask;
    hipLaunchKernelGGL(mega_fwd, dim3(grid), dim3(NWAVES * 64), LDS_BYTES, stream, a);
    const hipError_t le = hipPeekAtLastError();
    if (le != hipSuccess) { fprintf(stderr, "kernel_launch: launch failed: %s\n", hipGetErrorName(le)); return -1; }
    return 0;
}

extern "C" void kernel_launch(void* const* d_in, const int* in_sizes, int n_in, void* d_out, int out_size, void* d_ws, size_t ws_size, hipStream_t stream) {
  (void)in_sizes; (void)n_in; (void)out_size;
  launch_fast(d_in, d_out, d_ws, ws_size, stream, 0, NPH);
}
```

```cpp
#include <hip/hip_runtime.h>
#include <cstdio>
#include <cstdint>

namespace pg8 {
#define PG8_LAS __attribute__((address_space(3)))
typedef unsigned short bf16_t;
typedef short bf16x8 __attribute__((ext_vector_type(8)));
typedef float f32x4 __attribute__((ext_vector_type(4)));
typedef unsigned u32x4 __attribute__((ext_vector_type(4)));
constexpr int BM = 256, BK = 64, HALF = 128, HTB = HALF * BK * 2  , STAGE_BYTES = 8 * HTB, NXCD = 8, WGM = 8;

__host__ __device__ __forceinline__ int lds_byte(int r, int c) { const int st = (r >> 4) * 2 + (c >> 5), rr = r & 15, cc = c & 31, ob = rr * 64 + cc * 2; return st * 1024 + (ob ^ (((ob >> 9) & 1) << 5)); }
__host__ __device__ __forceinline__ void stage_rc(int b, int& R, int& C) { const int st = b / 1024, sb = b % 1024, swz = sb ^ (((sb >> 9) & 1) << 5); R = (st >> 1) * 16 + swz / 64; C = (st & 1) * 32 + (swz % 64) / 2; }
__host__ __device__ __forceinline__ int perm32(int rho) { const int n = rho >> 4, i = rho & 15; return 8 * (i >> 2) + 4 * n + (i & 3); }

struct Unit { int pm, pn; };
struct Gemm { const bf16_t* A; const bf16_t* Bt; int M, N, K, lda; const bf16_t* A2 = nullptr; int nsplit = 1 << 30; };

struct StaticOrder {
    int nM, nN, nwg, G, c, rev;
    __host__ __device__ void init(int M, int N, int G_, int c_, int rev_ = 0) { nM = M / BM; nN = N / BM; nwg = nM * nN; G = G_; c = c_; rev = rev_; }
    __host__ __device__ bool next(int i, Unit& u) const {
        long L = (long)i * G + c; if (L >= nwg) return false;
        if (rev) { const int R = nwg / G; if (i < R) L = (long)(R - 1 - i) * G + c; }
        int wgid = (int)L; { const int q = nwg / NXCD, r = nwg % NXCD, xcd = wgid % NXCD, off = wgid / NXCD; wgid = (xcd < r ? xcd * (q + 1) : r * (q + 1) + (xcd - r) * q) + off; }
        const int nig = WGM * nN, gid = wgid / nig, fm = gid * WGM, gsz = (nM - fm) < WGM ? (nM - fm) : WGM;
        u.pm = fm + ((wgid % nig) % gsz); u.pn = (wgid % nig) / gsz; return true;
    }
    __device__ __forceinline__ void a_ready(const Unit&) const {}
    __device__ __forceinline__ void done(const Unit&) const {}
};

__device__ __forceinline__ unsigned cvt_pk_bf16(float lo, float hi) { unsigned r; asm volatile("v_cvt_pk_bf16_f32 %0, %1, %2" : "=v"(r) : "v"(lo), "v"(hi)); return r; }
typedef float f32x2 __attribute__((ext_vector_type(2)));

constexpr int MROWS = 49152, SEQ = 2048, MPROMPT = 32768, ZP = 1280;
constexpr float NEPS = 1e-6f;
__device__ __forceinline__ u32x4 pack8(const f32x4 a, const f32x4 b) { u32x4 w; w.x = cvt_pk_bf16(a[0], a[1]); w.y = cvt_pk_bf16(a[2], a[3]); w.z = cvt_pk_bf16(b[0], b[1]); w.w = cvt_pk_bf16(b[2], b[3]); return w; }
__device__ __forceinline__ float sq8(const f32x4 a, const f32x4 b) { return (a[0] * a[0] + a[1] * a[1]) + (a[2] * a[2] + a[3] * a[3]) + (b[0] * b[0] + b[1] * b[1]) + (b[2] * b[2] + b[3] * b[3]); }
__device__ __forceinline__ float red_fq(float s) { s += __shfl_xor(s, 16); s += __shfl_xor(s, 32); return s; }
__device__ __forceinline__ float bflo(unsigned w) { return __uint_as_float(w << 16); }
__device__ __forceinline__ float bfhi(unsigned w) { return __uint_as_float(w & 0xffff0000u); }
#define EPI_HALF_BEGIN _Pragma("unroll") for (int ai = 0; ai < 2; ++ai) { int rbase = u.pm * BM + ai * HALF + wr * 64 + fr; asm volatile("" : "+v"(rbase) :: "memory");
#define EPI_HALF_END asm volatile("" ::: "memory"); }
#define EPI_M _Pragma("unroll") for (int m = 0; m < 4; ++m)
#define EPI_FENCE asm volatile("" ::: "memory")
__device__ __forceinline__ float rstd(float ss, float inv_n) { return 1.0f / sqrtf(ss * inv_n + NEPS); }

struct EpiIn {
    static constexpr bool PERM = true, AFTER_DRAIN = false;
    bf16_t* z; const float* ss1; float* ss_q; float* ss_kv; float* ss_kr; float* krr; const float* kn_g; const float* tab;
    __device__ __forceinline__ void operator()(const f32x4 (&acc)[2][2][4][2], const Unit& u, int wr, int wc, int fr, int fq) const {
        const int colt = u.pn * BM + wc * 32 + 8 * fq;
        EPI_HALF_BEGIN
            EPI_M { const int row = rbase + 16 * m;
                f32x4 v00 = acc[ai][0][m][0], v01 = acc[ai][0][m][1], v10 = acc[ai][1][m][0], v11 = acc[ai][1][m][1];
                bf16_t* zr = z + (size_t)row * ZP + colt;
                if (u.pn != 3) {
                    *(u32x4*)(zr) = pack8(v00, v01); *(u32x4*)(zr + HALF) = pack8(v10, v11);
                    if (u.pn == 2 || u.pn == 4) { const float s = red_fq(sq8(v00, v01) + sq8(v10, v11)); if (fq == 0) atomicAdd((u.pn == 2 ? ss_q : ss_kv) + row, s); }
                } else {
                    *(u32x4*)(zr) = pack8(v00, v01);
                    { const float s = red_fq(sq8(v00, v01)); if (fq == 0) atomicAdd(ss_q + row, s); }
                    if (wc == 0) {
                        const float s = red_fq(sq8(v10, v11)); if (fq == 0) ss_kr[row] = s;
                        const int t = row & (SEQ - 1); const float* tb = tab + ((size_t)t * 16 + 4 * fq) * 2;
                        const f32x4 cs0 = *(const f32x4*)(tb), cs1 = *(const f32x4*)(tb + 4);
                        const f32x4 g1 = *(const f32x4*)(kn_g + 64 + 4 * fq), g2 = *(const f32x4*)(kn_g + 80 + 4 * fq);
                        f32x4 o0, o1;
                        { const float a = v10[0] * g1[0], b = v10[1] * g2[0]; o0[0] = a * cs0[0] - b * cs0[1]; o0[1] = a * cs0[1] + b * cs0[0]; }
                        { const float a = v10[2] * g1[1], b = v10[3] * g2[1]; o0[2] = a * cs0[2] - b * cs0[3]; o0[3] = a * cs0[3] + b * cs0[2]; }
                        { const float a = v11[0] * g1[2], b = v11[1] * g2[2]; o1[0] = a * cs1[0] - b * cs1[1]; o1[1] = a * cs1[1] + b * cs1[0]; }
                        { const float a = v11[2] * g1[3], b = v11[3] * g2[3]; o1[2] = a * cs1[2] - b * cs1[3]; o1[3] = a * cs1[3] + b * cs1[2]; }
                        float* kr = krr + (size_t)row * 32 + 8 * fq; *(f32x4*)kr = o0; *(f32x4*)(kr + 4) = o1;
                    }
                }
            }
        EPI_HALF_END
    }
};
struct EpiQ {
    static constexpr bool PERM = true, AFTER_DRAIN = false;
    bf16_t* Q; const float* ss_q; float* hss;
    __device__ __forceinline__ void operator()(const f32x4 (&acc)[2][2][4][2], const Unit& u, int wr, int wc, int fr, int fq) const {
        const int s0 = u.pn * 8 + wc, s1 = s0 + 4; const int h0 = s0 / 3, p0 = s0 - 3 * h0, h1 = s1 / 3, p1 = s1 - 3 * h1;
        EPI_HALF_BEGIN
            EPI_M { const int row = rbase + 16 * m;
                const int b = row >> 11, t = row & (SEQ - 1);
                const f32x4 v00 = acc[ai][0][m][0], v01 = acc[ai][0][m][1], v10 = acc[ai][1][m][0], v11 = acc[ai][1][m][1];
                *(u32x4*)(Q + ((size_t)(b * 8 + h0) * SEQ + t) * 96 + p0 * 32 + 8 * fq) = pack8(v00, v01);
                *(u32x4*)(Q + ((size_t)(b * 8 + h1) * SEQ + t) * 96 + p1 * 32 + 8 * fq) = pack8(v10, v11);
                const float q0 = red_fq(sq8(v00, v01)), q1 = red_fq(sq8(v10, v11));
                if (fq == 0) { atomicAdd(hss + (size_t)h0 * MROWS + row, q0); atomicAdd(hss + (size_t)h1 * MROWS + row, q1); }
            }
        EPI_HALF_END
    }
};
struct EpiKV {
    static constexpr bool PERM = true, AFTER_DRAIN = false;
    bf16_t* K; bf16_t* V; const float* ss_kv; const float* ss_kr; const float* krr; const float* kn_g; int pn0;
    __device__ __forceinline__ void operator()(const f32x4 (&acc)[2][2][4][2], const Unit& u, int wr, int wc, int fr, int fq) const {
        const int h = 2 * (u.pn - pn0) + (wc & 1);
        EPI_HALF_BEGIN
            float rsv[4], skr[4]; f32x4 kr0[4], kr1[4];
            EPI_M rsv[m] = ss_kv[rbase + 16 * m];
            if (wc < 2) { EPI_M { skr[m] = ss_kr[rbase + 16 * m]; const float* kr = krr + (size_t)(rbase + 16 * m) * 32 + 8 * fq; kr0[m] = *(const f32x4*)kr; kr1[m] = *(const f32x4*)(kr + 4); } }
            EPI_FENCE;
            EPI_M { const int row = rbase + 16 * m; const float rs = rstd(rsv[m], 1.0f / 256.0f);
                const int b = row >> 11, t = row & (SEQ - 1);
                f32x4 v00 = acc[ai][0][m][0] * rs, v01 = acc[ai][0][m][1] * rs, v10 = acc[ai][1][m][0] * rs, v11 = acc[ai][1][m][1] * rs;
                if (wc >= 2) {
                    bf16_t* vp = V + ((size_t)(b * 8 + h) * SEQ + t) * 64 + 8 * fq;
                    *(u32x4*)(vp) = pack8(v00, v01); *(u32x4*)(vp + 32) = pack8(v10, v11);
                } else {
                    const float tot = red_fq(sq8(v00, v01) + sq8(v10, v11));
                    const float sk = rstd(tot + skr[m], 1.0f / 96.0f);
                    const f32x4 g00 = *(const f32x4*)(kn_g + 8 * fq), g01 = *(const f32x4*)(kn_g + 8 * fq + 4), g10 = *(const f32x4*)(kn_g + 32 + 8 * fq), g11 = *(const f32x4*)(kn_g + 36 + 8 * fq);
                    v00 = v00 * g00 * sk; v01 = v01 * g01 * sk; v10 = v10 * g10 * sk; v11 = v11 * g11 * sk;
                    bf16_t* kp = K + ((size_t)(b * 8 + h) * SEQ + t) * 96 + 8 * fq;
                    *(u32x4*)(kp) = pack8(v00, v01); *(u32x4*)(kp + 32) = pack8(v10, v11);
                    *(u32x4*)(kp + 64) = pack8(kr0[m] * sk, kr1[m] * sk);
                }
            }
        EPI_HALF_END
    }
};
struct EpiQKV {
    static constexpr bool PERM = true, AFTER_DRAIN = false;
    EpiQ q; EpiKV kv;
    __device__ __forceinline__ void operator()(const f32x4 (&acc)[2][2][4][2], const Unit& u, int wr, int wc, int fr, int fq) const {
        if (u.pn < 3) q(acc, u, wr, wc, fr, fq); else kv(acc, u, wr, wc, fr, fq);
    }
};
struct EpiResX {
    static constexpr bool PERM = true, AFTER_DRAIN = false;
    const bf16_t* xn; const float* xinv; bf16_t* hb; float* ss;
    __device__ __forceinline__ void operator()(const f32x4 (&acc)[2][2][4][2], const Unit& u, int wr, int wc, int fr, int fq) const {
        const int colt = u.pn * BM + wc * 32 + 8 * fq;
        EPI_HALF_BEGIN
            u32x4 xw[4][2]; float xs[4];
            EPI_M { const bf16_t* xp = xn + (size_t)(rbase + 16 * m) * 1024 + colt; xw[m][0] = *(const u32x4*)xp; xw[m][1] = *(const u32x4*)(xp + HALF); xs[m] = xinv[rbase + 16 * m]; }
            EPI_FENCE;
            EPI_M { const int row = rbase + 16 * m; float s = 0.f;
#pragma unroll
                for (int bj = 0; bj < 2; ++bj) {
                    const u32x4 w = xw[m][bj];
                    const f32x4 b0 = {bflo(w.x), bfhi(w.x), bflo(w.y), bfhi(w.y)}, b1 = {bflo(w.z), bfhi(w.z), bflo(w.w), bfhi(w.w)};
                    const f32x4 h0 = b0 * xs[m] + acc[ai][bj][m][0], h1 = b1 * xs[m] + acc[ai][bj][m][1];
                    *(u32x4*)(hb + (size_t)row * 1024 + colt + bj * HALF) = pack8(h0, h1);
                    s += sq8(h0, h1);
                }
                s = red_fq(s); if (fq == 0) atomicAdd(ss + row, s);
            }
        EPI_HALF_END
    }
};
struct EpiResB {
    static constexpr bool PERM = true, AFTER_DRAIN = false;
    bf16_t* hb; float* ss;
    __device__ __forceinline__ void operator()(const f32x4 (&acc)[2][2][4][2], const Unit& u, int wr, int wc, int fr, int fq) const {
        const int colt = u.pn * BM + wc * 32 + 8 * fq;
        EPI_HALF_BEGIN
            u32x4 hw[4][2];
            EPI_M { const bf16_t* hp = hb + (size_t)(rbase + 16 * m) * 1024 + colt; hw[m][0] = *(const u32x4*)hp; hw[m][1] = *(const u32x4*)(hp + HALF); }
            EPI_FENCE;
            EPI_M { const int row = rbase + 16 * m; float s = 0.f;
#pragma unroll
                for (int bj = 0; bj < 2; ++bj) {
                    const u32x4 w = hw[m][bj];
                    const f32x4 b0 = {bflo(w.x), bfhi(w.x), bflo(w.y), bfhi(w.y)}, b1 = {bflo(w.z), bfhi(w.z), bflo(w.w), bfhi(w.w)};
                    const f32x4 h0 = b0 + acc[ai][bj][m][0], h1 = b1 + acc[ai][bj][m][1];
                    *(u32x4*)(hb + (size_t)row * 1024 + colt + bj * HALF) = pack8(h0, h1);
                    s += sq8(h0, h1);
                }
                s = red_fq(s); if (fq == 0) atomicAdd(ss + row, s);
            }
        EPI_HALF_END
    }
};
struct EpiSwiglu {
    static constexpr bool PERM = true, AFTER_DRAIN = false;
    bf16_t* act; const float* ss2;
    __device__ __forceinline__ void operator()(const f32x4 (&acc)[2][2][4][2], const Unit& u, int wr, int wc, int fr, int fq) const {
        const int colt = u.pn * HALF + wc * 32 + 8 * fq;
        EPI_HALF_BEGIN
            float rsv[4];
            EPI_M rsv[m] = ss2[rbase + 16 * m];
            EPI_FENCE;
            EPI_M { const int row = rbase + 16 * m; const float rs = rstd(rsv[m], 1.0f / 1024.0f);
                f32x4 a[2];
#pragma unroll
                for (int n = 0; n < 2; ++n) { const f32x4 g = acc[ai][0][m][n] * rs, w = acc[ai][1][m][n] * rs;
#pragma unroll
                    for (int e = 0; e < 4; ++e) a[n][e] = g[e] * __builtin_amdgcn_rcpf(1.0f + __builtin_amdgcn_exp2f(-1.4426950408889634f * g[e])) * w[e]; }
                __builtin_nontemporal_store(pack8(a[0], a[1]), (u32x4*)(act + (size_t)row * 2816 + colt));
            }
        EPI_HALF_END
    }
};
struct EpiStore {
    static constexpr bool PERM = true, AFTER_DRAIN = false;
    bf16_t* o;
    __device__ __forceinline__ void operator()(const f32x4 (&acc)[2][2][4][2], const Unit& u, int wr, int wc, int fr, int fq) const {
        const int colt = u.pn * BM + wc * 32 + 8 * fq;
        EPI_HALF_BEGIN
            EPI_M { const int row = rbase + 16 * m;
#pragma unroll
                for (int bj = 0; bj < 2; ++bj) *(u32x4*)(o + (size_t)row * 1024 + colt + bj * HALF) = pack8(acc[ai][bj][m][0], acc[ai][bj][m][1]); }
        EPI_HALF_END
    }
};
struct EpiFinal {
    static constexpr bool PERM = true, AFTER_DRAIN = false;
    float* out; const bf16_t* hb; const bf16_t* proj; const float* ss3;
    __device__ __forceinline__ void operator()(const f32x4 (&acc)[2][2][4][2], const Unit& u, int wr, int wc, int fr, int fq) const {
        const int colt = u.pn * BM + wc * 32 + 8 * fq;
        EPI_HALF_BEGIN
            float rsv[4]; u32x4 hw[4][2], pw[4][2];
            EPI_M { const size_t off = (size_t)(rbase + 16 * m) * 1024 + colt; rsv[m] = ss3[rbase + 16 * m];
                hw[m][0] = *(const u32x4*)(hb + off); hw[m][1] = *(const u32x4*)(hb + off + HALF); pw[m][0] = *(const u32x4*)(proj + off); pw[m][1] = *(const u32x4*)(proj + off + HALF); }
            EPI_FENCE;
            EPI_M { const int row = rbase + 16 * m; const float rs = rstd(rsv[m], 1.0f / 1024.0f);
#pragma unroll
                for (int bj = 0; bj < 2; ++bj) {
                    const size_t off = (size_t)row * 1024 + colt + bj * HALF; const u32x4 pj = pw[m][bj], hv = hw[m][bj];
                    f32x4 h0 = {bflo(hv.x), bfhi(hv.x), bflo(hv.y), bfhi(hv.y)}, h1 = {bflo(hv.z), bfhi(hv.z), bflo(hv.w), bfhi(hv.w)};
                    const float pf[8] = {bflo(pj.x), bfhi(pj.x), bflo(pj.y), bfhi(pj.y), bflo(pj.z), bfhi(pj.z), bflo(pj.w), bfhi(pj.w)};
#pragma unroll
                    for (int e = 0; e < 4; ++e) { const float g0 = acc[ai][bj][m][0][e] * rs, g1 = acc[ai][bj][m][1][e] * rs;
                        h0[e] += pf[e] * __builtin_amdgcn_rcpf(1.0f + __builtin_amdgcn_exp2f(-1.4426950408889634f * g0));
                        h1[e] += pf[4 + e] * __builtin_amdgcn_rcpf(1.0f + __builtin_amdgcn_exp2f(-1.4426950408889634f * g1)); }
                    float* o = out + off; *(f32x4*)o = h0; *(f32x4*)(o + 4) = h1;
                }
            }
        EPI_HALF_END
    }
};

struct EpiNull {
    static constexpr bool PERM = true, AFTER_DRAIN = false;
    __device__ __forceinline__ void operator()(const f32x4 (&acc)[2][2][4][2], const Unit& u, int wr, int wc, int fr, int fq) const {
#pragma unroll
        for (int ai = 0; ai < 2; ++ai)
#pragma unroll
            for (int bj = 0; bj < 2; ++bj)
#pragma unroll
                for (int m = 0; m < 4; ++m) { asm volatile("" :: "v"(acc[ai][bj][m][0]), "v"(acc[ai][bj][m][1])); }
    }
};

template <class Epi, class Sched, bool ALIGN_EPI = false, bool SP2 = false>
__device__ __forceinline__ void gemm_phase(PG8_LAS unsigned char* lds, const Gemm g, const Sched& S, const Epi& E) {
    const int tid = threadIdx.x, wid = __builtin_amdgcn_readfirstlane(tid >> 6), lane = tid & 63, wr = wid >> 2, wc = wid & 3, fr = lane & 15, fq = lane >> 4;
    const int K = g.K, nt = K / BK;
    unsigned voffA[2], voffB[2];
#pragma unroll
    for (int i = 0; i < 2; ++i) { int R, C; stage_rc(tid * 16 + i * 8192, R, C); const int Rb = Epi::PERM ? ((R & ~31) + perm32(R & 31)) : R;
        voffA[i] = (unsigned)(R * g.lda + C) * 2u; voffB[i] = (unsigned)(Rb * K + C) * 2u; }
    const size_t kstep = (size_t)(BK * 2);
    const size_t hstepA = (size_t)HALF * g.lda * 2, hstepB = (size_t)HALF * K * 2;
    const size_t tstepA = 2 * hstepA, tstepB = 2 * hstepB;
    const unsigned ldsw = (unsigned)wid * 1024u;
    const int aoff = lds_byte(wr * 64 + fr, fq * 8), boff = lds_byte(wc * 32 + fr, fq * 8);
#define PG8_SA(b, h) (((b) * 2 + (h)) * HTB)
#define PG8_SB(b, h) ((4 + (b) * 2 + (h)) * HTB)
#define PG8_STAGE(bufoff, gbase, voff) do { _Pragma("unroll") for (int _i = 0; _i < 2; ++_i) \
        __builtin_amdgcn_global_load_lds((const unsigned*)((const char*)(gbase) + (voff)[_i]), (PG8_LAS unsigned*)(lds + (bufoff) + ldsw + _i * 8192), 16, 0, 0); } while (0)
#define PG8_LDA(dst, b, h) do { _Pragma("unroll") for (int m = 0; m < 4; ++m) _Pragma("unroll") for (int k = 0; k < 2; ++k) dst[m][k] = *(const PG8_LAS bf16x8*)(lds + PG8_SA(b, h) + aoff + m * 2048 + k * 1024); } while (0)
#define PG8_LDB(dst, b, h) do { _Pragma("unroll") for (int n = 0; n < 2; ++n) _Pragma("unroll") for (int k = 0; k < 2; ++k) dst[n][k] = *(const PG8_LAS bf16x8*)(lds + PG8_SB(b, h) + boff + n * 2048 + k * 1024); } while (0)
#define PG8_MMA(ai, bj, At, Bt) do { __builtin_amdgcn_s_setprio(1); _Pragma("unroll") for (int m = 0; m < 4; ++m) _Pragma("unroll") for (int n = 0; n < 2; ++n) _Pragma("unroll") for (int k = 0; k < 2; ++k) \
        acc[ai][bj][m][n] = __builtin_amdgcn_mfma_f32_16x16x32_bf16(Bt[n][k], At[m][k], acc[ai][bj][m][n], 0, 0, 0); __builtin_amdgcn_s_setprio(0); } while (0)
#define PG8_WAIT_V(n) asm volatile("s_waitcnt vmcnt(" #n ")" ::: "memory")
#define PG8_WAIT_L(n) asm volatile("s_waitcnt lgkmcnt(" #n ")" ::: "memory")
#define PG8_BAR __builtin_amdgcn_s_barrier()
#define PG8_SCHED __builtin_amdgcn_sched_barrier(0)
    Unit cur, nxt; int ui = 0;
    if (!S.next(0, cur)) return;
    f32x4 acc[2][2][4][2];
#pragma unroll
    for (int a = 0; a < 2; ++a)
#pragma unroll
        for (int b = 0; b < 2; ++b)
#pragma unroll
            for (int m = 0; m < 4; ++m)
#pragma unroll
                for (int n = 0; n < 2; ++n) acc[a][b][m][n] = (f32x4){0.f, 0.f, 0.f, 0.f};
    bf16x8 At[4][2], B0[2][2], B1[2][2];
    const char* cA = (const char*)(cur.pn < g.nsplit ? g.A : g.A2) + (size_t)cur.pm * tstepA; const char* cB = (const char*)g.Bt + (size_t)cur.pn * tstepB;
    S.a_ready(cur);
    if constexpr (SP2) {
        PG8_STAGE(PG8_SB(0, 0), cB, voffB); PG8_STAGE(PG8_SB(0, 1), cB + hstepB, voffB); PG8_STAGE(PG8_SA(0, 0), cA, voffA); PG8_STAGE(PG8_SA(0, 1), cA + hstepA, voffA);
        if (wr == 1) PG8_BAR;
        PG8_WAIT_V(2); PG8_BAR;
        PG8_STAGE(PG8_SB(1, 0), cB + kstep, voffB); PG8_STAGE(PG8_SA(1, 0), cA + kstep, voffA); PG8_STAGE(PG8_SB(1, 1), cB + hstepB + kstep, voffB);
        PG8_WAIT_V(6); PG8_BAR;
    } else {
        PG8_STAGE(PG8_SB(0, 0), cB, voffB); PG8_STAGE(PG8_SA(0, 0), cA, voffA); PG8_STAGE(PG8_SB(0, 1), cB + hstepB, voffB); PG8_STAGE(PG8_SA(0, 1), cA + hstepA, voffA);
        if (wr == 1) PG8_BAR;
        PG8_WAIT_V(4); PG8_BAR;
        PG8_STAGE(PG8_SB(1, 0), cB + kstep, voffB); PG8_STAGE(PG8_SA(1, 0), cA + kstep, voffA); PG8_STAGE(PG8_SB(1, 1), cB + hstepB + kstep, voffB);
        PG8_WAIT_V(6); PG8_BAR;
    }
    for (;;) {
        const bool has_next = S.next(ui + 1, nxt);
        const char* nA = has_next ? (const char*)(nxt.pn < g.nsplit ? g.A : g.A2) + (size_t)nxt.pm * tstepA : cA; const char* nB = has_next ? (const char*)g.Bt + (size_t)nxt.pn * tstepB : cB;
#pragma nounroll
        for (int t = 0; t < nt; t += 2) {
            const bool last = (t == nt - 2);
            const char* a1 = cA + (size_t)(t + 1) * kstep;
            const char* a2 = last ? nA : cA + (size_t)(t + 2) * kstep; const char* b2 = last ? nB : cB + (size_t)(t + 2) * kstep;
            const char* a3 = a2 + kstep; const char* b3 = b2 + kstep;
            if (last && has_next) S.a_ready(nxt);
            if constexpr (SP2) {
            PG8_LDB(B0, 0, 0); PG8_LDB(B1, 0, 1); PG8_SCHED; PG8_LDA(At, 0, 0); PG8_STAGE(PG8_SA(1, 1), a1 + hstepA, voffA);
            PG8_WAIT_V(8); PG8_WAIT_L(0); PG8_BAR; PG8_MMA(0, 0, At, B0); PG8_MMA(0, 1, At, B1); PG8_BAR; PG8_SCHED;
            PG8_LDA(At, 0, 1); PG8_STAGE(PG8_SB(0, 0), b2, voffB); PG8_STAGE(PG8_SB(0, 1), b2 + hstepB, voffB); PG8_STAGE(PG8_SA(0, 0), a2, voffA);
            PG8_WAIT_V(8); PG8_WAIT_L(0); PG8_BAR; PG8_MMA(1, 0, At, B0); PG8_MMA(1, 1, At, B1); PG8_BAR; PG8_SCHED;
            PG8_LDB(B0, 1, 0); PG8_LDB(B1, 1, 1); PG8_SCHED; PG8_LDA(At, 1, 0); PG8_STAGE(PG8_SA(0, 1), a2 + hstepA, voffA);
            PG8_WAIT_V(8); PG8_WAIT_L(0); PG8_BAR; PG8_MMA(0, 0, At, B0); PG8_MMA(0, 1, At, B1); PG8_BAR; PG8_SCHED;
            PG8_LDA(At, 1, 1); PG8_STAGE(PG8_SB(1, 0), b3, voffB); PG8_STAGE(PG8_SB(1, 1), b3 + hstepB, voffB); PG8_STAGE(PG8_SA(1, 0), a3, voffA);
            PG8_WAIT_V(8); PG8_WAIT_L(0); PG8_BAR; PG8_MMA(1, 0, At, B0); PG8_MMA(1, 1, At, B1); PG8_BAR; PG8_SCHED;
            } else {
            PG8_LDB(B0, 0, 0); PG8_SCHED; PG8_LDA(At, 0, 0); PG8_STAGE(PG8_SA(1, 1), a1 + hstepA, voffA);
            PG8_WAIT_L(8); PG8_BAR; PG8_WAIT_L(0); PG8_MMA(0, 0, At, B0); PG8_BAR; PG8_SCHED;
            PG8_LDB(B1, 0, 1); PG8_STAGE(PG8_SB(0, 0), b2, voffB);
            PG8_BAR; PG8_WAIT_L(0); PG8_MMA(0, 1, At, B1); PG8_BAR;
            PG8_LDA(At, 0, 1); PG8_STAGE(PG8_SA(0, 0), a2, voffA);
            PG8_BAR; PG8_WAIT_L(0); PG8_MMA(1, 0, At, B0); PG8_BAR; PG8_SCHED;
            PG8_STAGE(PG8_SB(0, 1), b2 + hstepB, voffB);
            PG8_WAIT_V(6); PG8_BAR; PG8_MMA(1, 1, At, B1); PG8_BAR;
            PG8_LDB(B0, 1, 0); PG8_SCHED; PG8_LDA(At, 1, 0); PG8_STAGE(PG8_SA(0, 1), a2 + hstepA, voffA);
            PG8_WAIT_L(8); PG8_BAR; PG8_WAIT_L(0); PG8_MMA(0, 0, At, B0); PG8_BAR; PG8_SCHED;
            PG8_LDB(B1, 1, 1); PG8_STAGE(PG8_SB(1, 0), b3, voffB);
            PG8_BAR; PG8_WAIT_L(0); PG8_MMA(0, 1, At, B1); PG8_BAR;
            PG8_LDA(At, 1, 1); PG8_STAGE(PG8_SA(1, 0), a3, voffA);
            PG8_BAR; PG8_WAIT_L(0); PG8_MMA(1, 0, At, B0); PG8_BAR; PG8_SCHED;
            PG8_STAGE(PG8_SB(1, 1), b3 + hstepB, voffB);
            PG8_WAIT_V(6); PG8_BAR; PG8_MMA(1, 1, At, B1); PG8_BAR;
            }
        }
        if constexpr (ALIGN_EPI) { if (wr == 0) PG8_BAR; }
        if constexpr (!Epi::AFTER_DRAIN) { E(acc, cur, wr, wc, fr, fq); S.done(cur); }
        if (!has_next) break;
#pragma unroll
        for (int a = 0; a < 2; ++a)
#pragma unroll
            for (int b = 0; b < 2; ++b)
#pragma unroll
                for (int m = 0; m < 4; ++m)
#pragma unroll
                    for (int n = 0; n < 2; ++n) acc[a][b][m][n] = (f32x4){0.f, 0.f, 0.f, 0.f};
        cur = nxt; cA = nA; cB = nB; ++ui;
        if constexpr (ALIGN_EPI) { if (wr == 1) PG8_BAR; }
    }
    PG8_WAIT_V(0);
    if constexpr (!ALIGN_EPI) { if (wr == 0) PG8_BAR; }
    PG8_BAR;
    if constexpr (Epi::AFTER_DRAIN) { E.fused(acc, cur, wr, wc, fr, fq, lds, wid, lane); S.done(cur); }
#undef PG8_SA
#undef PG8_SB
#undef PG8_STAGE
#undef PG8_LDA
#undef PG8_LDB
#undef PG8_MMA
#undef PG8_WAIT_V
#undef PG8_WAIT_L
#undef PG8_BAR
#undef PG8_SCHED
}
}

namespace att {
using bf16x8 = __attribute__((ext_vector_type(8))) short;
using s16x4  = __attribute__((ext_vector_type(4))) short;
using f32x16 = __attribute__((ext_vector_type(16))) float;
using f32x4  = __attribute__((ext_vector_type(4))) float;
using u32x4  = __attribute__((ext_vector_type(4))) unsigned;
typedef unsigned short bf16_t;
typedef __attribute__((address_space(3))) char LCH;
typedef __attribute__((address_space(3))) float LFL;
constexpr int NW = 8, QBLK = 32, KVBLK = 64, DQK = 96, DV = 64, SEQ = 2048, MROWS = 49152;
constexpr float SCALE = 0.10206207261596577f;
constexpr float THR = 8.f;
constexpr int KROW = 208;
constexpr int SHM_V = KVBLK * DV * 2, SHM_K = KVBLK * KROW, NSTG = 4, SHM_ATTN = NSTG * SHM_V + NSTG * SHM_K + NW * 64 * 4;
#define SBAR() __builtin_amdgcn_sched_barrier(0)
__device__ __forceinline__ int crow(int r, int hi) { return (r & 3) + 8 * (r >> 2) + 4 * hi; }
__device__ __forceinline__ unsigned cvtpk(float lo, float hi) { unsigned r; asm volatile("v_cvt_pk_bf16_f32 %0, %1, %2" : "=v"(r) : "v"(lo), "v"(hi)); return r; }
__device__ __forceinline__ float bflo(unsigned w) { return __uint_as_float(w << 16); }
__device__ __forceinline__ float bfhi(unsigned w) { return __uint_as_float(w & 0xffff0000u); }

constexpr float THRL = 8.f;
__device__ __forceinline__ void partialSM(f32x16& p0, f32x16& p1, float& mhat, float& alpha, f32x16* o, LFL* al_l, int r32, int hi) {
  float pmax;
  {
#define MX3(a, b, c) __builtin_fmaxf(__builtin_fmaxf((a), (b)), (c))
    const float a0 = MX3(p0[0], p0[1], p0[2]), a1 = MX3(p0[3], p0[4], p0[5]), a2 = MX3(p0[6], p0[7], p0[8]), a3 = MX3(p0[9], p0[10], p0[11]), a4 = MX3(p0[12], p0[13], p0[14]);
    const float a5 = MX3(p1[0], p1[1], p1[2]), a6 = MX3(p1[3], p1[4], p1[5]), a7 = MX3(p1[6], p1[7], p1[8]), a8 = MX3(p1[9], p1[10], p1[11]), a9 = MX3(p1[12], p1[13], p1[14]);
    const float b0 = MX3(a0, a1, a2), b1 = MX3(a3, a4, a5), b2 = MX3(a6, a7, a8), b3 = MX3(a9, p0[15], p1[15]);
    pmax = __builtin_fmaxf(__builtin_fmaxf(b0, b1), __builtin_fmaxf(b2, b3));
#undef MX3
  }
  { auto rr = __builtin_amdgcn_permlane32_swap(__float_as_uint(pmax), __float_as_uint(pmax), false, false);
    pmax = fmaxf(__uint_as_float(rr[0]), __uint_as_float(rr[1])); }
  f32x16 e0;
#pragma unroll
  for (int r = 0; r < 16; ++r) e0[r] = __builtin_amdgcn_exp2f(p0[r]);
  alpha = 1.f;
  if (__builtin_expect(__any(pmax > THRL), 0)) {
    const float dl = fmaxf(pmax, 0.f); mhat += dl;
#pragma unroll
    for (int r = 0; r < 16; ++r) { p1[r] -= dl; e0[r] = __builtin_amdgcn_exp2f(p0[r] - dl); }
    alpha = __builtin_amdgcn_exp2f(-dl);
    if (hi == 0) al_l[r32] = alpha; asm volatile("s_waitcnt lgkmcnt(0)" ::: "memory");
#pragma unroll
    for (int d = 0; d < 2; ++d)
#pragma unroll
      for (int r = 0; r < 16; ++r) o[d][r] *= al_l[crow(r, hi)];
  }
  p0 = e0;
}
__device__ __forceinline__ void finishSM(f32x16& p0, f32x16& p1, float alpha, float& l_reg, bf16x8& pa0, bf16x8& pa1, bf16x8& pa2, bf16x8& pa3) {
#pragma unroll
  for (int r = 0; r < 16; ++r) p1[r] = __builtin_amdgcn_exp2f(p1[r]);
  float ps;
  { float s0 = p0[0] + p0[1], s1 = p0[2] + p0[3], s2 = p1[0] + p1[1], s3 = p1[2] + p1[3];
#pragma unroll
    for (int r = 4; r < 16; r += 4) { s0 += p0[r] + p0[r + 1]; s1 += p0[r + 2] + p0[r + 3]; s2 += p1[r] + p1[r + 1]; s3 += p1[r + 2] + p1[r + 3]; }
    ps = (s0 + s1) + (s2 + s3); }
  l_reg = l_reg * alpha + ps;
#define PK4(P, BASE, OUT) do { u32x4 w = {cvtpk(P[BASE + 0], P[BASE + 1]), cvtpk(P[BASE + 2], P[BASE + 3]), cvtpk(P[BASE + 4], P[BASE + 5]), cvtpk(P[BASE + 6], P[BASE + 7])}; OUT = *reinterpret_cast<bf16x8*>(&w); } while (0)
  PK4(p0, 0, pa0); PK4(p0, 8, pa1); PK4(p1, 0, pa2); PK4(p1, 8, pa3);
#undef PK4
}
template <int VAR = 0> __device__ __forceinline__ void qkt(f32x16& p0, f32x16& p1, const LCH* Ks, const bf16x8* qr, float nm, int r32, int hi) {
#pragma unroll
  for (int r = 0; r < 16; ++r) { p0[r] = nm; p1[r] = nm; }
  if (VAR == 5) {
#pragma unroll
    for (int d0 = 0; d0 < 6; ++d0) { p0 = __builtin_amdgcn_mfma_f32_32x32x16_bf16(qr[5 - d0], qr[d0], p0, 0, 0, 0); p1 = __builtin_amdgcn_mfma_f32_32x32x16_bf16(qr[(d0 + 1) % 6], qr[d0], p1, 0, 0, 0); }
    return; }
#pragma unroll
  for (int d0 = 0; d0 < 6; ++d0) { const int cb = (d0 * 16 + hi * 8) * 2;
    const bf16x8 b0 = *(const __attribute__((address_space(3))) bf16x8*)(Ks + r32 * KROW + cb);
    const bf16x8 b1 = *(const __attribute__((address_space(3))) bf16x8*)(Ks + (32 + r32) * KROW + cb);
    p0 = __builtin_amdgcn_mfma_f32_32x32x16_bf16(b0, qr[d0], p0, 0, 0, 0);
    p1 = __builtin_amdgcn_mfma_f32_32x32x16_bf16(b1, qr[d0], p1, 0, 0, 0); }
}
__device__ __forceinline__ int v_st(int k, int c) { const int kk = k; return ((kk >> 3) * 2 + (c >> 5)) * 512 + ((kk & 7) * 32 + (c & 31)) * 2; }
__device__ __forceinline__ int v_rd_base(int lane) { return ((lane & 3) << 3) | (((lane >> 2) & 3) << 6) | (((lane >> 4) & 1) << 5) | (((lane >> 5) & 1) << 8); }
constexpr int v_rd_off(int d0, int ks, int half) { return d0 * 512 + ks * 2048 + half * 1024; }
typedef short v4i16_t __attribute__((ext_vector_type(4)));
__device__ __forceinline__ s16x4 vtr(const LCH* p) { return __builtin_bit_cast(s16x4, __builtin_amdgcn_ds_read_tr16_b64_v4i16((__attribute__((address_space(3))) v4i16_t*)p)); }
template <int VAR = 0> __device__ __forceinline__ void pv_d0(f32x16* o, const LCH* vb, bf16x8 pa0, bf16x8 pa1, bf16x8 pa2, bf16x8 pa3) {
  if (VAR == 5) { o[0] = __builtin_amdgcn_mfma_f32_32x32x16_bf16(pa0, pa1, o[0], 0, 0, 0); o[1] = __builtin_amdgcn_mfma_f32_32x32x16_bf16(pa0, pa2, o[1], 0, 0, 0); o[0] = __builtin_amdgcn_mfma_f32_32x32x16_bf16(pa1, pa3, o[0], 0, 0, 0); o[1] = __builtin_amdgcn_mfma_f32_32x32x16_bf16(pa1, pa0, o[1], 0, 0, 0);
    o[0] = __builtin_amdgcn_mfma_f32_32x32x16_bf16(pa2, pa1, o[0], 0, 0, 0); o[1] = __builtin_amdgcn_mfma_f32_32x32x16_bf16(pa2, pa3, o[1], 0, 0, 0); o[0] = __builtin_amdgcn_mfma_f32_32x32x16_bf16(pa3, pa0, o[0], 0, 0, 0); o[1] = __builtin_amdgcn_mfma_f32_32x32x16_bf16(pa3, pa2, o[1], 0, 0, 0); return; }
#define PK(L, H) (bf16x8){L[0], L[1], L[2], L[3], H[0], H[1], H[2], H[3]}
#define PVSTEP(ks, pa) do { const s16x4 l0 = vtr(vb + v_rd_off(0, ks, 0)), h0 = vtr(vb + v_rd_off(0, ks, 1)), l1 = vtr(vb + v_rd_off(1, ks, 0)), h1 = vtr(vb + v_rd_off(1, ks, 1)); \
    o[0] = __builtin_amdgcn_mfma_f32_32x32x16_bf16(pa, PK(l0, h0), o[0], 0, 0, 0); o[1] = __builtin_amdgcn_mfma_f32_32x32x16_bf16(pa, PK(l1, h1), o[1], 0, 0, 0); } while (0)
  PVSTEP(0, pa0); PVSTEP(1, pa1); PVSTEP(2, pa2); PVSTEP(3, pa3);
#undef PVSTEP
#undef PK
}
struct AttnArgs { const bf16_t* Q; const bf16_t* K; const bf16_t* V; const float* ss_q; const float* hss; const float* qn_g; const float* tab; bf16_t* Y; };
template <int VAR> __device__ __forceinline__ void attn_phase(const AttnArgs& A, int vcu, int G, LCH* lds, int flags) {
  const int tid = threadIdx.x, wid = tid >> 6, lane = tid & 63, r32 = lane & 31, hi = lane >> 5;
  LCH* V_lds = lds; LCH* K_lds = lds + NSTG * SHM_V;
  LFL* ws = (LFL*)(lds + NSTG * SHM_V + NSTG * SHM_K) + wid * 64; LFL* li_l = ws; LFL* al_l = ws + 32;
  const int kc0 = tid, kc1 = tid < 256 ? tid + 512 : tid; const bool k2 = tid < 256;
  const int kr0 = kc0 / 12, kch0 = kc0 - 12 * kr0, kr1 = kc1 / 12, kch1 = kc1 - 12 * kr1;
  const int kg0 = kr0 * DQK + kch0 * 8, kg1 = kr1 * DQK + kch1 * 8, kl0 = kr0 * KROW + kch0 * 16, kl1 = kr1 * KROW + kch1 * 16;
  const int vk = tid >> 3, vc = (tid & 7) * 8, vg = vk * DV + vc, vl = v_st(vk, vc);
  const LCH* vb0 = V_lds + v_rd_base(lane);
  struct { bf16x8 v, k0, k1; } sr_;
  const bf16_t* Kh; const bf16_t* Vh;
#define SLOAD(key0) do { sr_.v = *reinterpret_cast<const bf16x8*>(Vh + (size_t)(key0) * DV + vg); sr_.k0 = *reinterpret_cast<const bf16x8*>(Kh + (size_t)(key0) * DQK + kg0); \
    sr_.k1 = *reinterpret_cast<const bf16x8*>(Kh + (size_t)(key0) * DQK + kg1); } while (0)
#define SWRITE(st) do { *(__attribute__((address_space(3))) bf16x8*)(V_lds + (st) * SHM_V + vl) = sr_.v; *(__attribute__((address_space(3))) bf16x8*)(K_lds + (st) * SHM_K + kl0) = sr_.k0; if (k2) *(__attribute__((address_space(3))) bf16x8*)(K_lds + (st) * SHM_K + kl1) = sr_.k1; } while (0)
  float ssq_, hss_;
#define PREFETCH(uu) do { const int bh_ = (uu) >> 3, b_ = bh_ >> 3, h_ = bh_ & 7, t_ = ((uu) & 7) * 256 + wid * QBLK + r32; const size_t mrow_ = (size_t)b_ * SEQ + t_; \
    ssq_ = A.ss_q[mrow_]; hss_ = A.hss[(size_t)h_ * MROWS + mrow_]; \
    Kh = A.K + (size_t)bh_ * SEQ * DQK; Vh = A.V + (size_t)bh_ * SEQ * DV; SLOAD(0); } while (0)
#define RESC(a) do { if (__any((a) < 1.f)) { if (hi == 0) al_l[r32] = (a); asm volatile("s_waitcnt lgkmcnt(0)" ::: "memory"); \
    _Pragma("unroll") for (int d = 0; d < 2; ++d) _Pragma("unroll") for (int r = 0; r < 16; ++r) o[d][r] *= al_l[crow(r, hi)]; } } while (0)
  int u = vcu; if (u >= 1536) return;
  PREFETCH(u);
  for (;;) {
  const int bh = u >> 3, b = bh >> 3, h = bh & 7, q0 = (u & 7) * 256;
  u32x4 qw[6]; { const bf16_t* Qw_ = A.Q + ((size_t)bh * SEQ + q0 + wid * QBLK + r32) * DQK + hi * 8;
#pragma unroll
    for (int d0 = 0; d0 < 6; ++d0) qw[d0] = *reinterpret_cast<const u32x4*>(Qw_ + d0 * 16); }
  float mhat = 0.f, l_reg = 0; f32x16 o[2] = {}; bf16x8 qr[6];
  {
    const float rq = 1.0f / sqrtf(ssq_ * (1.0f / 384.0f) + 1e-6f);
    const float sq = (SCALE * 1.4426950408889634f) * rq / sqrtf(hss_ * rq * rq * (1.0f / 96.0f) + 1e-6f);
#pragma unroll
    for (int d0 = 0; d0 < 4; ++d0) {
      const u32x4 w = qw[d0];
      const f32x4 g0 = *reinterpret_cast<const f32x4*>(A.qn_g + d0 * 16 + hi * 8), g1 = *reinterpret_cast<const f32x4*>(A.qn_g + d0 * 16 + hi * 8 + 4);
      u32x4 o4; o4.x = cvtpk(bflo(w.x) * g0[0] * sq, bfhi(w.x) * g0[1] * sq); o4.y = cvtpk(bflo(w.y) * g0[2] * sq, bfhi(w.y) * g0[3] * sq);
      o4.z = cvtpk(bflo(w.z) * g1[0] * sq, bfhi(w.z) * g1[1] * sq); o4.w = cvtpk(bflo(w.w) * g1[2] * sq, bfhi(w.w) * g1[3] * sq);
      qr[d0] = *reinterpret_cast<bf16x8*>(&o4);
    }
#pragma unroll
    for (int d0 = 4; d0 < 6; ++d0) {
      const u32x4 w = qw[d0];
      const int i0 = 8 * (d0 - 4) + 4 * hi;
      const f32x4 g1 = *reinterpret_cast<const f32x4*>(A.qn_g + 64 + i0), g2 = *reinterpret_cast<const f32x4*>(A.qn_g + 80 + i0);
      const float* tb = A.tab + ((size_t)(q0 + wid * QBLK + r32) * 16 + i0) * 2; const f32x4 cs0 = *reinterpret_cast<const f32x4*>(tb), cs1 = *reinterpret_cast<const f32x4*>(tb + 4);
      const unsigned ww[4] = {w.x, w.y, w.z, w.w}; const float cc[4] = {cs0[0], cs0[2], cs1[0], cs1[2]}, sn[4] = {cs0[1], cs0[3], cs1[1], cs1[3]};
      unsigned ow[4];
#pragma unroll
      for (int jj = 0; jj < 4; ++jj) { const float a = bflo(ww[jj]) * g1[jj] * sq, bb = bfhi(ww[jj]) * g2[jj] * sq; ow[jj] = cvtpk(a * cc[jj] - bb * sn[jj], a * sn[jj] + bb * cc[jj]); }
      u32x4 o4 = {ow[0], ow[1], ow[2], ow[3]}; qr[d0] = *reinterpret_cast<bf16x8*>(&o4);
    }
  }
  f32x16 pA0, pA1, pB0, pB1; float alA, alB; bf16x8 pa0, pa1, pa2, pa3; const int NT = (flags & 16) ? SEQ / KVBLK / 2 : SEQ / KVBLK;
  SWRITE(0); SLOAD(KVBLK); __syncthreads();
  qkt(pA0, pA1, K_lds, qr, -mhat, r32, hi); partialSM(pA0, pA1, mhat, alA, o, al_l, r32, hi);
  SWRITE(1); SLOAD(2 * KVBLK); __syncthreads();
#define XPART(PC0, PC1, PP0, PP1, alP_, j_) do { \
    if (VAR != 4) { if ((j_) + 1 < NT) SWRITE(((j_) + 1) & 3); if ((j_) + 2 < NT) SLOAD(((j_) + 2) * KVBLK); } SBAR(); \
    if (VAR == 7 && wid >= 4) { asm volatile("" : "+v"(PC0), "+v"(PC1)); } else if (VAR != 3) qkt<VAR>(PC0, PC1, K_lds + ((j_) & 3) * SHM_K, qr, -mhat, r32, hi); else { asm volatile("" : "+v"(PC0), "+v"(PC1)); } \
    if (VAR == 7 && wid >= 4) { asm volatile("" : "+v"(pa0), "+v"(pa1), "+v"(pa2), "+v"(pa3)); } else if (VAR != 1) finishSM(PP0, PP1, alP_, l_reg, pa0, pa1, pa2, pa3); else { asm volatile("" : "+v"(PP0), "+v"(PP1)); asm volatile("" : "+v"(pa0), "+v"(pa1), "+v"(pa2), "+v"(pa3)); } SBAR(); } while (0)
#define YPART(PC0, PC1, alC_, j_) do { \
    if (VAR == 7 && wid >= 4) { asm volatile("" : "+v"(o[0]), "+v"(o[1])); } else if (VAR != 2) pv_d0<VAR>(o, vb0 + (((j_) - 1) & 3) * SHM_V, pa0, pa1, pa2, pa3); else { asm volatile("" : "+v"(o[0]), "+v"(o[1])); } \
    if (VAR == 7 && wid >= 4) { alC_ = 1.f; } else if (VAR != 1) { partialSM(PC0, PC1, mhat, alC_, o, al_l, r32, hi); } else { asm volatile("" : "+v"(PC0), "+v"(PC1)); alC_ = 1.f; } } while (0)
#define LOOPBAR() do { if (VAR != 6) __syncthreads(); } while (0)
  if (wid < 4) {
    for (int j = 1; j + 1 < NT; j += 2) {
      XPART(pB0, pB1, pA0, pA1, alA, j); YPART(pB0, pB1, alB, j); LOOPBAR();
      XPART(pA0, pA1, pB0, pB1, alB, j + 1); YPART(pA0, pA1, alA, j + 1); LOOPBAR();
    }
    XPART(pB0, pB1, pA0, pA1, alA, NT - 1); YPART(pB0, pB1, alB, NT - 1); LOOPBAR();
  } else {
    for (int j = 1; j + 1 < NT; j += 2) {
      XPART(pB0, pB1, pA0, pA1, alA, j); LOOPBAR(); YPART(pB0, pB1, alB, j);
      XPART(pA0, pA1, pB0, pB1, alB, j + 1); LOOPBAR(); YPART(pA0, pA1, alA, j + 1);
    }
    XPART(pB0, pB1, pA0, pA1, alA, NT - 1); LOOPBAR(); YPART(pB0, pB1, alB, NT - 1);
  }
#undef LOOPBAR
#undef XPART
#undef YPART
  finishSM(pB0, pB1, alB, l_reg, pa0, pa1, pa2, pa3); SBAR();
  pv_d0(o, vb0 + ((NT - 1) & 3) * SHM_V, pa0, pa1, pa2, pa3);
  const int un = u + G; bf16_t* Yw = A.Y + ((size_t)b * SEQ + q0 + wid * QBLK) * 1024 + 512 + h * DV;
  if (un < 1536) PREFETCH(un);
  { auto rr = __builtin_amdgcn_permlane32_swap(__float_as_uint(l_reg), __float_as_uint(l_reg), false, false); l_reg = __uint_as_float(rr[0]) + __uint_as_float(rr[1]); }
  if (hi == 0) li_l[r32] = l_reg; asm volatile("s_waitcnt lgkmcnt(0)" ::: "memory");
  float rli[16];
#pragma unroll
  for (int r = 0; r < 16; ++r) rli[r] = __builtin_amdgcn_rcpf(li_l[crow(r, hi)]);
#pragma unroll
  for (int r = 0; r < 16; ++r) { const int orow = crow(r, hi);
#pragma unroll
    for (int d0 = 0; d0 < 2; ++d0) { const unsigned pk = cvtpk(o[d0][r] * rli[r], 0.f); Yw[(size_t)orow * 1024 + d0 * 32 + r32] = (bf16_t)(pk & 0xffffu); } }
  __syncthreads();
  if (un >= 1536) break;
  u = un;
  }
#undef SLOAD
#undef SWRITE
#undef PREFETCH
#undef RESC
}
#undef SBAR
}

constexpr int NWAVES = 8;
constexpr int M = 49152, DM = 1024, SEQL = 2048, MPR = 32768, NPH = 9;
constexpr size_t MiB = 1u << 20;
constexpr size_t WS_CTL = 0, CTL_ZERO_BYTES = 1 * MiB;
constexpr size_t WS_TAB = 1 * MiB;
constexpr size_t WS_SSZ = 2 * MiB, SSZ_BYTES = 13 * (size_t)M * 4;
constexpr size_t WS_SS1 = 5 * MiB;
constexpr size_t WS_KRR = 6 * MiB;
constexpr size_t WS_WIN = 12 * MiB, WS_WQB = WS_WIN + 1280 * 1024 * 2, WS_WKVB = WS_WQB + 768 * 384 * 2, WS_WO = 16 * MiB, WS_WGU = 18 * MiB, WS_WD = 29 * MiB, WS_WPG = 35 * MiB, WS_WPP = 37 * MiB;
constexpr size_t WS_PB = 40 * MiB;
constexpr size_t WS_Z = 64 * MiB;
constexpr size_t WS_XB = 184 * MiB;
constexpr size_t WS_Q = 184 * MiB, WS_K = 256 * MiB, WS_V = 328 * MiB, WS_Y = 376 * MiB;
constexpr size_t WS_HB = 64 * MiB;
constexpr size_t WS_ACT = 184 * MiB;
constexpr size_t WS_PROJ = 184 * MiB;
constexpr size_t WS_END = 472 * MiB;
static_assert(WS_WKVB + 1024 * 256 * 2 <= WS_WO && WS_WGU + (size_t)5632 * 1024 * 2 <= WS_WD && WS_WD + (size_t)1024 * 2816 * 2 <= WS_WPG && WS_WPP + 1024 * 256 * 2 <= WS_PB, "weight map");
static_assert(WS_SSZ + SSZ_BYTES <= WS_SS1 && WS_SS1 + 2 * (size_t)M * 4 <= WS_KRR && WS_KRR + (size_t)M * 32 * 4 <= WS_WIN, "small arrays map");
constexpr int CW_TMO = 0, CW_BAR = 4096;
constexpr int RING_OFF = 0, RING_BYTES = 131072, LDSCTL_OFF = RING_BYTES, MISC_OFF = LDSCTL_OFF + 320, LDS_BYTES = 147456;

#define GAS __attribute__((address_space(1)))
#define LAS __attribute__((address_space(3)))
typedef unsigned short bf16;
typedef unsigned v4u __attribute__((ext_vector_type(4)));
typedef float f32x4 __attribute__((ext_vector_type(4)));
typedef GAS unsigned gu32;
#define RLX_AGENT __ATOMIC_RELAXED, __HIP_MEMORY_SCOPE_AGENT
#define LDS_WAIT() asm volatile("s_waitcnt lgkmcnt(0)" ::: "memory")
#define VM_WAIT() asm volatile("s_waitcnt vmcnt(0)" ::: "memory")
__device__ __forceinline__ unsigned f2bf(float f) { unsigned u = __builtin_bit_cast(unsigned, f); return (u + 0x7fffu + ((u >> 16) & 1u)) >> 16; }
__device__ __forceinline__ unsigned pk2(float lo, float hi) { return f2bf(lo) | (f2bf(hi) << 16); }

#define XB_TMO      128
#define XB_XCNT(j)  (256  + 64 * (j))
#define XB_XSUB(j)  (1280 + 64 * (j))
#define XB_XGEN(j)  (2304 + 64 * (j))
#define XB_TOP      3328
#define XB_TOPGEN   3392
#define XCD_BAR_WORDS 3456
#define XB_SPIN_CAP (1u << 18)

__device__ __forceinline__ unsigned xb_ld(unsigned* p)              { return __hip_atomic_load(p, __ATOMIC_RELAXED, __HIP_MEMORY_SCOPE_AGENT); }
__device__ __forceinline__ unsigned xb_add(unsigned* p, unsigned v) { return __hip_atomic_fetch_add(p, v, __ATOMIC_RELAXED, __HIP_MEMORY_SCOPE_AGENT); }
__device__ __forceinline__ unsigned xb_xcc_id() { return (unsigned)__builtin_amdgcn_s_getreg((3 << 11) | 20) & 0xFu; }
#define XB_SPIN(cond, bar) do { unsigned _sp = 0; while (cond) { __builtin_amdgcn_s_sleep(1); \
    if ((++_sp & 255u) == 0u) { if (xb_ld(&(bar)[XB_TMO])) break; if (_sp > XB_SPIN_CAP) { atomicAdd(&(bar)[XB_TMO], 1u); break; } } } } while (0)

struct XcdBarrier {
    unsigned* bar; unsigned x;
    volatile LAS unsigned* st;
};

__device__ __forceinline__ XcdBarrier xcd_barrier_post(unsigned* bar, volatile LAS unsigned* st) {
    XcdBarrier b; b.bar = bar; b.x = xb_xcc_id(); b.st = st;
    if (threadIdx.x == 0) (void)xb_add(&bar[XB_XCNT(b.x)], 1u);
    return b;
}
__device__ __forceinline__ void xcd_barrier_complete(unsigned* bar, unsigned x, unsigned& nloc, unsigned& nx) {
    const unsigned G = gridDim.x * gridDim.y * gridDim.z;
    unsigned sum, cnt, mine, sp = 0u;
    for (;;) {
        sum = 0u; cnt = 0u; mine = 0u;
#pragma unroll
        for (unsigned j = 0; j < 16; ++j) { const unsigned c = xb_ld(&bar[XB_XCNT(j)]); sum += c; cnt += (c > 0u) ? 1u : 0u; mine = (j == x) ? c : mine; }
        if (sum == G) break;
        __builtin_amdgcn_s_sleep(1);
        if ((++sp & 255u) == 0u) { if (xb_ld(&bar[XB_TMO])) break; if (sp > XB_SPIN_CAP) { atomicAdd(&bar[XB_TMO], 1u); break; } }
    }
    nloc = mine > 0u ? mine : 1u; nx = cnt > 0u ? cnt : 1u;
}

__device__ __forceinline__ void xcd_barrier(const XcdBarrier& b) {
    asm volatile("s_waitcnt vmcnt(0)" ::: "memory");
    __syncthreads();
    if (threadIdx.x == 0) {
        unsigned* bar = b.bar;
        __builtin_amdgcn_s_waitcnt(0);
        unsigned nloc = b.st[0], nx = b.st[1];
        if (nloc == 0u) { xcd_barrier_complete(bar, b.x, nloc, nx); b.st[0] = nloc; b.st[1] = nx; }
        const unsigned old = xb_add(&bar[XB_XSUB(b.x)], 1u);
        const unsigned gen = old / nloc;
        if (old + 1u == (gen + 1u) * nloc) {
            __builtin_amdgcn_fence(__ATOMIC_RELEASE, "agent");
            asm volatile("s_waitcnt vmcnt(0)" ::: "memory");
            const unsigned og = xb_add(&bar[XB_TOP], 1u);
            const unsigned tg = og / nx;
            if (og + 1u == (tg + 1u) * nx) xb_add(&bar[XB_TOPGEN], 1u);
            else XB_SPIN(xb_ld(&bar[XB_TOPGEN]) == tg, bar);
            __builtin_amdgcn_fence(__ATOMIC_ACQUIRE, "agent");
            xb_add(&bar[XB_XGEN(b.x)], 1u);
            asm volatile("s_waitcnt vmcnt(0)" ::: "memory");
        } else {
            XB_SPIN(xb_ld(&bar[XB_XGEN(b.x)]) == gen, bar);
            __builtin_amdgcn_fence(__ATOMIC_ACQUIRE, "agent");
            asm volatile("s_waitcnt vmcnt(0)" ::: "memory");
        }
    }
    __syncthreads();
}


struct Frame {
    LAS unsigned char* lds; volatile LAS unsigned* MISC; gu32* ctl;
    int tid, lane, wave, vcu, G;
};
struct Args { const float* in[22]; float* out; unsigned char* ws; int ph_lo, ph_hi, p0mask, pad; };

__device__ __forceinline__ float wave_sum(float v) {
#pragma unroll
    for (int o = 1; o < 64; o <<= 1) v += __shfl_xor(v, o);
    return v;
}
enum { MAP_ID = 0, MAP_IN = 1, MAP_QB = 2, MAP_KVB = 3, MAP_GU = 4 };
__device__ __forceinline__ int map_col(int map, int n) {
    if (map == MAP_IN) { if (n < 896) return n; if (n < 928) { const int i = n - 896, pr = i >> 1; return 1152 + ((i & 1) ? 16 + pr : pr); } if (n < 1024) return -1; return 896 + (n - 1024); }
    if (map == MAP_QB) { const int slab = n >> 5, c = n & 31, head = slab / 3, part = slab - 3 * head; const int lg = part < 2 ? part * 32 + c : 64 + ((c & 1) ? 16 + (c >> 1) : (c >> 1)); return head * 96 + lg; }
    if (map == MAP_KVB) { const int t = n >> 8, r = n & 255, bj = r >> 7, wc = (r >> 5) & 3, c = r & 31; return (2 * t + (wc & 1)) * 128 + (wc >> 1) * 64 + bj * 32 + c; }
    if (map == MAP_GU) { const int pn = n >> 8, r = n & 255; return ((r >> 7) ? 2816 : 0) + pn * 128 + (r & 127); }
    return n;
}
__device__ __forceinline__ void p0_transpose_item(const float* W, const float* W2, int ldw, const float* gain, bf16* WT, int ldt, int kdst0, int nblk, int map, LAS float* scr, int item, int lane) {
    const int kb = item / nblk, nb = item - kb * nblk, k0 = 64 * kb, n0 = 32 * nb;
    int col = map_col(map, n0 + (lane & 31)); const float* src = W; if (map == MAP_GU && col >= 2816) { col -= 2816; src = W2; }
    const float msk = col < 0 ? 0.f : 1.f; col = col < 0 ? 0 : col;
    const float* sp = src + (size_t)(k0 + (lane >> 5)) * ldw + col;
    float v[32];
#pragma unroll
    for (int i = 0; i < 32; ++i) v[i] = __builtin_nontemporal_load(sp + (size_t)(2 * i) * ldw);
    if (gain) {
        const float* gp = gain + k0 + (lane >> 5);
#pragma unroll
        for (int i = 0; i < 32; ++i) v[i] *= gp[2 * i];
    }
#pragma unroll
    for (int i = 0; i < 32; ++i) scr[(2 * i + (lane >> 5)) * 33 + (lane & 31)] = v[i] * msk;
    LDS_WAIT(); asm volatile("" ::: "memory");
    const int c = lane & 7;
#pragma unroll
    for (int j = 0; j < 4; ++j) { const int n = (lane >> 3) + 8 * j; const LAS float* s = scr + (8 * c) * 33 + n;
        v4u o; o.x = pk2(s[0 * 33], s[1 * 33]); o.y = pk2(s[2 * 33], s[3 * 33]); o.z = pk2(s[4 * 33], s[5 * 33]); o.w = pk2(s[6 * 33], s[7 * 33]);
        *(GAS v4u*)(WT + (size_t)(n0 + n) * ldt + kdst0 + k0 + 8 * c) = o; }
    LDS_WAIT(); asm volatile("" ::: "memory");
}
__device__ __forceinline__ void p0_prologue(Frame& F, const Args& a) {
    unsigned char* ws = a.ws;
    LAS float* scr = (LAS float*)(F.lds + RING_OFF + F.wave * 16384);
    constexpr int AW0 = 4, AW = NWAVES - AW0;
    const int pm_ = a.p0mask;
    if (F.wave >= AW0) {
    const int gw = F.vcu * AW + (F.wave - AW0), NGW = F.G * AW;
    const int gt = gw * 64 + F.lane, NGT = NGW * 64;
    if (pm_ & 1) { v4u* zp = (v4u*)(ws + WS_SSZ); const v4u zz = {0u, 0u, 0u, 0u}; for (int i = gt; i < (int)(SSZ_BYTES / 16); i += NGT) zp[i] = zz; }
    if (pm_ & 1) { float* tab = (float*)(ws + WS_TAB); for (int i = gt; i < SEQL * 16; i += NGT) { const int t = i >> 4, f = i & 15; const float ang = (float)t * powf(10000.0f, -(float)(2 * f) / 32.0f); tab[2 * i] = cosf(ang); tab[2 * i + 1] = sinf(ang); } }
    if (pm_ & 2) {
        const float *ln1 = a.in[4], *w_in = a.in[5], *qan = a.in[8], *w_qb = a.in[9], *kvan = a.in[10], *w_kvb = a.in[11], *w_o = a.in[14], *ln2 = a.in[15], *w_gate = a.in[16], *w_up = a.in[17], *w_down = a.in[18], *plen = a.in[19], *w_pg = a.in[20], *w_pp = a.in[21];
        constexpr int I_IN = (1024 / 64) * (1280 / 32), I_QB = (384 / 64) * (768 / 32), I_KVB = (256 / 64) * (1024 / 32), I_O = (512 / 64) * (1024 / 32), I_GU = (1024 / 64) * (5632 / 32), I_D = (2816 / 64) * (1024 / 32), I_PG = (1024 / 64) * (1024 / 32), I_PP = (256 / 64) * (1024 / 32);
        constexpr int NITEMS = I_IN + I_QB + I_KVB + I_O + I_GU + I_D + I_PG + I_PP;
        for (int it = gw; it < NITEMS; it += NGW) {
            int r = it;
            if (r < I_IN) { p0_transpose_item(w_in, nullptr, 1184, ln1, (bf16*)(ws + WS_WIN), 1024, 0, 1280 / 32, MAP_IN, scr, r, F.lane); continue; } r -= I_IN;
            if (r < I_QB) { p0_transpose_item(w_qb, nullptr, 768, qan, (bf16*)(ws + WS_WQB), 384, 0, 768 / 32, MAP_QB, scr, r, F.lane); continue; } r -= I_QB;
            if (r < I_KVB) { p0_transpose_item(w_kvb, nullptr, 1024, kvan, (bf16*)(ws + WS_WKVB), 256, 0, 1024 / 32, MAP_KVB, scr, r, F.lane); continue; } r -= I_KVB;
            if (r < I_O) { p0_transpose_item(w_o + (size_t)512 * 1024, nullptr, 1024, nullptr, (bf16*)(ws + WS_WO), 1024, 512, 1024 / 32, MAP_ID, scr, r, F.lane); continue; } r -= I_O;
            if (r < I_GU) { p0_transpose_item(w_gate, w_up, 2816, ln2, (bf16*)(ws + WS_WGU), 1024, 0, 5632 / 32, MAP_GU, scr, r, F.lane); continue; } r -= I_GU;
            if (r < I_D) { p0_transpose_item(w_down, nullptr, 1024, nullptr, (bf16*)(ws + WS_WD), 2816, 0, 1024 / 32, MAP_ID, scr, r, F.lane); continue; } r -= I_D;
            if (r < I_PG) { p0_transpose_item(w_pg, nullptr, 1024, plen, (bf16*)(ws + WS_WPG), 1024, 0, 1024 / 32, MAP_ID, scr, r, F.lane); continue; } r -= I_PG;
            p0_transpose_item(w_pp, nullptr, 1024, nullptr, (bf16*)(ws + WS_WPP), 256, 0, 1024 / 32, MAP_ID, scr, r, F.lane);
        }
    }
    if (pm_ & 4) {
        const float* w_pool = a.in[6]; const float* psc = a.in[7]; const float* w_o = a.in[14]; bf16* WO = (bf16*)(ws + WS_WO);
        for (int it = gw; it < 512; it += NGW) {
            const int kb = it >> 4, nb = it & 15, kk0 = kb * 16, g = kk0 >> 7, n = nb * 64 + F.lane;
            const float* wo = w_o + (size_t)(g * 128) * 1024 + n; const float* wp = w_pool + (size_t)kk0 * 128; const float* sc = psc + g * 128;
            { float t[32];
#pragma unroll
                for (int i = 0; i < 32; ++i) t[i] = wp[i * 64 + F.lane];
                const float s0 = sc[F.lane], s1 = sc[64 + F.lane];
#pragma unroll
                for (int i = 0; i < 32; ++i) scr[i * 64 + F.lane] = t[i] * ((i & 1) ? s1 : s0); }
            LDS_WAIT(); asm volatile("" ::: "memory");
            float acc[16];
#pragma unroll
            for (int e = 0; e < 16; ++e) acc[e] = 0.f;
#pragma unroll 1
            for (int j0 = 0; j0 < 128; j0 += 32) {
                float w[32];
#pragma unroll
                for (int j = 0; j < 32; ++j) w[j] = wo[(size_t)(j0 + j) * 1024];
#pragma unroll
                for (int j = 0; j < 32; j += 4)
#pragma unroll
                    for (int e = 0; e < 16; ++e) { const f32x4 av = *(const LAS f32x4*)(scr + e * 128 + j0 + j);
                        acc[e] = fmaf(av.x, w[j], acc[e]); acc[e] = fmaf(av.y, w[j + 1], acc[e]); acc[e] = fmaf(av.z, w[j + 2], acc[e]); acc[e] = fmaf(av.w, w[j + 3], acc[e]); }
            }
            v4u o0, o1; o0.x = pk2(acc[0], acc[1]); o0.y = pk2(acc[2], acc[3]); o0.z = pk2(acc[4], acc[5]); o0.w = pk2(acc[6], acc[7]); o1.x = pk2(acc[8], acc[9]); o1.y = pk2(acc[10], acc[11]); o1.z = pk2(acc[12], acc[13]); o1.w = pk2(acc[14], acc[15]);
            *(GAS v4u*)(WO + (size_t)n * 1024 + kk0) = o0; *(GAS v4u*)(WO + (size_t)n * 1024 + kk0 + 8) = o1;
            LDS_WAIT(); asm volatile("" ::: "memory");
        }
    }
    }
    if (pm_ & 8) {
        bf16* XB = (bf16*)a.out; bf16* PB = (bf16*)(ws + WS_PB); float* xinv = (float*)(ws + WS_SS1);
        volatile LAS int* ctr = (volatile LAS int*)(F.lds + LDSCTL_OFF + 64);
        const int ppb = (M / 2) / F.G, pbase = F.vcu * ppb, ptot = (F.vcu == F.G - 1) ? (M / 2) - pbase : ppb;
        for (;;) {
            int pr = 0; if (F.lane == 0) pr = __hip_atomic_fetch_add((LAS int*)ctr, 1, __ATOMIC_RELAXED, __HIP_MEMORY_SCOPE_WORKGROUP);
            pr = __builtin_amdgcn_readfirstlane(pr); if (pr >= ptot) break;
            const int m0 = 2 * (pbase + pr);
            f32x4 v[2][4], pv[2];
#pragma unroll
            for (int r = 0; r < 2; ++r) { const int m = m0 + r;
                const float* xrow = m < MPR ? a.in[0] + (size_t)m * DM : a.in[1] + (size_t)(m - MPR) * DM;
                const float* prow = m < MPR ? a.in[2] + (size_t)m * 256 : a.in[3] + (size_t)(m - MPR) * 256;
                const GAS f32x4* xr = (const GAS f32x4*)xrow + F.lane;
#pragma unroll
                for (int j = 0; j < 4; ++j) v[r][j] = __builtin_nontemporal_load(xr + 64 * j);
                pv[r] = __builtin_nontemporal_load((const GAS f32x4*)prow + F.lane); }
#pragma unroll
            for (int r = 0; r < 2; ++r) { const int m = m0 + r; float s = 0.f;
#pragma unroll
                for (int j = 0; j < 4; ++j) s += (v[r][j].x * v[r][j].x + v[r][j].y * v[r][j].y) + (v[r][j].z * v[r][j].z + v[r][j].w * v[r][j].w);
                s = wave_sum(s); const float rs = 1.0f / sqrtf(s * (1.0f / 1024.0f) + 1e-6f);
                if (F.lane == 0) xinv[m] = sqrtf(s * (1.0f / 1024.0f) + 1e-6f);
                GAS unsigned long long* o8 = (GAS unsigned long long*)(XB + (size_t)m * DM) + F.lane;
#pragma unroll
                for (int j = 0; j < 4; ++j) o8[64 * j] = (unsigned long long)pk2(v[r][j].x * rs, v[r][j].y * rs) | ((unsigned long long)pk2(v[r][j].z * rs, v[r][j].w * rs) << 32);
                ((GAS unsigned long long*)(PB + (size_t)m * 256))[F.lane] = (unsigned long long)pk2(pv[r].x, pv[r].y) | ((unsigned long long)pk2(pv[r].z, pv[r].w) << 32); }
        }
    }
}
template <int W, int R> __device__ __forceinline__ void pool_quad(const bf16* Z, bf16* Y, int row0, int c8) {
    const int t0 = row0 & (SEQL - 1), lo = t0 - W / 2; const bf16* zb = Z + (size_t)(row0 - t0) * 1280 + c8 * 8;
    v4u wv[W + R - 1];
#pragma unroll
    for (int i = 0; i < W + R - 1; ++i) { const int j = lo + i; const bool ok = j >= 0 && j < SEQL; wv[i] = *(const GAS v4u*)(zb + (size_t)(ok ? j : t0) * 1280); if (!ok) wv[i] = (v4u){0u, 0u, 0u, 0u}; }
#define PF(VV, e) (((e) & 1) ? __uint_as_float(((e) >> 1) == 0 ? (VV).x & 0xffff0000u : ((e) >> 1) == 1 ? (VV).y & 0xffff0000u : ((e) >> 1) == 2 ? (VV).z & 0xffff0000u : (VV).w & 0xffff0000u) \
                            : __uint_as_float(((e) >> 1) == 0 ? (VV).x << 16 : ((e) >> 1) == 1 ? (VV).y << 16 : ((e) >> 1) == 2 ? (VV).z << 16 : (VV).w << 16))
    float s[8];
#pragma unroll
    for (int e = 0; e < 8; ++e) { s[e] = 0.f;
#pragma unroll
        for (int i = 0; i < W; ++i) s[e] += PF(wv[i], e); }
#pragma unroll
    for (int r = 0; r < R; ++r) {
        if (r > 0) {
#pragma unroll
            for (int e = 0; e < 8; ++e) s[e] += PF(wv[W + r - 1], e) - PF(wv[r - 1], e); }
        const int t = t0 + r, a = t - W / 2, b = a + W; const float inv = 1.0f / (float)((b > SEQL ? SEQL : b) - (a < 0 ? 0 : a)); const v4u cv = wv[r + W / 2];
        v4u o; o.x = pk2(s[0] * inv - PF(cv, 0), s[1] * inv - PF(cv, 1)); o.y = pk2(s[2] * inv - PF(cv, 2), s[3] * inv - PF(cv, 3)); o.z = pk2(s[4] * inv - PF(cv, 4), s[5] * inv - PF(cv, 5)); o.w = pk2(s[6] * inv - PF(cv, 6), s[7] * inv - PF(cv, 7));
        *(GAS v4u*)(Y + (size_t)(row0 + r) * 1024 + c8 * 8) = o;
    }
#undef PF
}
__device__ __forceinline__ void pool_phase(Frame& F, const bf16* Z, bf16* Y) {
    const int gw = F.vcu * NWAVES + F.wave, NGW = F.G * NWAVES;
    constexpr int R = 8;
    for (int wi = gw; wi < M / R; wi += NGW) {
        const int g = (wi + (wi >> 11)) & 3, row0 = ((wi >> 2) * 4 + (F.lane >> 4)) * R, c8 = g * 16 + (F.lane & 15);
        if (g == 0) pool_quad<2, R>(Z, Y, row0, c8); else if (g == 1) pool_quad<4, R>(Z, Y, row0, c8); else if (g == 2) pool_quad<8, R>(Z, Y, row0, c8); else pool_quad<16, R>(Z, Y, row0, c8);
    }
}

__global__ void __launch_bounds__(NWAVES * 64, 2) mega_fwd(Args args) {
    extern __shared__ __attribute__((aligned(16))) unsigned char lds[];
    Frame F;
    F.lds = (LAS unsigned char*)lds; F.MISC = (volatile LAS unsigned*)(F.lds + MISC_OFF);
    F.tid = threadIdx.x; F.lane = F.tid & 63; F.wave = __builtin_amdgcn_readfirstlane(F.tid >> 6);
    F.G = gridDim.x; { const int bx = blockIdx.x; F.vcu = (F.G % 8 == 0) ? (bx % 8) * (F.G / 8) + bx / 8 : bx; }
    unsigned char* ws = args.ws; F.ctl = (gu32*)(ws + WS_CTL);
    for (int u = F.tid; u < (LDS_BYTES - LDSCTL_OFF) / 4; u += NWAVES * 64) ((LAS unsigned*)(F.lds + LDSCTL_OFF))[u] = 0u;
    __syncthreads();
    XcdBarrier bar = xcd_barrier_post((unsigned*)(F.ctl + CW_BAR), F.MISC + 8);
    const int lo = args.ph_lo, hi = args.ph_hi;
#ifdef TS_BUILD
    unsigned long long* tsb = (unsigned long long*)(ws + 39 * MiB); int nts = 0;
#define STAMP() do { if (blockIdx.x == 0 && F.tid == 0) tsb[nts] = __builtin_amdgcn_s_memrealtime(); ++nts; } while (0)
#else
#define STAMP() do {} while (0)
#endif
    STAMP();
#ifndef PHMASK
#define PHMASK 0x1ff
#endif
#define IN(k) (((PHMASK >> (k)) & 1) && lo <= (k) && (k) < hi)
#ifndef REPEAT_MASK
#define REPEAT_MASK 0
#endif
#define REPS(k) for (int rep = 0; rep < 1 + ((REPEAT_MASK >> (k)) & 1); ++rep)
    float* spare = (float*)(ws + 38 * MiB);
#define SEAM(k) do { if (IN(k) && IN((k) + 1)) xcd_barrier(bar); STAMP(); } while (0)
    float* ssz = (float*)(ws + WS_SSZ); float *ss_q = ssz, *ss_kv = ssz + M, *ss2 = ssz + 2 * (size_t)M, *ss3 = ssz + 3 * (size_t)M, *hss = ssz + 5 * (size_t)M;
    float* ss1 = (float*)(ws + WS_SS1); float* ss_kr = ss1 + M; float* krr = (float*)(ws + WS_KRR); const float* tab = (const float*)(ws + WS_TAB);
    float* out = args.out;

    if (IN(0)) REPS(0) { p0_prologue(F, args); } SEAM(0);
    if (IN(1)) REPS(1) {
        pg8::Gemm g{(const pg8::bf16_t*)out, (const pg8::bf16_t*)(ws + WS_WIN), M, 1280, 1024, 1024}; pg8::StaticOrder S; S.init(M, 1280, F.G, (int)blockIdx.x);
        pg8::EpiIn E{(pg8::bf16_t*)(ws + WS_Z), ss1, rep ? spare : ss_q, rep ? spare : ss_kv, ss_kr, krr, args.in[13], tab};
        pg8::gemm_phase<pg8::EpiIn, pg8::StaticOrder, true, true>(F.lds + RING_OFF, g, S, E);
    } SEAM(1);
    if (IN(2)) {
        REPS(9) { pool_phase(F, (const bf16*)(ws + WS_Z), (bf16*)(ws + WS_Y)); VM_WAIT(); }
        REPS(10) { pg8::Gemm g{(const pg8::bf16_t*)(ws + WS_Z) + 512, (const pg8::bf16_t*)(ws + WS_WQB), M, 768, 384, 1280}; pg8::StaticOrder S; S.init(M, 768, F.G, (int)blockIdx.x);
          pg8::EpiQ E{(pg8::bf16_t*)(ws + WS_Q), ss_q, rep ? spare : hss};
          pg8::gemm_phase<pg8::EpiQ, pg8::StaticOrder, true, true>(F.lds + RING_OFF, g, S, E); }
        REPS(11) { pg8::Gemm g{(const pg8::bf16_t*)(ws + WS_Z) + 1024, (const pg8::bf16_t*)(ws + WS_WKVB), M, 1024, 256, 1280}; pg8::StaticOrder S; S.init(M, 1024, F.G, (int)blockIdx.x);
          pg8::EpiKV E{(pg8::bf16_t*)(ws + WS_K), (pg8::bf16_t*)(ws + WS_V), ss_kv, ss_kr, krr, args.in[13], 0};
          pg8::gemm_phase<pg8::EpiKV, pg8::StaticOrder, true, true>(F.lds + RING_OFF, g, S, E); }
    } SEAM(2);
    if (IN(3)) REPS(3) {
        const att::AttnArgs A{(const att::bf16_t*)(ws + WS_Q), (const att::bf16_t*)(ws + WS_K), (const att::bf16_t*)(ws + WS_V), ss_q, hss, args.in[12], tab, (att::bf16_t*)(ws + WS_Y)};
        { const int var_ = args.p0mask >> 5; att::LCH* al_ = (att::LCH*)(F.lds + RING_OFF);
#ifdef ATTN_VARIANTS
          if (var_ == 1) att::attn_phase<1>(A, F.vcu, F.G, al_, args.p0mask); else if (var_ == 2) att::attn_phase<2>(A, F.vcu, F.G, al_, args.p0mask); else if (var_ == 3) att::attn_phase<3>(A, F.vcu, F.G, al_, args.p0mask); else if (var_ == 4) att::attn_phase<4>(A, F.vcu, F.G, al_, args.p0mask); else
#endif
          att::attn_phase<0>(A, F.vcu, F.G, al_, args.p0mask); (void)var_; }
    } SEAM(3);
    if (IN(4)) REPS(4) {
        pg8::Gemm g{(const pg8::bf16_t*)(ws + WS_Y), (const pg8::bf16_t*)(ws + WS_WO), M, 1024, 1024, 1024}; pg8::StaticOrder S; S.init(M, 1024, F.G, (int)blockIdx.x);
        pg8::EpiResX E{(const pg8::bf16_t*)out, ss1, (pg8::bf16_t*)(ws + WS_HB), rep ? spare : ss2};
        pg8::gemm_phase<pg8::EpiResX, pg8::StaticOrder, true, true>(F.lds + RING_OFF, g, S, E);
    } SEAM(4);
    if (IN(5)) REPS(5) {
        pg8::Gemm g{(const pg8::bf16_t*)(ws + WS_HB), (const pg8::bf16_t*)(ws + WS_WGU), M, 5632, 1024, 1024}; pg8::StaticOrder S; S.init(M, 5632, F.G, (int)blockIdx.x);
        pg8::EpiSwiglu E{(pg8::bf16_t*)(ws + WS_ACT), ss2};
        pg8::gemm_phase<pg8::EpiSwiglu, pg8::StaticOrder, true, true>(F.lds + RING_OFF, g, S, E);
    } SEAM(5);
    if (IN(6)) {
        pg8::Gemm g{(const pg8::bf16_t*)(ws + WS_ACT), (const pg8::bf16_t*)(ws + WS_WD), M, 1024, 2816, 2816}; pg8::StaticOrder S; S.init(M, 1024, F.G, (int)blockIdx.x, 1);
        pg8::EpiResB E{(pg8::bf16_t*)(ws + WS_HB), ss3};
        pg8::gemm_phase<pg8::EpiResB, pg8::StaticOrder, true, true>(F.lds + RING_OFF, g, S, E);
    } SEAM(6);
    if (IN(7)) REPS(7) {
        pg8::Gemm g{(const pg8::bf16_t*)(ws + WS_PB), (const pg8::bf16_t*)(ws + WS_WPP), M, 1024, 256, 256}; pg8::StaticOrder S; S.init(M, 1024, F.G, (int)blockIdx.x);
        pg8::EpiStore E{(pg8::bf16_t*)(ws + WS_PROJ)};
        pg8::gemm_phase<pg8::EpiStore, pg8::StaticOrder, true, true>(F.lds + RING_OFF, g, S, E);
    }
    if (IN(7) && IN(8)) { VM_WAIT(); __syncthreads(); } STAMP();
    if (IN(8)) {
        pg8::Gemm g{(const pg8::bf16_t*)(ws + WS_HB), (const pg8::bf16_t*)(ws + WS_WPG), M, 1024, 1024, 1024}; pg8::StaticOrder S; S.init(M, 1024, F.G, (int)blockIdx.x);
        pg8::EpiFinal E{out, (const pg8::bf16_t*)(ws + WS_HB), (const pg8::bf16_t*)(ws + WS_PROJ), ss3};
        pg8::gemm_phase<pg8::EpiFinal, pg8::StaticOrder, true, true>(F.lds + RING_OFF, g, S, E);
    }
    STAMP();
#undef IN
#undef SEAM
}

static int launch_fast(void* const* d_in, void* d_out, void* d_ws, size_t ws_size, hipStream_t stream, int ph_lo, int ph_hi, int p0mask = 15) {
    static int grid = 0;
    if (grid == 0) {
        if (ws_size < WS_END) { fprintf(stderr, "kernel_launch: workspace too small: %zu < %zu\n", ws_size, (size_t)WS_END); grid = -1; return -1; }
        int dev = 0, cus = 0, per_cu = 0;
        if (hipGetDevice(&dev) != hipSuccess || hipDeviceGetAttribute(&cus, hipDeviceAttributeMultiprocessorCount, dev) != hipSuccess) { grid = -1; return -1; }
        if (hipFuncSetAttribute((const void*)mega_fwd, hipFuncAttributeMaxDynamicSharedMemorySize, LDS_BYTES) != hipSuccess) { fprintf(stderr, "kernel_launch: hipFuncSetAttribute failed\n"); grid = -1; return -1; }
        if (hipOccupancyMaxActiveBlocksPerMultiprocessor(&per_cu, (const void*)mega_fwd, NWAVES * 64, LDS_BYTES) != hipSuccess || per_cu < 1) fprintf(stderr, "kernel_launch: note: occupancy query reports %d\n", per_cu);
        (void)hipGetLastError();
        grid = cus;
    }
    if (grid < 0) return -1;
    if (hipMemsetAsync((char*)d_ws + WS_CTL, 0, CTL_ZERO_BYTES, stream) != hipSuccess) return -1;
    Args a{};
    for (int i = 0; i < 22; ++i) a.in[i] = (const float*)d_in[i];
    a.out = (float*)d_out; a.ws = (unsigned char*)d_ws; a.ph_lo = ph_lo; a.ph_hi = ph_hi; a.p0mask = p0mask;
    hipLaunchKernelGGL(mega_fwd, dim3(grid), dim3(NWAVES * 64), LDS_BYTES, stream, a);
    const hipError_t le = hipPeekAtLastError();
    if (le != hipSuccess) { fprintf(stderr, "kernel_launch: launch failed: %s\n", hipGetErrorName(le)); return -1; }
    return 0;
}

extern "C" void kernel_launch(void* const* d_in, const int* in_sizes, int n_in, void* d_out, int out_size, void* d_ws, size_t ws_size, hipStream_t stream) {
  (void)in_sizes; (void)n_in; (void)out_size;
  launch_fast(d_in, d_out, d_ws, ws_size, stream, 0, NPH);
}
```

```cpp
#include <hip/hip_runtime.h>
#include <cstdio>
#include <cstdint>

#define EARLY_INV 1
namespace pg8 {
#define PG8_LAS __attribute__((address_space(3)))
typedef unsigned short bf16_t;
typedef short bf16x8 __attribute__((ext_vector_type(8)));
typedef float f32x4 __attribute__((ext_vector_type(4)));
typedef unsigned u32x4 __attribute__((ext_vector_type(4)));
constexpr int BM = 256, BK = 64, HALF = 128, HTB = HALF * BK * 2  , STAGE_BYTES = 8 * HTB, NXCD = 8, WGM = 8;

__host__ __device__ __forceinline__ int lds_byte(int r, int c) { const int st = (r >> 4) * 2 + (c >> 5), rr = r & 15, cc = c & 31, ob = rr * 64 + cc * 2; return st * 1024 + (ob ^ (((ob >> 9) & 1) << 5)); }
__host__ __device__ __forceinline__ void stage_rc(int b, int& R, int& C) { const int st = b / 1024, sb = b % 1024, swz = sb ^ (((sb >> 9) & 1) << 5); R = (st >> 1) * 16 + swz / 64; C = (st & 1) * 32 + (swz % 64) / 2; }
__host__ __device__ __forceinline__ int perm32(int rho) { const int n = rho >> 4, i = rho & 15; return 8 * (i >> 2) + 4 * n + (i & 3); }

struct Unit { int pm, pn; };
struct Gemm { const bf16_t* A; const bf16_t* Bt; int M, N, K, lda; const bf16_t* A2 = nullptr; int nsplit = 1 << 30; };

struct StaticOrder {
    int nM, nN, nwg, G, c, rev;
    __host__ __device__ void init(int M, int N, int G_, int c_, int rev_ = 0) { nM = M / BM; nN = N / BM; nwg = nM * nN; G = G_; c = c_; rev = rev_; }
    __host__ __device__ bool next(int i, Unit& u) const {
        long L = (long)i * G + c; if (L >= nwg) return false;
        if (rev) { const int R = nwg / G; if (i < R) L = (long)(R - 1 - i) * G + c; }
        int wgid = (int)L; { const int q = nwg / NXCD, r = nwg % NXCD, xcd = wgid % NXCD, off = wgid / NXCD; wgid = (xcd < r ? xcd * (q + 1) : r * (q + 1) + (xcd - r) * q) + off; }
        const int nig = WGM * nN, gid = wgid / nig, fm = gid * WGM, gsz = (nM - fm) < WGM ? (nM - fm) : WGM;
        u.pm = fm + ((wgid % nig) % gsz); u.pn = (wgid % nig) / gsz; return true;
    }
    __device__ __forceinline__ void a_ready(const Unit&) const {}
    __device__ __forceinline__ void done(const Unit&) const {}
};

__device__ __forceinline__ unsigned cvt_pk_bf16(float lo, float hi) { unsigned r; asm volatile("v_cvt_pk_bf16_f32 %0, %1, %2" : "=v"(r) : "v"(lo), "v"(hi)); return r; }
typedef float f32x2 __attribute__((ext_vector_type(2)));

constexpr int MROWS = 49152, SEQ = 2048, MPROMPT = 32768, ZP = 1280;
constexpr float NEPS = 1e-6f;
template <class T> __device__ __forceinline__ T* boff(T* base, unsigned elem) { return (T*)((char*)base + elem * (unsigned)sizeof(T)); }
template <class T> __device__ __forceinline__ const T* boff(const T* base, unsigned elem) { return (const T*)((const char*)base + elem * (unsigned)sizeof(T)); }
__device__ __forceinline__ u32x4 pack8(const f32x4 a, const f32x4 b) { u32x4 w; w.x = cvt_pk_bf16(a[0], a[1]); w.y = cvt_pk_bf16(a[2], a[3]); w.z = cvt_pk_bf16(b[0], b[1]); w.w = cvt_pk_bf16(b[2], b[3]); return w; }
__device__ __forceinline__ float sq8(const f32x4 a, const f32x4 b) { return (a[0] * a[0] + a[1] * a[1]) + (a[2] * a[2] + a[3] * a[3]) + (b[0] * b[0] + b[1] * b[1]) + (b[2] * b[2] + b[3] * b[3]); }
__device__ __forceinline__ float red_fq(float s) {
    { auto rr = __builtin_amdgcn_permlane16_swap(__float_as_uint(s), __float_as_uint(s), false, false); s = __uint_as_float(rr[0]) + __uint_as_float(rr[1]); }
    { auto rr = __builtin_amdgcn_permlane32_swap(__float_as_uint(s), __float_as_uint(s), false, false); s = __uint_as_float(rr[0]) + __uint_as_float(rr[1]); }
    return s; }
__device__ __forceinline__ float bflo(unsigned w) { return __uint_as_float(w << 16); }
__device__ __forceinline__ float bfhi(unsigned w) { return __uint_as_float(w & 0xffff0000u); }
#define EPI_HALF_BEGIN _Pragma("unroll") for (int ai = 0; ai < 2; ++ai) { int rbase = u.pm * BM + ai * HALF + wr * 64 + fr; asm volatile("" : "+v"(rbase) :: "memory");
#define EPI_HALF_END asm volatile("" ::: "memory"); }
#define EPI_M _Pragma("unroll") for (int m = 0; m < 4; ++m)
#define EPI_FENCE asm volatile("" ::: "memory")
__device__ __forceinline__ float rstd(float ss, float inv_n) { return __builtin_amdgcn_rsqf(ss * inv_n + NEPS); }

struct EpiIn {
    static constexpr bool PERM = true, AFTER_DRAIN = false;
    bf16_t* z; const float* ss1; float* ss_q; float* ss_kv; float* ss_kr; float* krr; const float* kn_g; const float* tab;
    __device__ __forceinline__ void operator()(const f32x4 (&acc)[2][2][4][2], const Unit& u, int wr, int wc, int fr, int fq) const {
        const int colt = u.pn * BM + wc * 32 + 8 * fq;
        EPI_HALF_BEGIN
            EPI_M { const int row = rbase + 16 * m;
                f32x4 v00 = acc[ai][0][m][0], v01 = acc[ai][0][m][1], v10 = acc[ai][1][m][0], v11 = acc[ai][1][m][1];
                bf16_t* zr = boff(z, (unsigned)row * ZP + colt);
                if (u.pn != 3) {
                    *(u32x4*)(zr) = pack8(v00, v01); *(u32x4*)(zr + HALF) = pack8(v10, v11);
                    if (u.pn == 2 || u.pn == 4) { const float s = red_fq(sq8(v00, v01) + sq8(v10, v11)); if (fq == 0) atomicAdd((u.pn == 2 ? ss_q : ss_kv) + row, s); }
                } else {
                    *(u32x4*)(zr) = pack8(v00, v01);
                    { const float s = red_fq(sq8(v00, v01)); if (fq == 0) atomicAdd(ss_q + row, s); }
                    if (wc == 0) {
                        const float s = red_fq(sq8(v10, v11)); if (fq == 0) ss_kr[row] = s;
                        const int t = row & (SEQ - 1); const float* tb = tab + ((size_t)t * 16 + 4 * fq) * 2;
                        const f32x4 cs0 = *(const f32x4*)(tb), cs1 = *(const f32x4*)(tb + 4);
                        const f32x4 g1 = *(const f32x4*)(kn_g + 64 + 4 * fq), g2 = *(const f32x4*)(kn_g + 80 + 4 * fq);
                        f32x4 o0, o1;
                        { const float a = v10[0] * g1[0], b = v10[1] * g2[0]; o0[0] = a * cs0[0] - b * cs0[1]; o0[1] = a * cs0[1] + b * cs0[0]; }
                        { const float a = v10[2] * g1[1], b = v10[3] * g2[1]; o0[2] = a * cs0[2] - b * cs0[3]; o0[3] = a * cs0[3] + b * cs0[2]; }
                        { const float a = v11[0] * g1[2], b = v11[1] * g2[2]; o1[0] = a * cs1[0] - b * cs1[1]; o1[1] = a * cs1[1] + b * cs1[0]; }
                        { const float a = v11[2] * g1[3], b = v11[3] * g2[3]; o1[2] = a * cs1[2] - b * cs1[3]; o1[3] = a * cs1[3] + b * cs1[2]; }
                        float* kr = boff(krr, (unsigned)row * 32 + 8 * fq); *(f32x4*)kr = o0; *(f32x4*)(kr + 4) = o1;
                    }
                }
            }
        EPI_HALF_END
    }
};
struct EpiQ {
    static constexpr bool PERM = true, AFTER_DRAIN = false;
    bf16_t* Q; const float* ss_q; float* hss;
    __device__ __forceinline__ void operator()(const f32x4 (&acc)[2][2][4][2], const Unit& u, int wr, int wc, int fr, int fq) const {
        const int s0 = u.pn * 8 + wc, s1 = s0 + 4; const int h0 = s0 / 3, p0 = s0 - 3 * h0, h1 = s1 / 3, p1 = s1 - 3 * h1;
        EPI_HALF_BEGIN
            EPI_M { const int row = rbase + 16 * m;
                const int b = row >> 11, t = row & (SEQ - 1);
                const f32x4 v00 = acc[ai][0][m][0], v01 = acc[ai][0][m][1], v10 = acc[ai][1][m][0], v11 = acc[ai][1][m][1];
                *(u32x4*)boff(Q, ((unsigned)(b * 8 + h0) * SEQ + t) * 96 + p0 * 32 + 8 * fq) = pack8(v00, v01);
                *(u32x4*)boff(Q, ((unsigned)(b * 8 + h1) * SEQ + t) * 96 + p1 * 32 + 8 * fq) = pack8(v10, v11);
                const float q0 = red_fq(sq8(v00, v01)), q1 = red_fq(sq8(v10, v11));
                if (fq == 0) { atomicAdd(boff(hss, (unsigned)h0 * MROWS + row), q0); atomicAdd(boff(hss, (unsigned)h1 * MROWS + row), q1); }
            }
        EPI_HALF_END
    }
};
struct EpiKV {
    static constexpr bool PERM = true, AFTER_DRAIN = false;
    bf16_t* K; bf16_t* V; const float* ss_kv; const float* ss_kr; const float* krr; const float* kn_g; int pn0;
    __device__ __forceinline__ void operator()(const f32x4 (&acc)[2][2][4][2], const Unit& u, int wr, int wc, int fr, int fq) const {
        const int h = 2 * (u.pn - pn0) + (wc & 1);
        EPI_HALF_BEGIN
            float rsv[4], skr[4]; f32x4 kr0[4], kr1[4];
            EPI_M rsv[m] = ss_kv[rbase + 16 * m];
            if (wc < 2) { EPI_M { skr[m] = ss_kr[rbase + 16 * m]; const float* kr = boff(krr, (unsigned)(rbase + 16 * m) * 32 + 8 * fq); kr0[m] = *(const f32x4*)kr; kr1[m] = *(const f32x4*)(kr + 4); } }
            EPI_FENCE;
            EPI_M { const int row = rbase + 16 * m; const float rs = rstd(rsv[m], 1.0f / 256.0f);
                const int b = row >> 11, t = row & (SEQ - 1);
                f32x4 v00 = acc[ai][0][m][0] * rs, v01 = acc[ai][0][m][1] * rs, v10 = acc[ai][1][m][0] * rs, v11 = acc[ai][1][m][1] * rs;
                if (wc >= 2) {
                    bf16_t* vp = boff(V, ((unsigned)(b * 8 + h) * SEQ + t) * 64 + 8 * fq);
                    *(u32x4*)(vp) = pack8(v00, v01); *(u32x4*)(vp + 32) = pack8(v10, v11);
                } else {
                    const float tot = red_fq(sq8(v00, v01) + sq8(v10, v11));
                    const float sk = rstd(tot + skr[m], 1.0f / 96.0f);
                    const f32x4 g00 = *(const f32x4*)(kn_g + 8 * fq), g01 = *(const f32x4*)(kn_g + 8 * fq + 4), g10 = *(const f32x4*)(kn_g + 32 + 8 * fq), g11 = *(const f32x4*)(kn_g + 36 + 8 * fq);
                    v00 = v00 * g00 * sk; v01 = v01 * g01 * sk; v10 = v10 * g10 * sk; v11 = v11 * g11 * sk;
                    bf16_t* kp = boff(K, ((unsigned)(b * 8 + h) * SEQ + t) * 96 + 8 * fq);
                    *(u32x4*)(kp) = pack8(v00, v01); *(u32x4*)(kp + 32) = pack8(v10, v11);
                    *(u32x4*)(kp + 64) = pack8(kr0[m] * sk, kr1[m] * sk);
                }
            }
        EPI_HALF_END
    }
};
struct EpiQKV {
    static constexpr bool PERM = true, AFTER_DRAIN = false;
    EpiQ q; EpiKV kv;
    __device__ __forceinline__ void operator()(const f32x4 (&acc)[2][2][4][2], const Unit& u, int wr, int wc, int fr, int fq) const {
        if (u.pn < 3) q(acc, u, wr, wc, fr, fq); else kv(acc, u, wr, wc, fr, fq);
    }
};
struct EpiResX {
    static constexpr bool PERM = true, AFTER_DRAIN = false;
    const bf16_t* xn; const float* xinv; bf16_t* hb; float* ss;
    __device__ __forceinline__ void operator()(const f32x4 (&acc)[2][2][4][2], const Unit& u, int wr, int wc, int fr, int fq) const {
        const int colt = u.pn * BM + wc * 32 + 8 * fq;
        EPI_HALF_BEGIN
            u32x4 xw[4][2]; float xs[4];
            EPI_M { const bf16_t* xp = boff(xn, (unsigned)(rbase + 16 * m) * 1024 + colt); xw[m][0] = *(const u32x4*)xp; xw[m][1] = *(const u32x4*)(xp + HALF); xs[m] = xinv[rbase + 16 * m]; }
            EPI_FENCE;
            EPI_M { const int row = rbase + 16 * m; float s = 0.f;
#pragma unroll
                for (int bj = 0; bj < 2; ++bj) {
                    const u32x4 w = xw[m][bj];
                    const f32x4 b0 = {bflo(w.x), bfhi(w.x), bflo(w.y), bfhi(w.y)}, b1 = {bflo(w.z), bfhi(w.z), bflo(w.w), bfhi(w.w)};
                    const f32x4 h0 = b0 * xs[m] + acc[ai][bj][m][0], h1 = b1 * xs[m] + acc[ai][bj][m][1];
                    *(u32x4*)boff(hb, (unsigned)row * 1024 + colt + bj * HALF) = pack8(h0, h1);
                    s += sq8(h0, h1);
                }
                s = red_fq(s); if (fq == 0) atomicAdd(ss + row, s);
            }
        EPI_HALF_END
    }
};
struct EpiResB {
    static constexpr bool PERM = true, AFTER_DRAIN = false;
    bf16_t* hb; float* ss;
    __device__ __forceinline__ void operator()(const f32x4 (&acc)[2][2][4][2], const Unit& u, int wr, int wc, int fr, int fq) const {
        const int colt = u.pn * BM + wc * 32 + 8 * fq;
        EPI_HALF_BEGIN
            u32x4 hw[4][2];
            EPI_M { const bf16_t* hp = boff(hb, (unsigned)(rbase + 16 * m) * 1024 + colt); hw[m][0] = *(const u32x4*)hp; hw[m][1] = *(const u32x4*)(hp + HALF); }
            EPI_FENCE;
            EPI_M { const int row = rbase + 16 * m; float s = 0.f;
#pragma unroll
                for (int bj = 0; bj < 2; ++bj) {
                    const u32x4 w = hw[m][bj];
                    const f32x4 b0 = {bflo(w.x), bfhi(w.x), bflo(w.y), bfhi(w.y)}, b1 = {bflo(w.z), bfhi(w.z), bflo(w.w), bfhi(w.w)};
                    const f32x4 h0 = b0 + acc[ai][bj][m][0], h1 = b1 + acc[ai][bj][m][1];
                    *(u32x4*)boff(hb, (unsigned)row * 1024 + colt + bj * HALF) = pack8(h0, h1);
                    s += sq8(h0, h1);
                }
                s = red_fq(s); if (fq == 0) atomicAdd(ss + row, s);
            }
        EPI_HALF_END
    }
};
struct EpiSwiglu {
    static constexpr bool PERM = true, AFTER_DRAIN = false;
    bf16_t* act; const float* ss2;
    __device__ __forceinline__ void operator()(const f32x4 (&acc)[2][2][4][2], const Unit& u, int wr, int wc, int fr, int fq) const {
        const int colt = u.pn * HALF + wc * 32 + 8 * fq;
        float rsa[2][4];
        { const int r0 = u.pm * BM + wr * 64 + fr;
#pragma unroll
          for (int ai = 0; ai < 2; ++ai)
#pragma unroll
            for (int m = 0; m < 4; ++m) rsa[ai][m] = ss2[r0 + ai * HALF + 16 * m]; }
        EPI_FENCE;
        EPI_HALF_BEGIN
            EPI_M { const int row = rbase + 16 * m; const float rs = __builtin_amdgcn_rsqf(rsa[ai][m] * (1.0f / 1024.0f) + NEPS);
                const float kg = -1.4426950408889634f * rs, rs2 = rs * rs;
                f32x4 a[2];
#pragma unroll
                for (int n = 0; n < 2; ++n) { const f32x4 g = acc[ai][0][m][n], w = acc[ai][1][m][n]; const f32x4 x = g * kg; f32x4 e;
#pragma unroll
                    for (int i = 0; i < 4; ++i) e[i] = __builtin_amdgcn_exp2f(x[i]);
                    const f32x4 d = e + 1.0f; f32x4 r;
#pragma unroll
                    for (int i = 0; i < 4; ++i) r[i] = __builtin_amdgcn_rcpf(d[i]);
                    a[n] = (g * w) * (r * rs2); }
                __builtin_nontemporal_store(pack8(a[0], a[1]), (u32x4*)((char*)act + ((unsigned)row * 2816u + (unsigned)colt) * 2u));
            }
        EPI_HALF_END
    }
};
struct EpiStore {
    static constexpr bool PERM = true, AFTER_DRAIN = false;
    bf16_t* o;
    __device__ __forceinline__ void operator()(const f32x4 (&acc)[2][2][4][2], const Unit& u, int wr, int wc, int fr, int fq) const {
        const int colt = u.pn * BM + wc * 32 + 8 * fq;
        EPI_HALF_BEGIN
            EPI_M { const int row = rbase + 16 * m;
#pragma unroll
                for (int bj = 0; bj < 2; ++bj) *(u32x4*)boff(o, (unsigned)row * 1024 + colt + bj * HALF) = pack8(acc[ai][bj][m][0], acc[ai][bj][m][1]); }
        EPI_HALF_END
    }
};
struct EpiFinal {
    static constexpr bool PERM = true, AFTER_DRAIN = false;
    float* out; const bf16_t* hb; const bf16_t* proj; const float* ss3;
    __device__ __forceinline__ void operator()(const f32x4 (&acc)[2][2][4][2], const Unit& u, int wr, int wc, int fr, int fq) const {
        const int colt = u.pn * BM + wc * 32 + 8 * fq;
        f32x4 one4 = {1.f, 1.f, 1.f, 1.f}; asm volatile("" : "+v"(one4));
        EPI_HALF_BEGIN
            float rsv[4]; u32x4 hw[4][2], pw[4][2];
            EPI_M { const unsigned off = (unsigned)(rbase + 16 * m) * 1024 + colt; rsv[m] = ss3[rbase + 16 * m];
                hw[m][0] = *(const u32x4*)boff(hb, off); hw[m][1] = *(const u32x4*)boff(hb, off + HALF); pw[m][0] = *(const u32x4*)boff(proj, off); pw[m][1] = *(const u32x4*)boff(proj, off + HALF); }
            EPI_FENCE;
            EPI_M { const int row = rbase + 16 * m; const float kg = -1.4426950408889634f * __builtin_amdgcn_rsqf(rsv[m] * (1.0f / 1024.0f) + NEPS);
#pragma unroll
                for (int bj = 0; bj < 2; ++bj) {
                    const unsigned off = (unsigned)row * 1024 + colt + bj * HALF; const u32x4 pj = pw[m][bj], hv = hw[m][bj];
                    const f32x4 h0 = {bflo(hv.x), bfhi(hv.x), bflo(hv.y), bfhi(hv.y)}, h1 = {bflo(hv.z), bfhi(hv.z), bflo(hv.w), bfhi(hv.w)};
                    const f32x4 p0 = {bflo(pj.x), bfhi(pj.x), bflo(pj.y), bfhi(pj.y)}, p1 = {bflo(pj.z), bfhi(pj.z), bflo(pj.w), bfhi(pj.w)};
                    const f32x4 x0 = acc[ai][bj][m][0] * kg, x1 = acc[ai][bj][m][1] * kg; f32x4 e0, e1, r0, r1;
#pragma unroll
                    for (int i = 0; i < 4; ++i) { e0[i] = __builtin_amdgcn_exp2f(x0[i]); e1[i] = __builtin_amdgcn_exp2f(x1[i]); }
                    const f32x4 d0 = e0 * one4 + one4, d1 = e1 * one4 + one4;
#pragma unroll
                    for (int i = 0; i < 4; ++i) { r0[i] = __builtin_amdgcn_rcpf(d0[i]); r1[i] = __builtin_amdgcn_rcpf(d1[i]); }
                    float* o = boff(out, off); *(f32x4*)o = p0 * r0 + h0; *(f32x4*)(o + 4) = p1 * r1 + h1;
                }
            }
        EPI_HALF_END
    }
};

struct EpiNull {
    static constexpr bool PERM = true, AFTER_DRAIN = false;
    __device__ __forceinline__ void operator()(const f32x4 (&acc)[2][2][4][2], const Unit& u, int wr, int wc, int fr, int fq) const {
#pragma unroll
        for (int ai = 0; ai < 2; ++ai)
#pragma unroll
            for (int bj = 0; bj < 2; ++bj)
#pragma unroll
                for (int m = 0; m < 4; ++m) { asm volatile("" :: "v"(acc[ai][bj][m][0]), "v"(acc[ai][bj][m][1])); }
    }
};

template <class Epi, class Sched, bool ALIGN_EPI = false, bool SP2 = false>
__device__ __forceinline__ void gemm_phase(PG8_LAS unsigned char* lds, const Gemm g, const Sched& S, const Epi& E) {
    const int tid = threadIdx.x, wid = __builtin_amdgcn_readfirstlane(tid >> 6), lane = tid & 63, wr = wid >> 2, wc = wid & 3, fr = lane & 15, fq = lane >> 4;
    const int K = g.K, nt = K / BK;
    unsigned voffA[2], voffB[2];
#pragma unroll
    for (int i = 0; i < 2; ++i) { int R, C; stage_rc(tid * 16 + i * 8192, R, C); const int Rb = Epi::PERM ? ((R & ~31) + perm32(R & 31)) : R;
        voffA[i] = (unsigned)(R * g.lda + C) * 2u; voffB[i] = (unsigned)(Rb * K + C) * 2u; }
    const size_t kstep = (size_t)(BK * 2);
    const size_t hstepA = (size_t)HALF * g.lda * 2, hstepB = (size_t)HALF * K * 2;
    const size_t tstepA = 2 * hstepA, tstepB = 2 * hstepB;
    const unsigned ldsw = (unsigned)wid * 1024u;
    const unsigned ldsb0 = (unsigned)(unsigned long)lds + ldsw;
    const int aoff = lds_byte(wr * 64 + fr, fq * 8), boff = lds_byte(wc * 32 + fr, fq * 8);
#define PG8_SA(b, h) (((b) * 2 + (h)) * HTB)
#define PG8_SB(b, h) ((4 + (b) * 2 + (h)) * HTB)
#define PG8_STAGE(bufoff, gbase, voff) do { const char* gb_ = (const char*)(gbase); _Pragma("unroll") for (int _i = 0; _i < 2; ++_i) \
        asm volatile("s_mov_b32 m0, %2\n\ts_nop 0\n\tglobal_load_lds_dwordx4 %0, %1" :: "v"((voff)[_i]), "s"(gb_), "s"(ldsb0 + (unsigned)(bufoff) + (unsigned)_i * 8192u) : "m0", "memory"); } while (0)
#define PG8_LDA(dst, b, h) do { _Pragma("unroll") for (int m = 0; m < 4; ++m) _Pragma("unroll") for (int k = 0; k < 2; ++k) dst[m][k] = *(const PG8_LAS bf16x8*)(lds + PG8_SA(b, h) + aoff + m * 2048 + k * 1024); } while (0)
#define PG8_LDB(dst, b, h) do { _Pragma("unroll") for (int n = 0; n < 2; ++n) _Pragma("unroll") for (int k = 0; k < 2; ++k) dst[n][k] = *(const PG8_LAS bf16x8*)(lds + PG8_SB(b, h) + boff + n * 2048 + k * 1024); } while (0)
#define PG8_MMA(ai, bj, At, Bt) do { __builtin_amdgcn_s_setprio(1); _Pragma("unroll") for (int m = 0; m < 4; ++m) _Pragma("unroll") for (int n = 0; n < 2; ++n) _Pragma("unroll") for (int k = 0; k < 2; ++k) \
        acc[ai][bj][m][n] = __builtin_amdgcn_mfma_f32_16x16x32_bf16(Bt[n][k], At[m][k], acc[ai][bj][m][n], 0, 0, 0); __builtin_amdgcn_s_setprio(0); } while (0)
#define PG8_WAIT_V(n) asm volatile("s_waitcnt vmcnt(" #n ")" ::: "memory")
#define PG8_WAIT_L(n) asm volatile("s_waitcnt lgkmcnt(" #n ")" ::: "memory")
#define PG8_BAR __builtin_amdgcn_s_barrier()
#define PG8_SCHED __builtin_amdgcn_sched_barrier(0)
    Unit cur, nxt; int ui = 0;
    if (!S.next(0, cur)) return;
    f32x4 acc[2][2][4][2];
#pragma unroll
    for (int a = 0; a < 2; ++a)
#pragma unroll
        for (int b = 0; b < 2; ++b)
#pragma unroll
            for (int m = 0; m < 4; ++m)
#pragma unroll
                for (int n = 0; n < 2; ++n) acc[a][b][m][n] = (f32x4){0.f, 0.f, 0.f, 0.f};
    bf16x8 At[4][2], B0[2][2], B1[2][2];
    const char* cA = (const char*)(cur.pn < g.nsplit ? g.A : g.A2) + (size_t)cur.pm * tstepA; const char* cB = (const char*)g.Bt + (size_t)cur.pn * tstepB;
    S.a_ready(cur);
    if constexpr (SP2) {
        PG8_STAGE(PG8_SB(0, 0), cB, voffB); PG8_STAGE(PG8_SB(0, 1), cB + hstepB, voffB); PG8_STAGE(PG8_SA(0, 0), cA, voffA); PG8_STAGE(PG8_SA(0, 1), cA + hstepA, voffA);
        if (wr == 1) PG8_BAR;
        PG8_WAIT_V(2); PG8_BAR;
        PG8_STAGE(PG8_SB(1, 0), cB + kstep, voffB); PG8_STAGE(PG8_SA(1, 0), cA + kstep, voffA); PG8_STAGE(PG8_SB(1, 1), cB + hstepB + kstep, voffB);
        PG8_WAIT_V(6); PG8_BAR;
    } else {
        PG8_STAGE(PG8_SB(0, 0), cB, voffB); PG8_STAGE(PG8_SA(0, 0), cA, voffA); PG8_STAGE(PG8_SB(0, 1), cB + hstepB, voffB); PG8_STAGE(PG8_SA(0, 1), cA + hstepA, voffA);
        if (wr == 1) PG8_BAR;
        PG8_WAIT_V(4); PG8_BAR;
        PG8_STAGE(PG8_SB(1, 0), cB + kstep, voffB); PG8_STAGE(PG8_SA(1, 0), cA + kstep, voffA); PG8_STAGE(PG8_SB(1, 1), cB + hstepB + kstep, voffB);
        PG8_WAIT_V(6); PG8_BAR;
    }
    for (;;) {
        const bool has_next = S.next(ui + 1, nxt);
        const char* nA = has_next ? (const char*)(nxt.pn < g.nsplit ? g.A : g.A2) + (size_t)nxt.pm * tstepA : cA; const char* nB = has_next ? (const char*)g.Bt + (size_t)nxt.pn * tstepB : cB;
#pragma nounroll
        for (int t = 0; t < nt; t += 2) {
            const bool last = (t == nt - 2);
            const char* a1 = cA + (size_t)(t + 1) * kstep;
            const char* a2 = last ? nA : cA + (size_t)(t + 2) * kstep; const char* b2 = last ? nB : cB + (size_t)(t + 2) * kstep;
            const char* a3 = a2 + kstep; const char* b3 = b2 + kstep;
            if (last && has_next) S.a_ready(nxt);
            if constexpr (SP2) {
            PG8_LDB(B0, 0, 0); PG8_LDB(B1, 0, 1); PG8_SCHED; PG8_LDA(At, 0, 0); PG8_STAGE(PG8_SA(1, 1), a1 + hstepA, voffA);
            PG8_WAIT_V(8); PG8_WAIT_L(0); PG8_BAR; PG8_MMA(0, 0, At, B0); PG8_MMA(0, 1, At, B1); PG8_BAR; PG8_SCHED;
            PG8_LDA(At, 0, 1); PG8_STAGE(PG8_SB(0, 0), b2, voffB); PG8_STAGE(PG8_SB(0, 1), b2 + hstepB, voffB); PG8_STAGE(PG8_SA(0, 0), a2, voffA);
            PG8_WAIT_V(8); PG8_WAIT_L(0); PG8_BAR; PG8_MMA(1, 0, At, B0); PG8_MMA(1, 1, At, B1); PG8_BAR; PG8_SCHED;
            PG8_LDB(B0, 1, 0); PG8_LDB(B1, 1, 1); PG8_SCHED; PG8_LDA(At, 1, 0); PG8_STAGE(PG8_SA(0, 1), a2 + hstepA, voffA);
            PG8_WAIT_V(8); PG8_WAIT_L(0); PG8_BAR; PG8_MMA(0, 0, At, B0); PG8_MMA(0, 1, At, B1); PG8_BAR; PG8_SCHED;
            PG8_LDA(At, 1, 1); PG8_STAGE(PG8_SB(1, 0), b3, voffB); PG8_STAGE(PG8_SB(1, 1), b3 + hstepB, voffB); PG8_STAGE(PG8_SA(1, 0), a3, voffA);
            PG8_WAIT_V(8); PG8_WAIT_L(0); PG8_BAR; PG8_MMA(1, 0, At, B0); PG8_MMA(1, 1, At, B1); PG8_BAR; PG8_SCHED;
            } else {
            PG8_LDB(B0, 0, 0); PG8_SCHED; PG8_LDA(At, 0, 0); PG8_STAGE(PG8_SA(1, 1), a1 + hstepA, voffA);
            PG8_WAIT_L(8); PG8_BAR; PG8_WAIT_L(0); PG8_MMA(0, 0, At, B0); PG8_BAR; PG8_SCHED;
            PG8_LDB(B1, 0, 1); PG8_STAGE(PG8_SB(0, 0), b2, voffB);
            PG8_BAR; PG8_WAIT_L(0); PG8_MMA(0, 1, At, B1); PG8_BAR;
            PG8_LDA(At, 0, 1); PG8_STAGE(PG8_SA(0, 0), a2, voffA);
            PG8_BAR; PG8_WAIT_L(0); PG8_MMA(1, 0, At, B0); PG8_BAR; PG8_SCHED;
            PG8_STAGE(PG8_SB(0, 1), b2 + hstepB, voffB);
            PG8_WAIT_V(6); PG8_BAR; PG8_MMA(1, 1, At, B1); PG8_BAR;
            PG8_LDB(B0, 1, 0); PG8_SCHED; PG8_LDA(At, 1, 0); PG8_STAGE(PG8_SA(0, 1), a2 + hstepA, voffA);
            PG8_WAIT_L(8); PG8_BAR; PG8_WAIT_L(0); PG8_MMA(0, 0, At, B0); PG8_BAR; PG8_SCHED;
            PG8_LDB(B1, 1, 1); PG8_STAGE(PG8_SB(1, 0), b3, voffB);
            PG8_BAR; PG8_WAIT_L(0); PG8_MMA(0, 1, At, B1); PG8_BAR;
            PG8_LDA(At, 1, 1); PG8_STAGE(PG8_SA(1, 0), a3, voffA);
            PG8_BAR; PG8_WAIT_L(0); PG8_MMA(1, 0, At, B0); PG8_BAR; PG8_SCHED;
            PG8_STAGE(PG8_SB(1, 1), b3 + hstepB, voffB);
            PG8_WAIT_V(6); PG8_BAR; PG8_MMA(1, 1, At, B1); PG8_BAR;
            }
        }
        if constexpr (ALIGN_EPI) { if (wr == 0) PG8_BAR; }
        if constexpr (!Epi::AFTER_DRAIN) { E(acc, cur, wr, wc, fr, fq); S.done(cur); }
        if (!has_next) break;
#pragma unroll
        for (int a = 0; a < 2; ++a)
#pragma unroll
            for (int b = 0; b < 2; ++b)
#pragma unroll
                for (int m = 0; m < 4; ++m)
#pragma unroll
                    for (int n = 0; n < 2; ++n) { f32x2 zl, zh; asm volatile("v_mov_b64 %0, 0" : "=v"(zl)); asm volatile("v_mov_b64 %0, 0" : "=v"(zh)); acc[a][b][m][n] = (f32x4){zl[0], zl[1], zh[0], zh[1]}; }
        cur = nxt; cA = nA; cB = nB; ++ui;
        if constexpr (ALIGN_EPI) { if (wr == 1) PG8_BAR; }
    }
    PG8_WAIT_V(0);
    if constexpr (!ALIGN_EPI) { if (wr == 0) PG8_BAR; }
    PG8_BAR;
    if constexpr (Epi::AFTER_DRAIN) { E.fused(acc, cur, wr, wc, fr, fq, lds, wid, lane); S.done(cur); }
#undef PG8_SA
#undef PG8_SB
#undef PG8_STAGE
#undef PG8_LDA
#undef PG8_LDB
#undef PG8_MMA
#undef PG8_WAIT_V
#undef PG8_WAIT_L
#undef PG8_BAR
#undef PG8_SCHED
}
}

namespace att {
using bf16x8 = __attribute__((ext_vector_type(8))) short;
using s16x4  = __attribute__((ext_vector_type(4))) short;
using f32x16 = __attribute__((ext_vector_type(16))) float;
using f32x4  = __attribute__((ext_vector_type(4))) float;
using u32x4  = __attribute__((ext_vector_type(4))) unsigned;
typedef unsigned short bf16_t;
typedef __attribute__((address_space(3))) char LCH;
typedef __attribute__((address_space(3))) float LFL;
constexpr int NW = 8, QBLK = 32, KVBLK = 64, DQK = 96, DV = 64, SEQ = 2048, MROWS = 49152;
constexpr float SCALE = 0.10206207261596577f;
constexpr float THR = 8.f;
constexpr int SHM_V = KVBLK * DV * 2, SHM_K = 12 * 1024, NSTG = 5, SHM_ATTN = NSTG * SHM_V + NSTG * SHM_K + NW * 64 * 4;
__device__ __forceinline__ int mod5(int x) { return x >= 5 ? x - 5 : x; }
__device__ __forceinline__ void glds16s(const void* sbase, unsigned voff, unsigned lds_base) {
  asm volatile("s_mov_b32 m0, %2\n\ts_nop 0\n\tglobal_load_lds_dwordx4 %0, %1" :: "v"(voff), "s"(sbase), "s"(lds_base) : "m0", "memory"); }
#define SBAR() __builtin_amdgcn_sched_barrier(0)
__device__ __forceinline__ int crow(int r, int hi) { return (r & 3) + 8 * (r >> 2) + 4 * hi; }
__device__ __forceinline__ unsigned cvtpk(float lo, float hi) { unsigned r; asm volatile("v_cvt_pk_bf16_f32 %0, %1, %2" : "=v"(r) : "v"(lo), "v"(hi)); return r; }
__device__ __forceinline__ float bflo(unsigned w) { return __uint_as_float(w << 16); }
__device__ __forceinline__ float bfhi(unsigned w) { return __uint_as_float(w & 0xffff0000u); }

constexpr float THRL = 8.f;
__device__ __forceinline__ void partialSM(f32x16& p0, f32x16& p1, float& mhat, f32x16& nmv, float& alpha, f32x16* o, LFL* al_l, int r32, int hi) {
  float pmax;
  {
#define MX3(a, b, c) __builtin_fmaxf(__builtin_fmaxf((a), (b)), (c))
    const float a0 = MX3(p0[0], p0[1], p0[2]), a1 = MX3(p0[3], p0[4], p0[5]), a2 = MX3(p0[6], p0[7], p0[8]), a3 = MX3(p0[9], p0[10], p0[11]), a4 = MX3(p0[12], p0[13], p0[14]);
    const float a5 = MX3(p1[0], p1[1], p1[2]), a6 = MX3(p1[3], p1[4], p1[5]), a7 = MX3(p1[6], p1[7], p1[8]), a8 = MX3(p1[9], p1[10], p1[11]), a9 = MX3(p1[12], p1[13], p1[14]);
    const float b0 = MX3(a0, a1, a2), b1 = MX3(a3, a4, a5), b2 = MX3(a6, a7, a8), b3 = MX3(a9, p0[15], p1[15]);
    pmax = __builtin_fmaxf(__builtin_fmaxf(b0, b1), __builtin_fmaxf(b2, b3));
#undef MX3
  }
  { auto rr = __builtin_amdgcn_permlane32_swap(__float_as_uint(pmax), __float_as_uint(pmax), false, false);
    pmax = fmaxf(__uint_as_float(rr[0]), __uint_as_float(rr[1])); }
  f32x16 e0;
#pragma unroll
  for (int r = 0; r < 16; ++r) e0[r] = __builtin_amdgcn_exp2f(p0[r]);
  alpha = 1.f;
  if (__builtin_expect(__any(pmax > THRL), 0)) {
    const float dl = fmaxf(pmax, 0.f); mhat += dl;
#pragma unroll
    for (int r = 0; r < 16; ++r) nmv[r] = -mhat;
    asm volatile("" : "+v"(nmv));
#pragma unroll
    for (int r = 0; r < 16; ++r) { p1[r] -= dl; e0[r] = __builtin_amdgcn_exp2f(p0[r] - dl); }
    alpha = __builtin_amdgcn_exp2f(-dl);
    if (hi == 0) al_l[r32] = alpha; asm volatile("s_waitcnt lgkmcnt(0)" ::: "memory");
#pragma unroll
    for (int d = 0; d < 2; ++d)
#pragma unroll
      for (int r = 0; r < 16; ++r) o[d][r] *= al_l[crow(r, hi)];
  }
  p0 = e0;
}
__device__ __forceinline__ void finishSM(f32x16& p0, f32x16& p1, float alpha, float& l_reg, bf16x8& pa0, bf16x8& pa1, bf16x8& pa2, bf16x8& pa3) {
#pragma unroll
  for (int r = 0; r < 16; ++r) p1[r] = __builtin_amdgcn_exp2f(p1[r]);
  float ps;
  { float s0 = p0[0] + p0[1], s1 = p0[2] + p0[3], s2 = p1[0] + p1[1], s3 = p1[2] + p1[3];
#pragma unroll
    for (int r = 4; r < 16; r += 4) { s0 += p0[r] + p0[r + 1]; s1 += p0[r + 2] + p0[r + 3]; s2 += p1[r] + p1[r + 1]; s3 += p1[r + 2] + p1[r + 3]; }
    ps = (s0 + s1) + (s2 + s3); }
  l_reg = l_reg * alpha + ps;
#define PK4(P, BASE, OUT) do { u32x4 w = {cvtpk(P[BASE + 0], P[BASE + 1]), cvtpk(P[BASE + 2], P[BASE + 3]), cvtpk(P[BASE + 4], P[BASE + 5]), cvtpk(P[BASE + 6], P[BASE + 7])}; OUT = *reinterpret_cast<bf16x8*>(&w); } while (0)
  PK4(p0, 0, pa0); PK4(p0, 8, pa1); PK4(p1, 0, pa2); PK4(p1, 8, pa3);
#undef PK4
}
template <int VAR = 0> __device__ __forceinline__ void qkt(f32x16& p0, f32x16& p1, const LCH* Ks, const bf16x8* qr, const f32x16& nmv, int r32, int hi) {
  if (VAR == 5) {
    p0 = nmv; p1 = nmv;
#pragma unroll
    for (int d0 = 0; d0 < 6; ++d0) { p0 = __builtin_amdgcn_mfma_f32_32x32x16_bf16(qr[5 - d0], qr[d0], p0, 0, 0, 0); p1 = __builtin_amdgcn_mfma_f32_32x32x16_bf16(qr[(d0 + 1) % 6], qr[d0], p1, 0, 0, 0); }
    return; }
#pragma unroll
  for (int d0 = 0; d0 < 6; ++d0) { const int cb = (2 * d0 + hi) * 1024 + r32 * 16;
    const bf16x8 b0 = *(const __attribute__((address_space(3))) bf16x8*)(Ks + cb);
    const bf16x8 b1 = *(const __attribute__((address_space(3))) bf16x8*)(Ks + cb + 512);
    p0 = __builtin_amdgcn_mfma_f32_32x32x16_bf16(b0, qr[d0], d0 == 0 ? nmv : p0, 0, 0, 0);
    p1 = __builtin_amdgcn_mfma_f32_32x32x16_bf16(b1, qr[d0], d0 == 0 ? nmv : p1, 0, 0, 0); }
}
__device__ __forceinline__ int v_st(int k, int c) { const int kk = k; return ((kk >> 3) * 2 + (c >> 5)) * 512 + ((kk & 7) * 32 + (c & 31)) * 2; }
__device__ __forceinline__ int v_rd_base(int lane) { return ((lane & 3) << 3) | (((lane >> 2) & 3) << 6) | (((lane >> 4) & 1) << 5) | (((lane >> 5) & 1) << 8); }
constexpr int v_rd_off(int d0, int ks, int half) { return d0 * 512 + ks * 2048 + half * 1024; }
typedef short v4i16_t __attribute__((ext_vector_type(4)));
__device__ __forceinline__ s16x4 vtr(const LCH* p) { return __builtin_bit_cast(s16x4, __builtin_amdgcn_ds_read_tr16_b64_v4i16((__attribute__((address_space(3))) v4i16_t*)p)); }
template <int VAR = 0> __device__ __forceinline__ void pv_d0(f32x16* o, const LCH* vb, bf16x8 pa0, bf16x8 pa1, bf16x8 pa2, bf16x8 pa3) {
  if (VAR == 5) { o[0] = __builtin_amdgcn_mfma_f32_32x32x16_bf16(pa0, pa1, o[0], 0, 0, 0); o[1] = __builtin_amdgcn_mfma_f32_32x32x16_bf16(pa0, pa2, o[1], 0, 0, 0); o[0] = __builtin_amdgcn_mfma_f32_32x32x16_bf16(pa1, pa3, o[0], 0, 0, 0); o[1] = __builtin_amdgcn_mfma_f32_32x32x16_bf16(pa1, pa0, o[1], 0, 0, 0);
    o[0] = __builtin_amdgcn_mfma_f32_32x32x16_bf16(pa2, pa1, o[0], 0, 0, 0); o[1] = __builtin_amdgcn_mfma_f32_32x32x16_bf16(pa2, pa3, o[1], 0, 0, 0); o[0] = __builtin_amdgcn_mfma_f32_32x32x16_bf16(pa3, pa0, o[0], 0, 0, 0); o[1] = __builtin_amdgcn_mfma_f32_32x32x16_bf16(pa3, pa2, o[1], 0, 0, 0); return; }
#define PK(L, H) (bf16x8){L[0], L[1], L[2], L[3], H[0], H[1], H[2], H[3]}
#define PVSTEP(ks, pa) do { const s16x4 l0 = vtr(vb + v_rd_off(0, ks, 0)), h0 = vtr(vb + v_rd_off(0, ks, 1)), l1 = vtr(vb + v_rd_off(1, ks, 0)), h1 = vtr(vb + v_rd_off(1, ks, 1)); \
    o[0] = __builtin_amdgcn_mfma_f32_32x32x16_bf16(pa, PK(l0, h0), o[0], 0, 0, 0); o[1] = __builtin_amdgcn_mfma_f32_32x32x16_bf16(pa, PK(l1, h1), o[1], 0, 0, 0); } while (0)
  PVSTEP(0, pa0); PVSTEP(1, pa1); PVSTEP(2, pa2); PVSTEP(3, pa3);
#undef PVSTEP
#undef PK
}
struct AttnArgs { const bf16_t* Q; const bf16_t* K; const bf16_t* V; const float* ss_q; const float* hss; const float* qn_g; const float* tab; bf16_t* Y; };
template <int VAR> __device__ __forceinline__ void attn_phase(const AttnArgs& A, int vcu, int G, LCH* lds, int flags) {
  const int tid = threadIdx.x, wid = tid >> 6, lane = tid & 63, r32 = lane & 31, hi = lane >> 5;
  LCH* V_lds = lds; LCH* K_lds = lds + NSTG * SHM_V;
  LFL* ws = (LFL*)(lds + NSTG * SHM_V + NSTG * SHM_K) + wid * 64; LFL* li_l = ws; LFL* al_l = ws + 32;
  const int wu = __builtin_amdgcn_readfirstlane(tid >> 6);
  const unsigned kaoff = (unsigned)(lane * DQK + wu * 8) * 2u, kboff = (unsigned)(lane * DQK + (8 + (wu & 3)) * 8) * 2u;
  const unsigned voff = (unsigned)((8 * wu + ((lane & 31) >> 2)) * DV + (lane >> 5) * 32 + (lane & 3) * 8) * 2u;
  const LCH* vb0 = V_lds + v_rd_base(lane);
  const bf16_t* Kh; const bf16_t* Vh;
  const unsigned ldsk0 = (unsigned)(unsigned long)K_lds + (unsigned)wu * 1024u, ldsv0 = (unsigned)(unsigned long)V_lds + (unsigned)wu * 1024u;
#define DMA_TILE(t_, st_) do { const char* kt_ = (const char*)Kh + (size_t)(t_) * (KVBLK * DQK * 2); const char* vt_ = (const char*)Vh + (size_t)(t_) * (KVBLK * DV * 2); \
    glds16s(kt_, kaoff, ldsk0 + (unsigned)(st_) * (unsigned)SHM_K); glds16s(vt_, voff, ldsv0 + (unsigned)(st_) * (unsigned)SHM_V); \
    if (wu < 4) glds16s(kt_, kboff, ldsk0 + (unsigned)(st_) * (unsigned)SHM_K + 8192u); } while (0)
#define VMW(n) asm volatile("s_waitcnt vmcnt(" #n ")" ::: "memory")
  constexpr int uend = 1536;
  const int qsl_off = wu < 4 ? SHM_ATTN + wu * 6144 : (131072 + 1024) + (wu - 4) * 6144;
  const unsigned ldsq0 = (unsigned)(unsigned long)lds + (unsigned)qsl_off;
  const unsigned qoff = (unsigned)(r32 * DQK + hi * 8) * 2u;
#define DMA_Q(uu) do { const char* qb_ = (const char*)(A.Q + ((size_t)((uu) >> 3) * SEQ + ((uu) & 7) * 256 + wu * QBLK) * DQK); \
    _Pragma("unroll") for (int d0 = 0; d0 < 6; ++d0) glds16s(qb_ + d0 * 32, qoff, ldsq0 + (unsigned)d0 * 1024u); } while (0)
  float ssq_, hss_;
#define PREFETCH(uu) do { const int bh_ = (uu) >> 3, b_ = bh_ >> 3, h_ = bh_ & 7, t_ = ((uu) & 7) * 256 + wid * QBLK + r32; const size_t mrow_ = (size_t)b_ * SEQ + t_; \
    ssq_ = A.ss_q[mrow_]; hss_ = A.hss[(size_t)h_ * MROWS + mrow_]; \
    Kh = A.K + (size_t)bh_ * SEQ * DQK; Vh = A.V + (size_t)bh_ * SEQ * DV; } while (0)
#define RESC(a) do { if (__any((a) < 1.f)) { if (hi == 0) al_l[r32] = (a); asm volatile("s_waitcnt lgkmcnt(0)" ::: "memory"); \
    _Pragma("unroll") for (int d = 0; d < 2; ++d) _Pragma("unroll") for (int r = 0; r < 16; ++r) o[d][r] *= al_l[crow(r, hi)]; } } while (0)
  int u = vcu; if (u >= uend) return;
  PREFETCH(u); DMA_Q(u); VMW(0);
  for (;;) {
  VMW(34);
  DMA_TILE(0, 0); DMA_TILE(1, 1);
  const int bh = u >> 3, b = bh >> 3, h = bh & 7, q0 = (u & 7) * 256;
  const int un = u + G; const bool qnext = un < uend;
  u32x4 qw[6];
#pragma unroll
  for (int d0 = 0; d0 < 6; ++d0) qw[d0] = *(const __attribute__((address_space(3))) u32x4*)(lds + qsl_off + d0 * 1024 + lane * 16);
  float mhat = 0.f, l_reg = 0; f32x16 o[2] = {}; bf16x8 qr[6]; f32x16 nmv = {}; asm volatile("" : "+v"(nmv));
  {
    const float rq = 1.0f / sqrtf(ssq_ * (1.0f / 384.0f) + 1e-6f);
    const float sq = (SCALE * 1.4426950408889634f) * rq / sqrtf(hss_ * rq * rq * (1.0f / 96.0f) + 1e-6f);
#pragma unroll
    for (int d0 = 0; d0 < 4; ++d0) {
      const u32x4 w = qw[d0];
      const f32x4 g0 = *reinterpret_cast<const f32x4*>(A.qn_g + d0 * 16 + hi * 8), g1 = *reinterpret_cast<const f32x4*>(A.qn_g + d0 * 16 + hi * 8 + 4);
      u32x4 o4; o4.x = cvtpk(bflo(w.x) * g0[0] * sq, bfhi(w.x) * g0[1] * sq); o4.y = cvtpk(bflo(w.y) * g0[2] * sq, bfhi(w.y) * g0[3] * sq);
      o4.z = cvtpk(bflo(w.z) * g1[0] * sq, bfhi(w.z) * g1[1] * sq); o4.w = cvtpk(bflo(w.w) * g1[2] * sq, bfhi(w.w) * g1[3] * sq);
      qr[d0] = *reinterpret_cast<bf16x8*>(&o4);
    }
#pragma unroll
    for (int d0 = 4; d0 < 6; ++d0) {
      const u32x4 w = qw[d0];
      const int i0 = 8 * (d0 - 4) + 4 * hi;
      const f32x4 g1 = *reinterpret_cast<const f32x4*>(A.qn_g + 64 + i0), g2 = *reinterpret_cast<const f32x4*>(A.qn_g + 80 + i0);
      const float* tb = A.tab + ((size_t)(q0 + wid * QBLK + r32) * 16 + i0) * 2; const f32x4 cs0 = *reinterpret_cast<const f32x4*>(tb), cs1 = *reinterpret_cast<const f32x4*>(tb + 4);
      const unsigned ww[4] = {w.x, w.y, w.z, w.w}; const float cc[4] = {cs0[0], cs0[2], cs1[0], cs1[2]}, sn[4] = {cs0[1], cs0[3], cs1[1], cs1[3]};
      unsigned ow[4];
#pragma unroll
      for (int jj = 0; jj < 4; ++jj) { const float a = bflo(ww[jj]) * g1[jj] * sq, bb = bfhi(ww[jj]) * g2[jj] * sq; ow[jj] = cvtpk(a * cc[jj] - bb * sn[jj], a * sn[jj] + bb * cc[jj]); }
      u32x4 o4 = {ow[0], ow[1], ow[2], ow[3]}; qr[d0] = *reinterpret_cast<bf16x8*>(&o4);
    }
  }
  f32x16 pA0, pA1, pB0, pB1; float alA, alB; bf16x8 pa0, pa1, pa2, pa3; const int NT = (flags & 16) ? SEQ / KVBLK / 2 : SEQ / KVBLK;
  VMW(0); __syncthreads();
  qkt(pA0, pA1, K_lds, qr, nmv, r32, hi); partialSM(pA0, pA1, mhat, nmv, alA, o, al_l, r32, hi);
  DMA_TILE(2, 2); asm volatile("s_barrier" ::: "memory");
  int sk = 1;
#define XPART(PC0, PC1, PP0, PP1, alP_, j_) do { \
    if (VAR != 4) { if ((j_) + 2 < NT) DMA_TILE((j_) + 2, mod5(sk + 2)); else if ((j_) == NT - 2 && qnext) DMA_Q(un); } SBAR(); \
    if (VAR == 7 && wid >= 4) { asm volatile("" : "+v"(PC0), "+v"(PC1)); } else if (VAR != 3) qkt<VAR>(PC0, PC1, K_lds + sk * SHM_K, qr, nmv, r32, hi); else { asm volatile("" : "+v"(PC0), "+v"(PC1)); } \
    if (VAR == 7 && wid >= 4) { asm volatile("" : "+v"(pa0), "+v"(pa1), "+v"(pa2), "+v"(pa3)); } else if (VAR != 1) finishSM(PP0, PP1, alP_, l_reg, pa0, pa1, pa2, pa3); else { asm volatile("" : "+v"(PP0), "+v"(PP1)); asm volatile("" : "+v"(pa0), "+v"(pa1), "+v"(pa2), "+v"(pa3)); } SBAR(); } while (0)
#define YPART(PC0, PC1, alC_, j_) do { \
    if (VAR == 7 && wid >= 4) { asm volatile("" : "+v"(o[0]), "+v"(o[1])); } else if (VAR != 2) pv_d0<VAR>(o, vb0 + mod5(sk + 4) * SHM_V, pa0, pa1, pa2, pa3); else { asm volatile("" : "+v"(o[0]), "+v"(o[1])); } \
    if (VAR == 7 && wid >= 4) { alC_ = 1.f; } else if (VAR != 1) { partialSM(PC0, PC1, mhat, nmv, alC_, o, al_l, r32, hi); } else { asm volatile("" : "+v"(PC0), "+v"(PC1)); alC_ = 1.f; } } while (0)
#define LOOPBAR_A(j_) do { if ((j_) + 2 < NT) asm volatile("s_waitcnt vmcnt(3)\n\ts_barrier" ::: "memory"); else if (qnext) asm volatile("s_waitcnt vmcnt(6)\n\ts_barrier" ::: "memory"); else asm volatile("s_waitcnt vmcnt(0)\n\ts_barrier" ::: "memory"); } while (0)
#define LOOPBAR_B(j_) do { if ((j_) + 2 < NT) asm volatile("s_waitcnt vmcnt(2)\n\ts_barrier" ::: "memory"); else if (qnext) asm volatile("s_waitcnt vmcnt(6)\n\ts_barrier" ::: "memory"); else asm volatile("s_waitcnt vmcnt(0)\n\ts_barrier" ::: "memory"); } while (0)
#define NEXTSTG() do { sk = mod5(sk + 1); } while (0)
  if (wid < 4) {
    for (int j = 1; j + 1 < NT; j += 2) {
      XPART(pB0, pB1, pA0, pA1, alA, j); YPART(pB0, pB1, alB, j); LOOPBAR_A(j); NEXTSTG();
      XPART(pA0, pA1, pB0, pB1, alB, j + 1); YPART(pA0, pA1, alA, j + 1); LOOPBAR_A(j + 1); NEXTSTG();
    }
    XPART(pB0, pB1, pA0, pA1, alA, NT - 1); YPART(pB0, pB1, alB, NT - 1); LOOPBAR_A(NT - 1); NEXTSTG();
  } else {
    for (int j = 1; j + 1 < NT; j += 2) {
      XPART(pB0, pB1, pA0, pA1, alA, j); LOOPBAR_B(j); YPART(pB0, pB1, alB, j); NEXTSTG();
      XPART(pA0, pA1, pB0, pB1, alB, j + 1); LOOPBAR_B(j + 1); YPART(pA0, pA1, alA, j + 1); NEXTSTG();
    }
    XPART(pB0, pB1, pA0, pA1, alA, NT - 1); LOOPBAR_B(NT - 1); YPART(pB0, pB1, alB, NT - 1); NEXTSTG();
  }
#undef LOOPBAR_A
#undef LOOPBAR_B
#undef NEXTSTG
#undef XPART
#undef YPART
  finishSM(pB0, pB1, alB, l_reg, pa0, pa1, pa2, pa3); SBAR();
  pv_d0(o, vb0 + mod5(sk + 4) * SHM_V, pa0, pa1, pa2, pa3);
  bf16_t* Yw = A.Y + ((size_t)b * SEQ + q0 + wid * QBLK) * 1024 + 512 + h * DV;
  if (qnext) PREFETCH(un);
  { auto rr = __builtin_amdgcn_permlane32_swap(__float_as_uint(l_reg), __float_as_uint(l_reg), false, false); l_reg = __uint_as_float(rr[0]) + __uint_as_float(rr[1]); }
  if (hi == 0) li_l[r32] = l_reg; asm volatile("s_waitcnt lgkmcnt(0)" ::: "memory");
  float rli[16];
#pragma unroll
  for (int r = 0; r < 16; ++r) rli[r] = __builtin_amdgcn_rcpf(li_l[crow(r, hi)]);
#pragma unroll
  for (int r = 0; r < 16; ++r) { const int orow = crow(r, hi);
#pragma unroll
    for (int d0 = 0; d0 < 2; ++d0) { const unsigned pk = cvtpk(o[d0][r] * rli[r], 0.f); Yw[(size_t)orow * 1024 + d0 * 32 + r32] = (bf16_t)(pk & 0xffffu); } }
  __syncthreads();
  if (!qnext) break;
  u = un;
  }
#undef DMA_TILE
#undef DMA_Q
#undef VMW
#undef PREFETCH
#undef RESC
}
#undef SBAR
}

constexpr int NWAVES = 8;
constexpr int M = 49152, DM = 1024, SEQL = 2048, MPR = 32768, NPH = 9;
constexpr size_t MiB = 1u << 20;
constexpr size_t WS_CTL = 0, CTL_ZERO_BYTES = 1 * MiB;
constexpr size_t WS_TAB = 1 * MiB;
constexpr size_t WS_SSZ = 2 * MiB, SSZ_BYTES = 13 * (size_t)M * 4;
constexpr size_t WS_SS1 = 5 * MiB;
constexpr size_t WS_KRR = 6 * MiB;
constexpr size_t WS_WIN = 12 * MiB, WS_WQB = WS_WIN + 1280 * 1024 * 2, WS_WKVB = WS_WQB + 768 * 384 * 2, WS_WO = 16 * MiB, WS_WGU = 18 * MiB, WS_WD = 29 * MiB, WS_WPG = 35 * MiB, WS_WPP = 37 * MiB;
constexpr size_t WS_PB = 40 * MiB;
constexpr size_t WS_Z = 64 * MiB;
constexpr size_t WS_XB = 184 * MiB;
constexpr size_t WS_Q = 184 * MiB, WS_K = 256 * MiB, WS_V = 328 * MiB, WS_Y = 376 * MiB;
constexpr size_t WS_HB = 64 * MiB;
constexpr size_t WS_ACT = 184 * MiB;
constexpr size_t WS_PROJ = 184 * MiB;
constexpr size_t WS_END = 472 * MiB;
static_assert(WS_WKVB + 1024 * 256 * 2 <= WS_WO && WS_WGU + (size_t)5632 * 1024 * 2 <= WS_WD && WS_WD + (size_t)1024 * 2816 * 2 <= WS_WPG && WS_WPP + 1024 * 256 * 2 <= WS_PB, "weight map");
static_assert(WS_SSZ + SSZ_BYTES <= WS_SS1 && WS_SS1 + 2 * (size_t)M * 4 <= WS_KRR && WS_KRR + (size_t)M * 32 * 4 <= WS_WIN, "small arrays map");
constexpr int CW_TMO = 0, CW_BAR = 4096;
constexpr int RING_OFF = 0, RING_BYTES = 131072, LDSCTL_OFF = RING_BYTES, MISC_OFF = LDSCTL_OFF + 320, LDS_BYTES = 163840;

#define GAS __attribute__((address_space(1)))
#define LAS __attribute__((address_space(3)))
typedef unsigned short bf16;
typedef unsigned v4u __attribute__((ext_vector_type(4)));
typedef float f32x4 __attribute__((ext_vector_type(4)));
typedef GAS unsigned gu32;
#define RLX_AGENT __ATOMIC_RELAXED, __HIP_MEMORY_SCOPE_AGENT
#define LDS_WAIT() asm volatile("s_waitcnt lgkmcnt(0)" ::: "memory")
#define VM_WAIT() asm volatile("s_waitcnt vmcnt(0)" ::: "memory")
__device__ __forceinline__ unsigned f2bf(float f) { unsigned u = __builtin_bit_cast(unsigned, f); return (u + 0x7fffu + ((u >> 16) & 1u)) >> 16; }
__device__ __forceinline__ unsigned pk2(float lo, float hi) { return f2bf(lo) | (f2bf(hi) << 16); }

#define XB_TMO      128
#define XB_XCNT(j)  (256  + 64 * (j))
#define XB_XSUB(j)  (1280 + 64 * (j))
#define XB_XGEN(j)  (2304 + 64 * (j))
#define XB_TOP      3328
#define XB_TOPGEN   3392
#define XCD_BAR_WORDS 3456
#define XB_SPIN_CAP (1u << 18)

__device__ __forceinline__ unsigned xb_ld(unsigned* p)              { return __hip_atomic_load(p, __ATOMIC_RELAXED, __HIP_MEMORY_SCOPE_AGENT); }
__device__ __forceinline__ unsigned xb_add(unsigned* p, unsigned v) { return __hip_atomic_fetch_add(p, v, __ATOMIC_RELAXED, __HIP_MEMORY_SCOPE_AGENT); }
__device__ __forceinline__ unsigned xb_xcc_id() { return (unsigned)__builtin_amdgcn_s_getreg((3 << 11) | 20) & 0xFu; }
#define XB_SPIN(cond, bar) do { unsigned _sp = 0; while (cond) { __builtin_amdgcn_s_sleep(1); \
    if ((++_sp & 255u) == 0u) { if (xb_ld(&(bar)[XB_TMO])) break; if (_sp > XB_SPIN_CAP) { atomicAdd(&(bar)[XB_TMO], 1u); break; } } } } while (0)

struct XcdBarrier {
    unsigned* bar; unsigned x;
    volatile LAS unsigned* st;
};

__device__ __forceinline__ XcdBarrier xcd_barrier_post(unsigned* bar, volatile LAS unsigned* st) {
    XcdBarrier b; b.bar = bar; b.x = xb_xcc_id(); b.st = st;
    if (threadIdx.x == 0) (void)xb_add(&bar[XB_XCNT(b.x)], 1u);
    return b;
}
__device__ __forceinline__ void xcd_barrier_complete(unsigned* bar, unsigned x, unsigned& nloc, unsigned& nx) {
    const unsigned G = gridDim.x * gridDim.y * gridDim.z;
    unsigned sum, cnt, mine, sp = 0u;
    for (;;) {
        sum = 0u; cnt = 0u; mine = 0u;
#pragma unroll
        for (unsigned j = 0; j < 16; ++j) { const unsigned c = xb_ld(&bar[XB_XCNT(j)]); sum += c; cnt += (c > 0u) ? 1u : 0u; mine = (j == x) ? c : mine; }
        if (sum == G) break;
        __builtin_amdgcn_s_sleep(1);
        if ((++sp & 255u) == 0u) { if (xb_ld(&bar[XB_TMO])) break; if (sp > XB_SPIN_CAP) { atomicAdd(&bar[XB_TMO], 1u); break; } }
    }
    nloc = mine > 0u ? mine : 1u; nx = cnt > 0u ? cnt : 1u;
}

__device__ __forceinline__ void xcd_barrier(const XcdBarrier& b) {
    asm volatile("s_waitcnt vmcnt(0)" ::: "memory");
    __syncthreads();
    if (threadIdx.x == 0) {
        unsigned* bar = b.bar;
        __builtin_amdgcn_s_waitcnt(0);
        unsigned nloc = b.st[0], nx = b.st[1];
        if (nloc == 0u) { xcd_barrier_complete(bar, b.x, nloc, nx); b.st[0] = nloc; b.st[1] = nx; }
#ifdef EARLY_INV
        __builtin_amdgcn_fence(__ATOMIC_ACQUIRE, "agent");
#endif
        const unsigned old = xb_add(&bar[XB_XSUB(b.x)], 1u);
        const unsigned gen = old / nloc;
        if (old + 1u == (gen + 1u) * nloc) {
            __builtin_amdgcn_fence(__ATOMIC_RELEASE, "agent");
            asm volatile("s_waitcnt vmcnt(0)" ::: "memory");
            const unsigned og = xb_add(&bar[XB_TOP], 1u);
            const unsigned tg = og / nx;
            if (og + 1u == (tg + 1u) * nx) xb_add(&bar[XB_TOPGEN], 1u);
            else XB_SPIN(xb_ld(&bar[XB_TOPGEN]) == tg, bar);
#ifndef EARLY_INV
            __builtin_amdgcn_fence(__ATOMIC_ACQUIRE, "agent");
#endif
            xb_add(&bar[XB_XGEN(b.x)], 1u);
            asm volatile("s_waitcnt vmcnt(0)" ::: "memory");
        } else {
            XB_SPIN(xb_ld(&bar[XB_XGEN(b.x)]) == gen, bar);
#ifndef EARLY_INV
            __builtin_amdgcn_fence(__ATOMIC_ACQUIRE, "agent");
#endif
            asm volatile("s_waitcnt vmcnt(0)" ::: "memory");
        }
    }
    __syncthreads();
}


struct Frame {
    LAS unsigned char* lds; volatile LAS unsigned* MISC; gu32* ctl;
    int tid, lane, wave, vcu, G;
};
struct Args { const float* in[22]; float* out; unsigned char* ws; int ph_lo, ph_hi, p0mask, pad; };

__device__ __forceinline__ float wave_sum(float v) {
#pragma unroll
    for (int o = 1; o < 64; o <<= 1) v += __shfl_xor(v, o);
    return v;
}
enum { MAP_ID = 0, MAP_IN = 1, MAP_QB = 2, MAP_KVB = 3, MAP_GU = 4 };
__device__ __forceinline__ int map_col(int map, int n) {
    if (map == MAP_IN) { if (n < 896) return n; if (n < 928) { const int i = n - 896, pr = i >> 1; return 1152 + ((i & 1) ? 16 + pr : pr); } if (n < 1024) return -1; return 896 + (n - 1024); }
    if (map == MAP_QB) { const int slab = n >> 5, c = n & 31, head = slab / 3, part = slab - 3 * head; const int lg = part < 2 ? part * 32 + c : 64 + ((c & 1) ? 16 + (c >> 1) : (c >> 1)); return head * 96 + lg; }
    if (map == MAP_KVB) { const int t = n >> 8, r = n & 255, bj = r >> 7, wc = (r >> 5) & 3, c = r & 31; return (2 * t + (wc & 1)) * 128 + (wc >> 1) * 64 + bj * 32 + c; }
    if (map == MAP_GU) { const int pn = n >> 8, r = n & 255; return ((r >> 7) ? 2816 : 0) + pn * 128 + (r & 127); }
    return n;
}
__device__ __forceinline__ void p0_transpose_item(const float* W, const float* W2, int ldw, const float* gain, bf16* WT, int ldt, int kdst0, int nblk, int map, LAS float* scr, int item, int lane) {
    const int kb = item / nblk, nb = item - kb * nblk, k0 = 64 * kb, n0 = 32 * nb;
    int col = map_col(map, n0 + (lane & 31)); const float* src = W; if (map == MAP_GU && col >= 2816) { col -= 2816; src = W2; }
    const float msk = col < 0 ? 0.f : 1.f; col = col < 0 ? 0 : col;
    const float* sp = src + (size_t)(k0 + (lane >> 5)) * ldw + col;
    float v[32];
#pragma unroll
    for (int i = 0; i < 32; ++i) v[i] = __builtin_nontemporal_load(sp + (size_t)(2 * i) * ldw);
    if (gain) {
        const float* gp = gain + k0 + (lane >> 5);
#pragma unroll
        for (int i = 0; i < 32; ++i) v[i] *= gp[2 * i];
    }
#pragma unroll
    for (int i = 0; i < 32; ++i) scr[(2 * i + (lane >> 5)) * 33 + (lane & 31)] = v[i] * msk;
    LDS_WAIT(); asm volatile("" ::: "memory");
    const int c = lane & 7;
#pragma unroll
    for (int j = 0; j < 4; ++j) { const int n = (lane >> 3) + 8 * j; const LAS float* s = scr + (8 * c) * 33 + n;
        v4u o; o.x = pk2(s[0 * 33], s[1 * 33]); o.y = pk2(s[2 * 33], s[3 * 33]); o.z = pk2(s[4 * 33], s[5 * 33]); o.w = pk2(s[6 * 33], s[7 * 33]);
        *(GAS v4u*)(WT + (size_t)(n0 + n) * ldt + kdst0 + k0 + 8 * c) = o; }
    LDS_WAIT(); asm volatile("" ::: "memory");
}
__device__ __forceinline__ void p0_prologue(Frame& F, const Args& a) {
    unsigned char* ws = a.ws;
    LAS float* scr = (LAS float*)(F.lds + RING_OFF + F.wave * 16384);
    constexpr int AW0 = 4, AW = NWAVES - AW0;
    const int pm_ = a.p0mask;
    if (F.wave >= AW0) {
    const int gw = F.vcu * AW + (F.wave - AW0), NGW = F.G * AW;
    const int gt = gw * 64 + F.lane, NGT = NGW * 64;
    if (pm_ & 1) { v4u* zp = (v4u*)(ws + WS_SSZ); const v4u zz = {0u, 0u, 0u, 0u}; for (int i = gt; i < (int)(SSZ_BYTES / 16); i += NGT) zp[i] = zz; }
    if (pm_ & 1) { float* tab = (float*)(ws + WS_TAB); for (int i = gt; i < SEQL * 16; i += NGT) { const int t = i >> 4, f = i & 15; const float ang = (float)t * powf(10000.0f, -(float)(2 * f) / 32.0f); tab[2 * i] = cosf(ang); tab[2 * i + 1] = sinf(ang); } }
    if (pm_ & 2) {
        const float *ln1 = a.in[4], *w_in = a.in[5], *qan = a.in[8], *w_qb = a.in[9], *kvan = a.in[10], *w_kvb = a.in[11], *w_o = a.in[14], *ln2 = a.in[15], *w_gate = a.in[16], *w_up = a.in[17], *w_down = a.in[18], *plen = a.in[19], *w_pg = a.in[20], *w_pp = a.in[21];
        constexpr int I_IN = (1024 / 64) * (1280 / 32), I_QB = (384 / 64) * (768 / 32), I_KVB = (256 / 64) * (1024 / 32), I_O = (512 / 64) * (1024 / 32), I_GU = (1024 / 64) * (5632 / 32), I_D = (2816 / 64) * (1024 / 32), I_PG = (1024 / 64) * (1024 / 32), I_PP = (256 / 64) * (1024 / 32);
        constexpr int NITEMS = I_IN + I_QB + I_KVB + I_O + I_GU + I_D + I_PG + I_PP;
        for (int it = gw; it < NITEMS; it += NGW) {
            int r = it;
            if (r < I_IN) { p0_transpose_item(w_in, nullptr, 1184, ln1, (bf16*)(ws + WS_WIN), 1024, 0, 1280 / 32, MAP_IN, scr, r, F.lane); continue; } r -= I_IN;
            if (r < I_QB) { p0_transpose_item(w_qb, nullptr, 768, qan, (bf16*)(ws + WS_WQB), 384, 0, 768 / 32, MAP_QB, scr, r, F.lane); continue; } r -= I_QB;
            if (r < I_KVB) { p0_transpose_item(w_kvb, nullptr, 1024, kvan, (bf16*)(ws + WS_WKVB), 256, 0, 1024 / 32, MAP_KVB, scr, r, F.lane); continue; } r -= I_KVB;
            if (r < I_O) { p0_transpose_item(w_o + (size_t)512 * 1024, nullptr, 1024, nullptr, (bf16*)(ws + WS_WO), 1024, 512, 1024 / 32, MAP_ID, scr, r, F.lane); continue; } r -= I_O;
            if (r < I_GU) { p0_transpose_item(w_gate, w_up, 2816, ln2, (bf16*)(ws + WS_WGU), 1024, 0, 5632 / 32, MAP_GU, scr, r, F.lane); continue; } r -= I_GU;
            if (r < I_D) { p0_transpose_item(w_down, nullptr, 1024, nullptr, (bf16*)(ws + WS_WD), 2816, 0, 1024 / 32, MAP_ID, scr, r, F.lane); continue; } r -= I_D;
            if (r < I_PG) { p0_transpose_item(w_pg, nullptr, 1024, plen, (bf16*)(ws + WS_WPG), 1024, 0, 1024 / 32, MAP_ID, scr, r, F.lane); continue; } r -= I_PG;
            p0_transpose_item(w_pp, nullptr, 1024, nullptr, (bf16*)(ws + WS_WPP), 256, 0, 1024 / 32, MAP_ID, scr, r, F.lane);
        }
    }
    if (pm_ & 4) {
        const float* w_pool = a.in[6]; const float* psc = a.in[7]; const float* w_o = a.in[14]; bf16* WO = (bf16*)(ws + WS_WO);
        for (int it = gw; it < 512; it += NGW) {
            const int kb = it >> 4, nb = it & 15, kk0 = kb * 16, g = kk0 >> 7, n = nb * 64 + F.lane;
            const float* wo = w_o + (size_t)(g * 128) * 1024 + n; const float* wp = w_pool + (size_t)kk0 * 128; const float* sc = psc + g * 128;
            { float t[32];
#pragma unroll
                for (int i = 0; i < 32; ++i) t[i] = wp[i * 64 + F.lane];
                const float s0 = sc[F.lane], s1 = sc[64 + F.lane];
#pragma unroll
                for (int i = 0; i < 32; ++i) scr[i * 64 + F.lane] = t[i] * ((i & 1) ? s1 : s0); }
            LDS_WAIT(); asm volatile("" ::: "memory");
            float acc[16];
#pragma unroll
            for (int e = 0; e < 16; ++e) acc[e] = 0.f;
#pragma unroll 1
            for (int j0 = 0; j0 < 128; j0 += 32) {
                float w[32];
#pragma unroll
                for (int j = 0; j < 32; ++j) w[j] = wo[(size_t)(j0 + j) * 1024];
#pragma unroll
                for (int j = 0; j < 32; j += 4)
#pragma unroll
                    for (int e = 0; e < 16; ++e) { const f32x4 av = *(const LAS f32x4*)(scr + e * 128 + j0 + j);
                        acc[e] = fmaf(av.x, w[j], acc[e]); acc[e] = fmaf(av.y, w[j + 1], acc[e]); acc[e] = fmaf(av.z, w[j + 2], acc[e]); acc[e] = fmaf(av.w, w[j + 3], acc[e]); }
            }
            v4u o0, o1; o0.x = pk2(acc[0], acc[1]); o0.y = pk2(acc[2], acc[3]); o0.z = pk2(acc[4], acc[5]); o0.w = pk2(acc[6], acc[7]); o1.x = pk2(acc[8], acc[9]); o1.y = pk2(acc[10], acc[11]); o1.z = pk2(acc[12], acc[13]); o1.w = pk2(acc[14], acc[15]);
            *(GAS v4u*)(WO + (size_t)n * 1024 + kk0) = o0; *(GAS v4u*)(WO + (size_t)n * 1024 + kk0 + 8) = o1;
            LDS_WAIT(); asm volatile("" ::: "memory");
        }
    }
    }
    if (pm_ & 8) {
        bf16* XB = (bf16*)a.out; bf16* PB = (bf16*)(ws + WS_PB); float* xinv = (float*)(ws + WS_SS1);
        volatile LAS int* ctr = (volatile LAS int*)(F.lds + LDSCTL_OFF + 64);
        const int ppb = (M / 2) / F.G, pbase = F.vcu * ppb, ptot = (F.vcu == F.G - 1) ? (M / 2) - pbase : ppb;
        for (;;) {
            int pr = 0; if (F.lane == 0) pr = __hip_atomic_fetch_add((LAS int*)ctr, 1, __ATOMIC_RELAXED, __HIP_MEMORY_SCOPE_WORKGROUP);
            pr = __builtin_amdgcn_readfirstlane(pr); if (pr >= ptot) break;
            const int m0 = 2 * (pbase + pr);
            f32x4 v[2][4], pv[2];
#pragma unroll
            for (int r = 0; r < 2; ++r) { const int m = m0 + r;
                const float* xrow = m < MPR ? a.in[0] + (size_t)m * DM : a.in[1] + (size_t)(m - MPR) * DM;
                const float* prow = m < MPR ? a.in[2] + (size_t)m * 256 : a.in[3] + (size_t)(m - MPR) * 256;
                const GAS f32x4* xr = (const GAS f32x4*)xrow + F.lane;
#pragma unroll
                for (int j = 0; j < 4; ++j) v[r][j] = __builtin_nontemporal_load(xr + 64 * j);
                pv[r] = __builtin_nontemporal_load((const GAS f32x4*)prow + F.lane); }
#pragma unroll
            for (int r = 0; r < 2; ++r) { const int m = m0 + r; float s = 0.f;
#pragma unroll
                for (int j = 0; j < 4; ++j) s += (v[r][j].x * v[r][j].x + v[r][j].y * v[r][j].y) + (v[r][j].z * v[r][j].z + v[r][j].w * v[r][j].w);
                s = wave_sum(s); const float rs = 1.0f / sqrtf(s * (1.0f / 1024.0f) + 1e-6f);
                if (F.lane == 0) xinv[m] = sqrtf(s * (1.0f / 1024.0f) + 1e-6f);
                GAS unsigned long long* o8 = (GAS unsigned long long*)(XB + (size_t)m * DM) + F.lane;
#pragma unroll
                for (int j = 0; j < 4; ++j) o8[64 * j] = (unsigned long long)pk2(v[r][j].x * rs, v[r][j].y * rs) | ((unsigned long long)pk2(v[r][j].z * rs, v[r][j].w * rs) << 32);
                __builtin_nontemporal_store((unsigned long long)pk2(pv[r].x, pv[r].y) | ((unsigned long long)pk2(pv[r].z, pv[r].w) << 32), (unsigned long long*)(PB + (size_t)m * 256) + F.lane); }
        }
    }
}
template <int W, int R> __device__ __forceinline__ void pool_quad(const bf16* Z, bf16* Y, int row0, int c8) {
    const int t0 = row0 & (SEQL - 1), lo = t0 - W / 2; const bf16* zb = Z + (size_t)(row0 - t0) * 1280 + c8 * 8;
    v4u wv[W + R - 1];
#pragma unroll
    for (int i = 0; i < W + R - 1; ++i) { const int j = lo + i; const bool ok = j >= 0 && j < SEQL; wv[i] = *(const GAS v4u*)(zb + (size_t)(ok ? j : t0) * 1280); if (!ok) wv[i] = (v4u){0u, 0u, 0u, 0u}; }
#define PF(VV, e) (((e) & 1) ? __uint_as_float(((e) >> 1) == 0 ? (VV).x & 0xffff0000u : ((e) >> 1) == 1 ? (VV).y & 0xffff0000u : ((e) >> 1) == 2 ? (VV).z & 0xffff0000u : (VV).w & 0xffff0000u) \
                            : __uint_as_float(((e) >> 1) == 0 ? (VV).x << 16 : ((e) >> 1) == 1 ? (VV).y << 16 : ((e) >> 1) == 2 ? (VV).z << 16 : (VV).w << 16))
    float s[8];
#pragma unroll
    for (int e = 0; e < 8; ++e) { s[e] = 0.f;
#pragma unroll
        for (int i = 0; i < W; ++i) s[e] += PF(wv[i], e); }
#pragma unroll
    for (int r = 0; r < R; ++r) {
        if (r > 0) {
#pragma unroll
            for (int e = 0; e < 8; ++e) s[e] += PF(wv[W + r - 1], e) - PF(wv[r - 1], e); }
        const int t = t0 + r, a = t - W / 2, b = a + W; const float inv = 1.0f / (float)((b > SEQL ? SEQL : b) - (a < 0 ? 0 : a)); const v4u cv = wv[r + W / 2];
        v4u o; o.x = pk2(s[0] * inv - PF(cv, 0), s[1] * inv - PF(cv, 1)); o.y = pk2(s[2] * inv - PF(cv, 2), s[3] * inv - PF(cv, 3)); o.z = pk2(s[4] * inv - PF(cv, 4), s[5] * inv - PF(cv, 5)); o.w = pk2(s[6] * inv - PF(cv, 6), s[7] * inv - PF(cv, 7));
        *(GAS v4u*)(Y + (size_t)(row0 + r) * 1024 + c8 * 8) = o;
    }
#undef PF
}
__device__ __forceinline__ void pool_phase(Frame& F, const bf16* Z, bf16* Y) {
    const int gw = F.vcu * NWAVES + F.wave, NGW = F.G * NWAVES;
    constexpr int R = 8;
    for (int wi = gw; wi < M / R; wi += NGW) {
        const int g = (wi + (wi >> 11)) & 3, row0 = ((wi >> 2) * 4 + (F.lane >> 4)) * R, c8 = g * 16 + (F.lane & 15);
        if (g == 0) pool_quad<2, R>(Z, Y, row0, c8); else if (g == 1) pool_quad<4, R>(Z, Y, row0, c8); else if (g == 2) pool_quad<8, R>(Z, Y, row0, c8); else pool_quad<16, R>(Z, Y, row0, c8);
    }
}

__global__ void __launch_bounds__(NWAVES * 64, 2) mega_fwd(Args args) {
    extern __shared__ __attribute__((aligned(16))) unsigned char lds[];
    Frame F;
    F.lds = (LAS unsigned char*)lds; F.MISC = (volatile LAS unsigned*)(F.lds + MISC_OFF);
    F.tid = threadIdx.x; F.lane = F.tid & 63; F.wave = __builtin_amdgcn_readfirstlane(F.tid >> 6);
    F.G = gridDim.x; { const int bx = blockIdx.x; F.vcu = (F.G % 8 == 0) ? (bx % 8) * (F.G / 8) + bx / 8 : bx; }
    unsigned char* ws = args.ws; F.ctl = (gu32*)(ws + WS_CTL);
    for (int u = F.tid; u < (LDS_BYTES - LDSCTL_OFF) / 4; u += NWAVES * 64) ((LAS unsigned*)(F.lds + LDSCTL_OFF))[u] = 0u;
    __syncthreads();
    XcdBarrier bar = xcd_barrier_post((unsigned*)(F.ctl + CW_BAR), F.MISC + 8);
    const int lo = args.ph_lo, hi = args.ph_hi;
#ifdef TS_BUILD
    unsigned long long* tsb = (unsigned long long*)(ws + 39 * MiB); int nts = 0;
#define STAMP() do { if (blockIdx.x == 0 && F.tid == 0) tsb[nts] = __builtin_amdgcn_s_memrealtime(); ++nts; } while (0)
#else
#define STAMP() do {} while (0)
#endif
    STAMP();
#ifndef PHMASK
#define PHMASK 0x1ff
#endif
#define IN(k) (((PHMASK >> (k)) & 1) && lo <= (k) && (k) < hi)
#ifndef REPEAT_MASK
#define REPEAT_MASK 0
#endif
#define REPS(k) for (int rep = 0; rep < 1 + ((REPEAT_MASK >> (k)) & 1); ++rep)
    float* spare = (float*)(ws + 38 * MiB);
#define SEAM(k) do { if (IN(k) && IN((k) + 1)) xcd_barrier(bar); STAMP(); } while (0)
    float* ssz = (float*)(ws + WS_SSZ); float *ss_q = ssz, *ss_kv = ssz + M, *ss2 = ssz + 2 * (size_t)M, *ss3 = ssz + 3 * (size_t)M, *hss = ssz + 5 * (size_t)M;
    float* ss1 = (float*)(ws + WS_SS1); float* ss_kr = ss1 + M; float* krr = (float*)(ws + WS_KRR); const float* tab = (const float*)(ws + WS_TAB);
    float* out = args.out;

    if (IN(0)) REPS(0) { p0_prologue(F, args); } SEAM(0);
    if (IN(1)) REPS(1) {
        pg8::Gemm g{(const pg8::bf16_t*)out, (const pg8::bf16_t*)(ws + WS_WIN), M, 1280, 1024, 1024}; pg8::StaticOrder S; S.init(M, 1280, F.G, (int)blockIdx.x);
        pg8::EpiIn E{(pg8::bf16_t*)(ws + WS_Z), ss1, rep ? spare : ss_q, rep ? spare : ss_kv, ss_kr, krr, args.in[13], tab};
        pg8::gemm_phase<pg8::EpiIn, pg8::StaticOrder, true, true>(F.lds + RING_OFF, g, S, E);
    } SEAM(1);
    if (IN(2)) {
        REPS(9) { pool_phase(F, (const bf16*)(ws + WS_Z), (bf16*)(ws + WS_Y)); VM_WAIT(); }
        REPS(10) { pg8::Gemm g{(const pg8::bf16_t*)(ws + WS_Z) + 512, (const pg8::bf16_t*)(ws + WS_WQB), M, 768, 384, 1280}; pg8::StaticOrder S; S.init(M, 768, F.G, (int)blockIdx.x);
          pg8::EpiQ E{(pg8::bf16_t*)(ws + WS_Q), ss_q, rep ? spare : hss};
          pg8::gemm_phase<pg8::EpiQ, pg8::StaticOrder, true, true>(F.lds + RING_OFF, g, S, E); }
        REPS(11) { pg8::Gemm g{(const pg8::bf16_t*)(ws + WS_Z) + 1024, (const pg8::bf16_t*)(ws + WS_WKVB), M, 1024, 256, 1280}; pg8::StaticOrder S; S.init(M, 1024, F.G, (int)blockIdx.x);
          pg8::EpiKV E{(pg8::bf16_t*)(ws + WS_K), (pg8::bf16_t*)(ws + WS_V), ss_kv, ss_kr, krr, args.in[13], 0};
          pg8::gemm_phase<pg8::EpiKV, pg8::StaticOrder, true, true>(F.lds + RING_OFF, g, S, E); }
    } SEAM(2);
    if (IN(3)) REPS(3) {
        const att::AttnArgs A{(const att::bf16_t*)(ws + WS_Q), (const att::bf16_t*)(ws + WS_K), (const att::bf16_t*)(ws + WS_V), ss_q, hss, args.in[12], tab, (att::bf16_t*)(ws + WS_Y)};
        { const int var_ = args.p0mask >> 5; att::LCH* al_ = (att::LCH*)(F.lds + RING_OFF);
#ifdef ATTN_VARIANTS
          if (var_ == 1) att::attn_phase<1>(A, F.vcu, F.G, al_, args.p0mask); else if (var_ == 2) att::attn_phase<2>(A, F.vcu, F.G, al_, args.p0mask); else if (var_ == 3) att::attn_phase<3>(A, F.vcu, F.G, al_, args.p0mask); else if (var_ == 4) att::attn_phase<4>(A, F.vcu, F.G, al_, args.p0mask); else
#endif
          att::attn_phase<0>(A, F.vcu, F.G, al_, args.p0mask); (void)var_; }
    } SEAM(3);
    if (IN(4)) REPS(4) {
        pg8::Gemm g{(const pg8::bf16_t*)(ws + WS_Y), (const pg8::bf16_t*)(ws + WS_WO), M, 1024, 1024, 1024}; pg8::StaticOrder S; S.init(M, 1024, F.G, (int)blockIdx.x);
        pg8::EpiResX E{(const pg8::bf16_t*)out, ss1, (pg8::bf16_t*)(ws + WS_HB), rep ? spare : ss2};
        pg8::gemm_phase<pg8::EpiResX, pg8::StaticOrder, true, true>(F.lds + RING_OFF, g, S, E);
    } SEAM(4);
    if (IN(5)) REPS(5) {
        pg8::Gemm g{(const pg8::bf16_t*)(ws + WS_HB), (const pg8::bf16_t*)(ws + WS_WGU), M, 5632, 1024, 1024}; pg8::StaticOrder S; S.init(M, 5632, F.G, (int)blockIdx.x);
        pg8::EpiSwiglu E{(pg8::bf16_t*)(ws + WS_ACT), ss2};
        pg8::gemm_phase<pg8::EpiSwiglu, pg8::StaticOrder, true, true>(F.lds + RING_OFF, g, S, E);
    } SEAM(5);
    if (IN(6)) {
        pg8::Gemm g{(const pg8::bf16_t*)(ws + WS_ACT), (const pg8::bf16_t*)(ws + WS_WD), M, 1024, 2816, 2816}; pg8::StaticOrder S; S.init(M, 1024, F.G, (int)blockIdx.x, 1);
        pg8::EpiResB E{(pg8::bf16_t*)(ws + WS_HB), ss3};
        pg8::gemm_phase<pg8::EpiResB, pg8::StaticOrder, true, true>(F.lds + RING_OFF, g, S, E);
    } SEAM(6);
    if (IN(7)) REPS(7) {
        pg8::Gemm g{(const pg8::bf16_t*)(ws + WS_PB), (const pg8::bf16_t*)(ws + WS_WPP), M, 1024, 256, 256}; pg8::StaticOrder S; S.init(M, 1024, F.G, (int)blockIdx.x);
        pg8::EpiStore E{(pg8::bf16_t*)(ws + WS_PROJ)};
        pg8::gemm_phase<pg8::EpiStore, pg8::StaticOrder, true, true>(F.lds + RING_OFF, g, S, E);
    }
    if (IN(7) && IN(8)) { VM_WAIT(); __syncthreads(); } STAMP();
    if (IN(8)) {
        pg8::Gemm g{(const pg8::bf16_t*)(ws + WS_HB), (const pg8::bf16_t*)(ws + WS_WPG), M, 1024, 1024, 1024}; pg8::StaticOrder S; S.init(M, 1024, F.G, (int)blockIdx.x);
        pg8::EpiFinal E{out, (const pg8::bf16_t*)(ws + WS_HB), (const pg8::bf16_t*)(ws + WS_PROJ), ss3};
        pg8::gemm_phase<pg8::EpiFinal, pg8::StaticOrder, true, true>(F.lds + RING_OFF, g, S, E);
    }
    STAMP();
#undef IN
#undef SEAM
}

static int launch_fast(void* const* d_in, void* d_out, void* d_ws, size_t ws_size, hipStream_t stream, int ph_lo, int ph_hi, int p0mask = 15) {
    static int grid = 0;
    if (grid == 0) {
        if (ws_size < WS_END) { fprintf(stderr, "kernel_launch: workspace too small: %zu < %zu\n", ws_size, (size_t)WS_END); grid = -1; return -1; }
        int dev = 0, cus = 0, per_cu = 0;
        if (hipGetDevice(&dev) != hipSuccess || hipDeviceGetAttribute(&cus, hipDeviceAttributeMultiprocessorCount, dev) != hipSuccess) { grid = -1; return -1; }
        if (hipFuncSetAttribute((const void*)mega_fwd, hipFuncAttributeMaxDynamicSharedMemorySize, LDS_BYTES) != hipSuccess) { fprintf(stderr, "kernel_launch: hipFuncSetAttribute failed\n"); grid = -1; return -1; }
        if (hipOccupancyMaxActiveBlocksPerMultiprocessor(&per_cu, (const void*)mega_fwd, NWAVES * 64, LDS_BYTES) != hipSuccess || per_cu < 1) fprintf(stderr, "kernel_launch: note: occupancy query reports %d\n", per_cu);
        (void)hipGetLastError();
        grid = cus;
    }
    if (grid < 0) return -1;
    if (hipMemsetAsync((char*)d_ws + WS_CTL, 0, CTL_ZERO_BYTES, stream) != hipSuccess) return -1;
    Args a{};
    for (int i = 0; i < 22; ++i) a.in[i] = (const float*)d_in[i];
    a.out = (float*)d_out; a.ws = (unsigned char*)d_ws; a.ph_lo = ph_lo; a.ph_hi = ph_hi; a.p0mask = p0mask;
    hipLaunchKernelGGL(mega_fwd, dim3(grid), dim3(NWAVES * 64), LDS_BYTES, stream, a);
    const hipError_t le = hipPeekAtLastError();
    if (le != hipSuccess) { fprintf(stderr, "kernel_launch: launch failed: %s\n", hipGetErrorName(le)); return -1; }
    return 0;
}

extern "C" void kernel_launch(void* const* d_in, const int* in_sizes, int n_in, void* d_out, int out_size, void* d_ws, size_t ws_size, hipStream_t stream) {
  (void)in_sizes; (void)n_in; (void)out_size;
  launch_fast(d_in, d_out, d_ws, ws_size, stream, 0, NPH);
}
```
